# Optimizing an MI355X kernel written in HIP

```python
import jax, jax.numpy as jnp
from jax import lax
import numpy as np

D_MODEL = 1024
BATCH = 4
SEQ = 4096
DEPTH = 2

HEAD_DIM = 64
BLK = 128
NEG = -1e30
RMS_EPS = 1e-6
FOX_HEADS = 8
DIL_HEADS = 8
DIL_BRANCHES = ((128, 1), (512, 4), (2048, 16))
MLA_HEADS = 8
MLA_Q_RANK = 384
MLA_KV_RANK = 256
MLA_NOPE = 64
MLA_ROPE = 32
MLA_V = 64
ROPE_THETA = 10000.0
SWA_Q_HEADS = 8
SWA_KV_HEADS = 2
SWA_WINDOW = 128
N_GROUPS = 4
EXPERTS_PER_GROUP = 8
N_EXPERTS = N_GROUPS * EXPERTS_PER_GROUP
EXPERT_TOPK = 2
D_EXPERT = 256

EVEN_SPLIT = [FOX_HEADS * HEAD_DIM] * 3 + [FOX_HEADS] + [DIL_HEADS * HEAD_DIM] * 3
EVEN_IN = sum(EVEN_SPLIT)
EVEN_MIX = (FOX_HEADS + DIL_HEADS) * HEAD_DIM
ODD_SPLIT = [MLA_Q_RANK, MLA_KV_RANK, MLA_ROPE, SWA_Q_HEADS * HEAD_DIM, SWA_KV_HEADS * HEAD_DIM, SWA_KV_HEADS * HEAD_DIM]
ODD_IN = sum(ODD_SPLIT)
ODD_MIX = MLA_HEADS * MLA_V + SWA_Q_HEADS * HEAD_DIM
N_EVEN = (DEPTH + 1) // 2
N_ODD = DEPTH // 2

kernel_name = "hybrid_fox_dilated_mla_swa_hmoe"

F32 = jnp.float32


def rmsnorm(x, g):
    xf = x.astype(F32)
    y = xf * lax.rsqrt(jnp.mean(xf * xf, axis=-1, keepdims=True) + RMS_EPS)
    return (y * g.astype(F32)).astype(x.dtype)


def split_cols(z, sizes):
    idx = [int(v) for v in np.cumsum(sizes)[:-1]]
    return jnp.split(z, idx, axis=-1)


def to_heads(t, n):
    b, s, _ = t.shape
    return t.reshape(b, s, n, -1).transpose(0, 2, 1, 3)


def from_heads(o):
    b, h, s, e = o.shape
    return o.transpose(0, 2, 1, 3).reshape(b, s, h * e)


def alibi_slopes(n):
    return jnp.exp2(-8.0 * jnp.arange(1, n + 1, dtype=F32) / n)


def rope_tables(s):
    inv = ROPE_THETA ** (-jnp.arange(0, MLA_ROPE, 2, dtype=F32) / MLA_ROPE)
    ang = jnp.arange(s, dtype=F32)[:, None] * inv[None, :]
    return jnp.cos(ang), jnp.sin(ang)


def apply_rope(t, cos, sin):
    half = t.shape[-1] // 2
    t1, t2 = t[..., :half].astype(F32), t[..., half:].astype(F32)
    return jnp.concatenate([t1 * cos - t2 * sin, t1 * sin + t2 * cos], axis=-1).astype(t.dtype)


def causal_block_sweep(block_scores, v):
    b, h, s, e = v.shape
    kpos = jnp.arange(s)
    vf = v.astype(F32)

    def one(i):
        sc = block_scores(i)
        qpos = i * BLK + jnp.arange(BLK)
        sc = jnp.where(kpos[None, :] <= qpos[:, None], sc, NEG)
        p = jax.nn.softmax(sc, axis=-1)
        return jnp.einsum("bhqk,bhke->bhqe", p, vf)

    out = lax.map(one, jnp.arange(s // BLK))
    return out.transpose(1, 2, 0, 3, 4).reshape(b, h, s, e).astype(v.dtype)


def banded_attention(q, k, v, max_steps, step_dist, slopes, sinks=None):
    n, hk, g, L, e = q.shape
    nb = L // BLK
    qb = q.reshape(n, hk, g, nb, BLK, e)

    def with_prev(t):
        t = t.reshape(n, hk, nb, BLK, e)
        prev = jnp.concatenate([jnp.zeros_like(t[:, :, :1]), t[:, :, :-1]], axis=2)
        return jnp.concatenate([prev, t], axis=3)

    kc, vc = with_prev(k), with_prev(v)
    s = jnp.einsum("nhgbqe,nhbke->nhgbqk", qb, kc, preferred_element_type=F32) * (e ** -0.5)
    steps = (jnp.arange(BLK)[:, None] + BLK) - jnp.arange(2 * BLK)[None, :]
    in_band = (steps >= 0) & (steps <= max_steps)
    has_prev = (jnp.arange(nb)[:, None, None] > 0) | (jnp.arange(2 * BLK)[None, None, :] >= BLK)
    mask = in_band[None] & has_prev
    dist = (steps * step_dist).astype(F32)
    s = s - slopes.astype(F32)[None, :, :, None, None, None] * dist
    s = jnp.where(mask, s, NEG)
    m = s.max(axis=-1)
    if sinks is not None:
        sk = sinks.astype(F32)[None, :, :, None, None]
        m = jnp.maximum(m, sk)
    p = jnp.exp(s - m[..., None])
    den = p.sum(axis=-1)
    if sinks is not None:
        den = den + jnp.exp(sk - m)
    o = jnp.einsum("nhgbqk,nhbke->nhgbqe", p, vc.astype(F32)) / den[..., None]
    lse = m + jnp.log(den)
    return o.reshape(n, hk, g, L, e).astype(q.dtype), lse.reshape(n, hk, g, L)


def forgetting_attention(q, k, v, log_f):
    c = jnp.cumsum(log_f, axis=-1)
    scale = q.shape[-1] ** -0.5

    def scores(i):
        qi = lax.dynamic_slice_in_dim(q, i * BLK, BLK, axis=2)
        ci = lax.dynamic_slice_in_dim(c, i * BLK, BLK, axis=2)
        sc = jnp.einsum("bhqe,bhke->bhqk", qi, k, preferred_element_type=F32) * scale
        return sc + ci[..., None] - c[:, :, None, :]

    return causal_block_sweep(scores, v)


def dilated_branch(q, k, v, window, dil, slopes):
    b, h, s, e = q.shape
    L = s // dil
    Lp = -(-L // BLK) * BLK

    def split(t):
        t = t.reshape(b, h, L, dil, e).transpose(0, 3, 1, 2, 4).reshape(b * dil, h, L, e)
        return jnp.pad(t, ((0, 0), (0, 0), (0, Lp - L), (0, 0)))

    o, lse = banded_attention(split(q)[:, :, None], split(k), split(v), window // dil, dil, slopes[:, None])
    o = o[:, :, 0, :L].reshape(b, dil, h, L, e).transpose(0, 2, 3, 1, 4).reshape(b, h, s, e)
    lse = lse[:, :, 0, :L].reshape(b, dil, h, L).transpose(0, 2, 3, 1).reshape(b, h, s)
    return o, lse


def dilated_attention(q, k, v, slopes):
    res = [dilated_branch(q, k, v, w, d, slopes) for (w, d) in DIL_BRANCHES]
    outs = jnp.stack([r[0] for r in res]).astype(F32)
    wts = jax.nn.softmax(jnp.stack([r[1] for r in res]), axis=0)
    return jnp.einsum("rbhs,rbhse->bhse", wts, outs).astype(q.dtype)


def even_mixer(hn, w_in, b_f, w_out, dil_slopes):
    zq, zk, zv, zf, dq, dk, dv = split_cols(hn @ w_in, EVEN_SPLIT)
    log_f = jax.nn.log_sigmoid((zf + b_f).astype(F32)).transpose(0, 2, 1)
    o_a = forgetting_attention(to_heads(zq, FOX_HEADS), to_heads(zk, FOX_HEADS), to_heads(zv, FOX_HEADS), log_f)
    o_b = dilated_attention(to_heads(dq, DIL_HEADS), to_heads(dk, DIL_HEADS), to_heads(dv, DIL_HEADS), dil_slopes)
    o = jnp.concatenate([o_a, o_b.astype(o_a.dtype)], axis=1)
    return from_heads(o) @ w_out


def odd_mixer(hn, w_in, q_norm, kv_norm, w_uq, w_ukv, sinks, w_out, cos, sin, swa_slopes):
    b, s, _ = hn.shape
    c_q, c_kv, k_pe, q_s, k_s, v_s = split_cols(hn @ w_in, ODD_SPLIT)
    q = to_heads(rmsnorm(c_q, q_norm) @ w_uq, MLA_HEADS)
    q_nope, q_pe = q[..., :MLA_NOPE], apply_rope(q[..., MLA_NOPE:], cos, sin)
    kv = to_heads(rmsnorm(c_kv, kv_norm) @ w_ukv, MLA_HEADS)
    k_nope, v_c = kv[..., :MLA_NOPE], kv[..., MLA_NOPE:]
    k_pe = apply_rope(k_pe, cos, sin)
    scale = (MLA_NOPE + MLA_ROPE) ** -0.5

    def mla_scores(i):
        qn = lax.dynamic_slice_in_dim(q_nope, i * BLK, BLK, axis=2)
        qp = lax.dynamic_slice_in_dim(q_pe, i * BLK, BLK, axis=2)
        sc = jnp.einsum("bhqe,bhke->bhqk", qn, k_nope, preferred_element_type=F32)
        sc = sc + jnp.einsum("bhqr,bkr->bhqk", qp, k_pe, preferred_element_type=F32)
        return sc * scale

    o_c = causal_block_sweep(mla_scores, v_c)
    grp = SWA_Q_HEADS // SWA_KV_HEADS
    qd = to_heads(q_s, SWA_Q_HEADS).reshape(b, SWA_KV_HEADS, grp, s, HEAD_DIM)
    o_d, _ = banded_attention(qd, to_heads(k_s, SWA_KV_HEADS), to_heads(v_s, SWA_KV_HEADS),
                              SWA_WINDOW - 1, 1, swa_slopes, sinks.reshape(SWA_KV_HEADS, grp))
    o_d = o_d.reshape(b, SWA_Q_HEADS, s, HEAD_DIM)
    o = jnp.concatenate([o_c, o_d.astype(o_c.dtype)], axis=1)
    return from_heads(o) @ w_out


def hierarchical_moe(hn, w_group, b_group, w_router, b_router, w_gate, w_up, w_down):
    b, s, d = hn.shape
    t = hn.reshape(-1, d)
    g_logits = (t @ w_group + b_group).astype(F32)
    g_prob = jax.nn.softmax(g_logits, axis=-1)
    g_idx = jnp.argmax(g_logits, axis=-1)
    g_w = jnp.take_along_axis(g_prob, g_idx[:, None], axis=-1)[:, 0]
    e_logits = (t @ w_router + b_router).astype(F32).reshape(-1, N_GROUPS, EXPERTS_PER_GROUP)
    e_sel = jnp.take_along_axis(e_logits, g_idx[:, None, None], axis=1)[:, 0]
    top_v, top_i = lax.top_k(e_sel, EXPERT_TOPK)
    top_w = jax.nn.softmax(top_v, axis=-1) * g_w[:, None]
    expert_id = g_idx[:, None] * EXPERTS_PER_GROUP + top_i
    gates = jnp.sum(jax.nn.one_hot(expert_id, N_EXPERTS, dtype=F32) * top_w[..., None], axis=1)
    gates = gates.reshape(-1, N_GROUPS, EXPERTS_PER_GROUP)
    y = jnp.zeros((t.shape[0], d), F32)
    for grp in range(N_GROUPS):
        a = jnp.einsum("nd,edf->nef", t, w_gate[grp])
        u = jnp.einsum("nd,edf->nef", t, w_up[grp])
        act = jax.nn.silu(a) * u * gates[:, grp, :, None]
        y = y + jnp.einsum("nef,efd->nd", act, w_down[grp])
    return y.reshape(b, s, d).astype(hn.dtype)


def setup_inputs(seed: int = 0) -> dict:
    key = jax.random.key(seed)
    ks = jax.random.split(key, 24)

    def nrm(k, shape, scale):
        return scale * jax.random.normal(k, shape, F32)

    def gain(k, shape):
        return 1.0 + 0.01 * jax.random.normal(k, shape, F32)

    return {
        "x": nrm(ks[0], (BATCH, SEQ, D_MODEL), 1.0),
        "attn_norm": gain(ks[1], (DEPTH, D_MODEL)),
        "ffn_norm": gain(ks[2], (DEPTH, D_MODEL)),
        "final_norm": gain(ks[3], (D_MODEL,)),
        "e_w_in": nrm(ks[4], (N_EVEN, D_MODEL, EVEN_IN), D_MODEL ** -0.5),
        "e_b_f": jax.random.uniform(ks[5], (N_EVEN, FOX_HEADS), F32, 1.0, 4.0),
        "e_w_out": nrm(ks[6], (N_EVEN, EVEN_MIX, D_MODEL), EVEN_MIX ** -0.5),
        "o_w_in": nrm(ks[7], (N_ODD, D_MODEL, ODD_IN), D_MODEL ** -0.5),
        "o_q_norm": gain(ks[8], (N_ODD, MLA_Q_RANK)),
        "o_kv_norm": gain(ks[9], (N_ODD, MLA_KV_RANK)),
        "o_w_uq": nrm(ks[10], (N_ODD, MLA_Q_RANK, MLA_HEADS * (MLA_NOPE + MLA_ROPE)), MLA_Q_RANK ** -0.5),
        "o_w_ukv": nrm(ks[11], (N_ODD, MLA_KV_RANK, MLA_HEADS * (MLA_NOPE + MLA_V)), MLA_KV_RANK ** -0.5),
        "o_sinks": nrm(ks[12], (N_ODD, SWA_Q_HEADS), 1.0),
        "o_w_out": nrm(ks[13], (N_ODD, ODD_MIX, D_MODEL), ODD_MIX ** -0.5),
        "moe_w_group": nrm(ks[14], (DEPTH, D_MODEL, N_GROUPS), D_MODEL ** -0.5),
        "moe_b_group": nrm(ks[15], (DEPTH, N_GROUPS), 0.01),
        "moe_w_router": nrm(ks[16], (DEPTH, D_MODEL, N_EXPERTS), D_MODEL ** -0.5),
        "moe_b_router": nrm(ks[17], (DEPTH, N_EXPERTS), 0.01),
        "moe_w_gate": nrm(ks[18], (DEPTH, N_GROUPS, EXPERTS_PER_GROUP, D_MODEL, D_EXPERT), D_MODEL ** -0.5),
        "moe_w_up": nrm(ks[19], (DEPTH, N_GROUPS, EXPERTS_PER_GROUP, D_MODEL, D_EXPERT), D_MODEL ** -0.5),
        "moe_w_down": nrm(ks[20], (DEPTH, N_GROUPS, EXPERTS_PER_GROUP, D_EXPERT, D_MODEL), D_EXPERT ** -0.5),
    }


def reference(x, attn_norm, ffn_norm, final_norm, e_w_in, e_b_f, e_w_out, o_w_in, o_q_norm, o_kv_norm,
              o_w_uq, o_w_ukv, o_sinks, o_w_out, moe_w_group, moe_b_group, moe_w_router, moe_b_router,
              moe_w_gate, moe_w_up, moe_w_down):
    s = x.shape[1]
    cos, sin = rope_tables(s)
    dil_slopes = alibi_slopes(DIL_HEADS)
    swa_slopes = alibi_slopes(SWA_Q_HEADS).reshape(SWA_KV_HEADS, SWA_Q_HEADS // SWA_KV_HEADS)
    h = x
    for layer in range(DEPTH):
        hn = rmsnorm(h, attn_norm[layer])
        if layer % 2 == 0:
            i = layer // 2
            h = h + even_mixer(hn, e_w_in[i], e_b_f[i], e_w_out[i], dil_slopes)
        else:
            i = layer // 2
            h = h + odd_mixer(hn, o_w_in[i], o_q_norm[i], o_kv_norm[i], o_w_uq[i], o_w_ukv[i], o_sinks[i],
                              o_w_out[i], cos, sin, swa_slopes)
        h = h + hierarchical_moe(rmsnorm(h, ffn_norm[layer]), moe_w_group[layer], moe_b_group[layer],
                                 moe_w_router[layer], moe_b_router[layer], moe_w_gate[layer],
                                 moe_w_up[layer], moe_w_down[layer])
    return rmsnorm(h, final_norm)
```

```cpp
#include <hip/hip_runtime.h>
#include <cstdio>
#include <cstdint>
#include <cmath>

namespace nv {
constexpr int B = 4, S = 4096, D = 1024, N = B * S;
constexpr int EVEN_IN = 3080, ODD_IN = 1440;
constexpr float EPS = 1e-6f;

__device__ __forceinline__ float block_sum256(float v, float* red) {
#pragma unroll
    for (int o = 32; o > 0; o >>= 1) v += __shfl_xor(v, o);
    const int w = threadIdx.x >> 6;
    __syncthreads();
    if ((threadIdx.x & 63) == 0) red[w] = v;
    __syncthreads();
    return red[0] + red[1] + red[2] + red[3];
}

__global__ void rmsnorm_rows(const float* __restrict__ x, const float* __restrict__ g, float* __restrict__ y) {
    __shared__ float red[4];
    const size_t row = blockIdx.x; const float4 v = ((const float4*)(x + row * D))[threadIdx.x];
    const float ss = block_sum256(v.x * v.x + v.y * v.y + v.z * v.z + v.w * v.w, red);
    const float r = 1.0f / sqrtf(ss * (1.0f / D) + EPS); const float4 gg = ((const float4*)g)[threadIdx.x];
    ((float4*)(y + row * D))[threadIdx.x] = make_float4(v.x * r * gg.x, v.y * r * gg.y, v.z * r * gg.z, v.w * r * gg.w);
}
__global__ void rmsnorm_sub(const float* x, int ldx, const float* __restrict__ g, float* y, int ldy, int C) {
    const size_t row = blockIdx.x; float ss = 0.f;
    for (int c = threadIdx.x; c < C; c += 64) { const float v = x[row * ldx + c]; ss += v * v; }
#pragma unroll
    for (int o = 32; o > 0; o >>= 1) ss += __shfl_xor(ss, o);
    const float r = 1.0f / sqrtf(ss / (float)C + EPS);
    for (int c = threadIdx.x; c < C; c += 64) y[row * ldy + c] = x[row * ldx + c] * r * g[c];
}

__global__ void __launch_bounds__(256) gemm_f32(const float* __restrict__ A, int lda, const float* __restrict__ Bm, int ldb, float* C, int ldc,
                                                int M, int Nn, int K, const float* R, int ldr) {
    __shared__ float As[16][65], Bs[16][65];
    const int tx = threadIdx.x & 15, ty = threadIdx.x >> 4, m0 = blockIdx.y * 64, n0 = blockIdx.x * 64;
    float acc[4][4] = {};
    for (int k0 = 0; k0 < K; k0 += 16) {
#pragma unroll
        for (int i = 0; i < 4; ++i) { const int e = threadIdx.x + 256 * i, r = e >> 4, c = e & 15; As[c][r] = A[(size_t)(m0 + r) * lda + k0 + c]; }
#pragma unroll
        for (int i = 0; i < 4; ++i) { const int e = threadIdx.x + 256 * i, r = e >> 6, c = e & 63; Bs[r][c] = (n0 + c < Nn) ? Bm[(size_t)(k0 + r) * ldb + n0 + c] : 0.f; }
        __syncthreads();
#pragma unroll
        for (int k = 0; k < 16; ++k) { float a[4], b[4];
#pragma unroll
            for (int i = 0; i < 4; ++i) { a[i] = As[k][ty * 4 + i]; b[i] = Bs[k][tx * 4 + i]; }
#pragma unroll
            for (int i = 0; i < 4; ++i)
#pragma unroll
                for (int j = 0; j < 4; ++j) acc[i][j] += a[i] * b[j]; }
        __syncthreads();
    }
#pragma unroll
    for (int i = 0; i < 4; ++i)
#pragma unroll
        for (int j = 0; j < 4; ++j) { const int r = m0 + ty * 4 + i, c = n0 + tx * 4 + j; if (c < Nn) { float v = acc[i][j]; if (R) v += R[(size_t)r * ldr + c]; C[(size_t)r * ldc + c] = v; } }
}

__global__ void fox_cumsum(const float* __restrict__ z, const float* __restrict__ bf, float* __restrict__ c) {
    __shared__ float part[256];
    const int b = blockIdx.x >> 3, h = blockIdx.x & 7, t = threadIdx.x; float loc[16]; float run = 0.f;
#pragma unroll
    for (int i = 0; i < 16; ++i) { const int s = t * 16 + i; const float x = z[(size_t)(b * S + s) * EVEN_IN + 1536 + h] + bf[h];
        const float ls = fminf(x, 0.f) - log1pf(expf(-fabsf(x))); run += ls; loc[i] = run; }
    part[t] = run; __syncthreads();
    float off = 0.f; for (int i = 0; i < t; ++i) off += part[i];
#pragma unroll
    for (int i = 0; i < 16; ++i) c[(size_t)(b * 8 + h) * S + t * 16 + i] = loc[i] + off;
}

#define NV_STEP(sval, vptr, DV) do { const float s_ = (sval); if (s_ > m) { const float f_ = __expf(m - s_); l *= f_; _Pragma("unroll") for (int d = 0; d < DV; ++d) o[d] *= f_; m = s_; } \
        const float p_ = __expf(s_ - m); l += p_; _Pragma("unroll") for (int d = 0; d < DV; ++d) o[d] += p_ * (vptr)[d]; } while (0)

__global__ void __launch_bounds__(64) fox_attn(const float* __restrict__ z, const float* __restrict__ cb, float* __restrict__ out) {
    const int b = blockIdx.z, h = blockIdx.y, i = blockIdx.x * 64 + threadIdx.x;
    const float* zr = z + (size_t)(b * S + i) * EVEN_IN + h * 64; float q[64], o[64];
#pragma unroll
    for (int d = 0; d < 64; ++d) { q[d] = zr[d] * 0.125f; o[d] = 0.f; }
    const float* c = cb + (size_t)(b * 8 + h) * S; const float ci = c[i]; float m = -1e30f, l = 0.f;
    const int jmax = blockIdx.x * 64 + 63;
    for (int j = 0; j <= jmax; ++j) {
        const float* kr = z + (size_t)(b * S + j) * EVEN_IN + 512 + h * 64; const float* vr = kr + 512;
        float s = 0.f;
#pragma unroll
        for (int d = 0; d < 64; ++d) s += q[d] * kr[d];
        s += ci - c[j];
        if (j <= i) NV_STEP(s, vr, 64);
    }
    float* orow = out + (size_t)(b * S + i) * D + h * 64; const float il = 1.f / l;
#pragma unroll
    for (int d = 0; d < 64; ++d) orow[d] = o[d] * il;
}
__global__ void __launch_bounds__(64) dil_attn(const float* __restrict__ z, float* __restrict__ out) {
    const int b = blockIdx.z, h = blockIdx.y, i = blockIdx.x * 64 + threadIdx.x;
    const float* zr = z + (size_t)(b * S + i) * EVEN_IN + 1544 + h * 64; float q[64], o[64];
#pragma unroll
    for (int d = 0; d < 64; ++d) { q[d] = zr[d] * 0.125f; o[d] = 0.f; }
    const float slope = exp2f(-(float)(h + 1)); float m = -1e30f, l = 0.f;
    for (int br = 0; br < 3; ++br) { const int dil = br == 0 ? 1 : (br == 1 ? 4 : 16);
        for (int t = 0; t <= 128; ++t) { const int j = i - t * dil; if (j < 0) break;
            const float* kr = z + (size_t)(b * S + j) * EVEN_IN + 1544 + 512 + h * 64; const float* vr = kr + 512;
            float s = 0.f;
#pragma unroll
            for (int d = 0; d < 64; ++d) s += q[d] * kr[d];
            s -= slope * (float)(t * dil);
            NV_STEP(s, vr, 64); } }
    float* orow = out + (size_t)(b * S + i) * D + 512 + h * 64; const float il = 1.f / l;
#pragma unroll
    for (int d = 0; d < 64; ++d) orow[d] = o[d] * il;
}
__global__ void rope32(float* __restrict__ x, int ld, int nh, int hs, int off) {
    const int idx = blockIdx.x * blockDim.x + threadIdx.x; if (idx >= N * nh * 16) return;
    const int i = idx & 15, hh = (idx >> 4) % nh, n = idx / (16 * nh), pos = n % S;
    const float inv = powf(10000.0f, -(float)(2 * i) / 32.0f), ang = (float)pos * inv; float sn, cs; sincosf(ang, &sn, &cs);
    float* p = x + (size_t)n * ld + hh * hs + off; const float t1 = p[i], t2 = p[i + 16];
    p[i] = t1 * cs - t2 * sn; p[i + 16] = t1 * sn + t2 * cs;
}
__global__ void __launch_bounds__(64) mla_attn(const float* __restrict__ qb, const float* __restrict__ kv, const float* __restrict__ z1, float* __restrict__ out) {
    const int b = blockIdx.z, h = blockIdx.y, i = blockIdx.x * 64 + threadIdx.x; const float sc = 0.10206207261596575f;
    const float* qr = qb + (size_t)(b * S + i) * 768 + h * 96; float q[96], o[64];
#pragma unroll
    for (int d = 0; d < 96; ++d) q[d] = qr[d] * sc;
#pragma unroll
    for (int d = 0; d < 64; ++d) o[d] = 0.f;
    float m = -1e30f, l = 0.f; const int jmax = blockIdx.x * 64 + 63;
    for (int j = 0; j <= jmax; ++j) {
        const float* kr = kv + (size_t)(b * S + j) * 1024 + h * 128; const float* vr = kr + 64; const float* pr = z1 + (size_t)(b * S + j) * ODD_IN + 640;
        float s = 0.f;
#pragma unroll
        for (int d = 0; d < 64; ++d) s += q[d] * kr[d];
#pragma unroll
        for (int d = 0; d < 32; ++d) s += q[64 + d] * pr[d];
        if (j <= i) NV_STEP(s, vr, 64);
    }
    float* orow = out + (size_t)(b * S + i) * D + h * 64; const float il = 1.f / l;
#pragma unroll
    for (int d = 0; d < 64; ++d) orow[d] = o[d] * il;
}
__global__ void __launch_bounds__(64) swa_attn(const float* __restrict__ z1, const float* __restrict__ sinks, float* __restrict__ out) {
    const int b = blockIdx.z, h = blockIdx.y, i = blockIdx.x * 64 + threadIdx.x, kvh = h >> 2;
    const float* qr = z1 + (size_t)(b * S + i) * ODD_IN + 672 + h * 64; float q[64], o[64];
#pragma unroll
    for (int d = 0; d < 64; ++d) { q[d] = qr[d] * 0.125f; o[d] = 0.f; }
    const float slope = exp2f(-(float)(h + 1)); float m = -1e30f, l = 0.f;
    for (int t = 0; t <= 127; ++t) { const int j = i - t; if (j < 0) break;
        const float* kr = z1 + (size_t)(b * S + j) * ODD_IN + 1184 + kvh * 64; const float* vr = kr + 128;
        float s = 0.f;
#pragma unroll
        for (int d = 0; d < 64; ++d) s += q[d] * kr[d];
        s -= slope * (float)t;
        NV_STEP(s, vr, 64); }
    const float sk = sinks[h]; const float mm = fmaxf(m, sk); const float f = __expf(m - mm); l = l * f + __expf(sk - mm);
    float* orow = out + (size_t)(b * S + i) * D + 512 + h * 64; const float il = f / l;
#pragma unroll
    for (int d = 0; d < 64; ++d) orow[d] = o[d] * il;
}
__global__ void __launch_bounds__(256) moe_token(float* __restrict__ h, const float* __restrict__ g, const float* __restrict__ wg, const float* __restrict__ bg,
                                                 const float* __restrict__ wr, const float* __restrict__ br, const float* __restrict__ wgate, const float* __restrict__ wup, const float* __restrict__ wdown) {
    __shared__ float hn[D]; __shared__ float red[4]; __shared__ float logit[36]; __shared__ float act[256]; __shared__ int sel[2]; __shared__ float selw[2];
    const size_t row = blockIdx.x; const int t = threadIdx.x; float* hr = h + row * D;
    const float4 v = ((const float4*)hr)[t];
    const float ss = block_sum256(v.x * v.x + v.y * v.y + v.z * v.z + v.w * v.w, red);
    const float r = 1.0f / sqrtf(ss * (1.0f / D) + EPS); const float4 gg = ((const float4*)g)[t];
    hn[4 * t] = v.x * r * gg.x; hn[4 * t + 1] = v.y * r * gg.y; hn[4 * t + 2] = v.z * r * gg.z; hn[4 * t + 3] = v.w * r * gg.w;
    __syncthreads();
    if (t < 36) { float a = 0.f; if (t < 4) { for (int k = 0; k < D; ++k) a += hn[k] * wg[k * 4 + t]; a += bg[t]; } else { const int e = t - 4; for (int k = 0; k < D; ++k) a += hn[k] * wr[k * 32 + e]; a += br[e]; } logit[t] = a; }
    __syncthreads();
    if (t == 0) { int gi = 0; float gm = logit[0]; for (int i = 1; i < 4; ++i) if (logit[i] > gm) { gm = logit[i]; gi = i; }
        float den = 0.f; for (int i = 0; i < 4; ++i) den += expf(logit[i] - gm); const float gw = 1.0f / den;
        const float* el = logit + 4 + gi * 8; int i1 = 0; float v1 = el[0]; for (int i = 1; i < 8; ++i) if (el[i] > v1) { v1 = el[i]; i1 = i; }
        int i2 = -1; float v2 = -INFINITY; for (int i = 0; i < 8; ++i) if (i != i1 && el[i] > v2) { v2 = el[i]; i2 = i; }
        const float e2 = expf(v2 - v1); const float w1 = 1.0f / (1.0f + e2), w2 = e2 / (1.0f + e2);
        sel[0] = gi * 8 + i1; sel[1] = gi * 8 + i2; selw[0] = w1 * gw; selw[1] = w2 * gw; }
    __syncthreads();
    float y[4] = {0.f, 0.f, 0.f, 0.f};
    for (int s = 0; s < 2; ++s) { const int e = sel[s]; const float w = selw[s];
        const float* G = wgate + (size_t)e * D * 256; const float* U = wup + (size_t)e * D * 256; const float* Dn = wdown + (size_t)e * 256 * D;
        float a = 0.f, u = 0.f;
        for (int k = 0; k < D; ++k) { const float x = hn[k]; a += x * G[k * 256 + t]; u += x * U[k * 256 + t]; }
        __syncthreads();
        act[t] = a / (1.0f + __expf(-a)) * u * w;
        __syncthreads();
        for (int f = 0; f < 256; ++f) { const float av = act[f]; const float* dr = Dn + (size_t)f * D;
#pragma unroll
            for (int j = 0; j < 4; ++j) y[j] += av * dr[t + 256 * j]; } }
#pragma unroll
    for (int j = 0; j < 4; ++j) hr[t + 256 * j] += y[j];
}
}

extern "C" void kernel_launch(void* const* d_in, const int* in_sizes, int n_in, void* d_out, int out_size, void* d_ws, size_t ws_size, hipStream_t stream) {
    using namespace nv;
    const float* x = (const float*)d_in[0]; const float* attn_norm = (const float*)d_in[1]; const float* ffn_norm = (const float*)d_in[2]; const float* final_norm = (const float*)d_in[3];
    const float* e_w_in = (const float*)d_in[4]; const float* e_b_f = (const float*)d_in[5]; const float* e_w_out = (const float*)d_in[6]; const float* o_w_in = (const float*)d_in[7];
    const float* o_q_norm = (const float*)d_in[8]; const float* o_kv_norm = (const float*)d_in[9]; const float* o_w_uq = (const float*)d_in[10]; const float* o_w_ukv = (const float*)d_in[11];
    const float* o_sinks = (const float*)d_in[12]; const float* o_w_out = (const float*)d_in[13]; const float* w_group = (const float*)d_in[14]; const float* b_group = (const float*)d_in[15];
    const float* w_router = (const float*)d_in[16]; const float* b_router = (const float*)d_in[17]; const float* w_gate = (const float*)d_in[18]; const float* w_up = (const float*)d_in[19]; const float* w_down = (const float*)d_in[20];
    float* ws = (float*)d_ws; float* out = (float*)d_out;
    const size_t MF = 1u << 20;
    float* H = ws;
    float* Z = ws + 16 * MF;
    float* CB = ws + 16 * MF + (size_t)N * 3080;
    float* Z1 = Z; float* Q1 = Z1 + (size_t)N * ODD_IN; float* KV = Q1 + (size_t)N * 768;
    float* T = out;
    if (ws_size < (size_t)(16 * MF + (size_t)N * 3080 + 131072) * 4) { fprintf(stderr, "workspace too small\n"); return; }
    rmsnorm_rows<<<N, 256, 0, stream>>>(x, attn_norm, T);
    gemm_f32<<<dim3((EVEN_IN + 63) / 64, N / 64), 256, 0, stream>>>(T, D, e_w_in, EVEN_IN, Z, EVEN_IN, N, EVEN_IN, D, nullptr, 0);
    fox_cumsum<<<B * 8, 256, 0, stream>>>(Z, e_b_f, CB);
    fox_attn<<<dim3(S / 64, 8, B), 64, 0, stream>>>(Z, CB, T);
    dil_attn<<<dim3(S / 64, 8, B), 64, 0, stream>>>(Z, T);
    gemm_f32<<<dim3(D / 64, N / 64), 256, 0, stream>>>(T, D, e_w_out, D, H, D, N, D, D, x, D);
    moe_token<<<N, 256, 0, stream>>>(H, ffn_norm, w_group, b_group, w_router, b_router, w_gate, w_up, w_down);
    rmsnorm_rows<<<N, 256, 0, stream>>>(H, attn_norm + D, T);
    gemm_f32<<<dim3((ODD_IN + 63) / 64, N / 64), 256, 0, stream>>>(T, D, o_w_in, ODD_IN, Z1, ODD_IN, N, ODD_IN, D, nullptr, 0);
    rmsnorm_sub<<<N, 64, 0, stream>>>(Z1, ODD_IN, o_q_norm, Z1, ODD_IN, 384);
    rmsnorm_sub<<<N, 64, 0, stream>>>(Z1 + 384, ODD_IN, o_kv_norm, Z1 + 384, ODD_IN, 256);
    gemm_f32<<<dim3(768 / 64, N / 64), 256, 0, stream>>>(Z1, ODD_IN, o_w_uq, 768, Q1, 768, N, 768, 384, nullptr, 0);
    gemm_f32<<<dim3(1024 / 64, N / 64), 256, 0, stream>>>(Z1 + 384, ODD_IN, o_w_ukv, 1024, KV, 1024, N, 1024, 256, nullptr, 0);
    rope32<<<(N * 8 * 16 + 255) / 256, 256, 0, stream>>>(Q1, 768, 8, 96, 64);
    rope32<<<(N * 16 + 255) / 256, 256, 0, stream>>>(Z1, ODD_IN, 1, 0, 640);
    mla_attn<<<dim3(S / 64, 8, B), 64, 0, stream>>>(Q1, KV, Z1, T);
    swa_attn<<<dim3(S / 64, 8, B), 64, 0, stream>>>(Z1, o_sinks, T);
    gemm_f32<<<dim3(D / 64, N / 64), 256, 0, stream>>>(T, D, o_w_out, D, H, D, N, D, D, H, D);
    moe_token<<<N, 256, 0, stream>>>(H, ffn_norm + D, w_group + D * 4, b_group + 4, w_router + D * 32, b_router + 32, w_gate + (size_t)32 * D * 256, w_up + (size_t)32 * D * 256, w_down + (size_t)32 * 256 * D);
    rmsnorm_rows<<<N, 256, 0, stream>>>(H, final_norm, out);
}
```

```cpp
#include <hip/hip_cooperative_groups.h>
#include <hip/hip_runtime.h>
#include <cstdio>
#include <cstdint>
#include <cmath>

namespace nv {
constexpr int B = 4, S = 4096, D = 1024, N = B * S;
constexpr int EVEN_IN = 3080, ODD_IN = 1440;
constexpr float EPS = 1e-6f;

__device__ __forceinline__ float block_sum256(float v, float* red) {
#pragma unroll
    for (int o = 32; o > 0; o >>= 1) v += __shfl_xor(v, o);
    const int w = threadIdx.x >> 6;
    __syncthreads();
    if ((threadIdx.x & 63) == 0) red[w] = v;
    __syncthreads();
    return red[0] + red[1] + red[2] + red[3];
}

__global__ void rmsnorm_rows(const float* __restrict__ x, const float* __restrict__ g, float* __restrict__ y) {
    __shared__ float red[4];
    const size_t row = blockIdx.x; const float4 v = ((const float4*)(x + row * D))[threadIdx.x];
    const float ss = block_sum256(v.x * v.x + v.y * v.y + v.z * v.z + v.w * v.w, red);
    const float r = 1.0f / sqrtf(ss * (1.0f / D) + EPS); const float4 gg = ((const float4*)g)[threadIdx.x];
    ((float4*)(y + row * D))[threadIdx.x] = make_float4(v.x * r * gg.x, v.y * r * gg.y, v.z * r * gg.z, v.w * r * gg.w);
}
__global__ void rmsnorm_sub(const float* x, int ldx, const float* __restrict__ g, float* y, int ldy, int C) {
    const size_t row = blockIdx.x; float ss = 0.f;
    for (int c = threadIdx.x; c < C; c += 64) { const float v = x[row * ldx + c]; ss += v * v; }
#pragma unroll
    for (int o = 32; o > 0; o >>= 1) ss += __shfl_xor(ss, o);
    const float r = 1.0f / sqrtf(ss / (float)C + EPS);
    for (int c = threadIdx.x; c < C; c += 64) y[row * ldy + c] = x[row * ldx + c] * r * g[c];
}

__global__ void __launch_bounds__(256) gemm_f32(const float* __restrict__ A, int lda, const float* __restrict__ Bm, int ldb, float* C, int ldc,
                                                int M, int Nn, int K, const float* R, int ldr) {
    __shared__ float As[16][65], Bs[16][65];
    const int tx = threadIdx.x & 15, ty = threadIdx.x >> 4, m0 = blockIdx.y * 64, n0 = blockIdx.x * 64;
    float acc[4][4] = {};
    for (int k0 = 0; k0 < K; k0 += 16) {
#pragma unroll
        for (int i = 0; i < 4; ++i) { const int e = threadIdx.x + 256 * i, r = e >> 4, c = e & 15; As[c][r] = A[(size_t)(m0 + r) * lda + k0 + c]; }
#pragma unroll
        for (int i = 0; i < 4; ++i) { const int e = threadIdx.x + 256 * i, r = e >> 6, c = e & 63; Bs[r][c] = (n0 + c < Nn) ? Bm[(size_t)(k0 + r) * ldb + n0 + c] : 0.f; }
        __syncthreads();
#pragma unroll
        for (int k = 0; k < 16; ++k) { float a[4], b[4];
#pragma unroll
            for (int i = 0; i < 4; ++i) { a[i] = As[k][ty * 4 + i]; b[i] = Bs[k][tx * 4 + i]; }
#pragma unroll
            for (int i = 0; i < 4; ++i)
#pragma unroll
                for (int j = 0; j < 4; ++j) acc[i][j] += a[i] * b[j]; }
        __syncthreads();
    }
#pragma unroll
    for (int i = 0; i < 4; ++i)
#pragma unroll
        for (int j = 0; j < 4; ++j) { const int r = m0 + ty * 4 + i, c = n0 + tx * 4 + j; if (c < Nn) { float v = acc[i][j]; if (R) v += R[(size_t)r * ldr + c]; C[(size_t)r * ldc + c] = v; } }
}

__global__ void fox_cumsum(const float* __restrict__ z, const float* __restrict__ bf, float* __restrict__ c) {
    __shared__ float part[256];
    const int b = blockIdx.x >> 3, h = blockIdx.x & 7, t = threadIdx.x; float loc[16]; float run = 0.f;
#pragma unroll
    for (int i = 0; i < 16; ++i) { const int s = t * 16 + i; const float x = z[(size_t)(b * S + s) * EVEN_IN + 1536 + h] + bf[h];
        const float ls = fminf(x, 0.f) - log1pf(expf(-fabsf(x))); run += ls; loc[i] = run; }
    part[t] = run; __syncthreads();
    float off = 0.f; for (int i = 0; i < t; ++i) off += part[i];
#pragma unroll
    for (int i = 0; i < 16; ++i) c[(size_t)(b * 8 + h) * S + t * 16 + i] = loc[i] + off;
}

#define NV_STEP(sval, vptr, DV) do { const float s_ = (sval); if (s_ > m) { const float f_ = __expf(m - s_); l *= f_; _Pragma("unroll") for (int d = 0; d < DV; ++d) o[d] *= f_; m = s_; } \
        const float p_ = __expf(s_ - m); l += p_; _Pragma("unroll") for (int d = 0; d < DV; ++d) o[d] += p_ * (vptr)[d]; } while (0)

__global__ void __launch_bounds__(64) fox_attn(const float* __restrict__ z, const float* __restrict__ cb, float* __restrict__ out) {
    const int b = blockIdx.z, h = blockIdx.y, i = blockIdx.x * 64 + threadIdx.x;
    const float* zr = z + (size_t)(b * S + i) * EVEN_IN + h * 64; float q[64], o[64];
#pragma unroll
    for (int d = 0; d < 64; ++d) { q[d] = zr[d] * 0.125f; o[d] = 0.f; }
    const float* c = cb + (size_t)(b * 8 + h) * S; const float ci = c[i]; float m = -1e30f, l = 0.f;
    const int jmax = blockIdx.x * 64 + 63;
    for (int j = 0; j <= jmax; ++j) {
        const float* kr = z + (size_t)(b * S + j) * EVEN_IN + 512 + h * 64; const float* vr = kr + 512;
        float s = 0.f;
#pragma unroll
        for (int d = 0; d < 64; ++d) s += q[d] * kr[d];
        s += ci - c[j];
        if (j <= i) NV_STEP(s, vr, 64);
    }
    float* orow = out + (size_t)(b * S + i) * D + h * 64; const float il = 1.f / l;
#pragma unroll
    for (int d = 0; d < 64; ++d) orow[d] = o[d] * il;
}
__global__ void __launch_bounds__(64) dil_attn(const float* __restrict__ z, float* __restrict__ out) {
    const int b = blockIdx.z, h = blockIdx.y, i = blockIdx.x * 64 + threadIdx.x;
    const float* zr = z + (size_t)(b * S + i) * EVEN_IN + 1544 + h * 64; float q[64], o[64];
#pragma unroll
    for (int d = 0; d < 64; ++d) { q[d] = zr[d] * 0.125f; o[d] = 0.f; }
    const float slope = exp2f(-(float)(h + 1)); float m = -1e30f, l = 0.f;
    for (int br = 0; br < 3; ++br) { const int dil = br == 0 ? 1 : (br == 1 ? 4 : 16);
        for (int t = 0; t <= 128; ++t) { const int j = i - t * dil; if (j < 0) break;
            const float* kr = z + (size_t)(b * S + j) * EVEN_IN + 1544 + 512 + h * 64; const float* vr = kr + 512;
            float s = 0.f;
#pragma unroll
            for (int d = 0; d < 64; ++d) s += q[d] * kr[d];
            s -= slope * (float)(t * dil);
            NV_STEP(s, vr, 64); } }
    float* orow = out + (size_t)(b * S + i) * D + 512 + h * 64; const float il = 1.f / l;
#pragma unroll
    for (int d = 0; d < 64; ++d) orow[d] = o[d] * il;
}
__global__ void rope32(float* __restrict__ x, int ld, int nh, int hs, int off) {
    const int idx = blockIdx.x * blockDim.x + threadIdx.x; if (idx >= N * nh * 16) return;
    const int i = idx & 15, hh = (idx >> 4) % nh, n = idx / (16 * nh), pos = n % S;
    const float inv = powf(10000.0f, -(float)(2 * i) / 32.0f), ang = (float)pos * inv; float sn, cs; sincosf(ang, &sn, &cs);
    float* p = x + (size_t)n * ld + hh * hs + off; const float t1 = p[i], t2 = p[i + 16];
    p[i] = t1 * cs - t2 * sn; p[i + 16] = t1 * sn + t2 * cs;
}
__global__ void __launch_bounds__(64) mla_attn(const float* __restrict__ qb, const float* __restrict__ kv, const float* __restrict__ z1, float* __restrict__ out) {
    const int b = blockIdx.z, h = blockIdx.y, i = blockIdx.x * 64 + threadIdx.x; const float sc = 0.10206207261596575f;
    const float* qr = qb + (size_t)(b * S + i) * 768 + h * 96; float q[96], o[64];
#pragma unroll
    for (int d = 0; d < 96; ++d) q[d] = qr[d] * sc;
#pragma unroll
    for (int d = 0; d < 64; ++d) o[d] = 0.f;
    float m = -1e30f, l = 0.f; const int jmax = blockIdx.x * 64 + 63;
    for (int j = 0; j <= jmax; ++j) {
        const float* kr = kv + (size_t)(b * S + j) * 1024 + h * 128; const float* vr = kr + 64; const float* pr = z1 + (size_t)(b * S + j) * ODD_IN + 640;
        float s = 0.f;
#pragma unroll
        for (int d = 0; d < 64; ++d) s += q[d] * kr[d];
#pragma unroll
        for (int d = 0; d < 32; ++d) s += q[64 + d] * pr[d];
        if (j <= i) NV_STEP(s, vr, 64);
    }
    float* orow = out + (size_t)(b * S + i) * D + h * 64; const float il = 1.f / l;
#pragma unroll
    for (int d = 0; d < 64; ++d) orow[d] = o[d] * il;
}
__global__ void __launch_bounds__(64) swa_attn(const float* __restrict__ z1, const float* __restrict__ sinks, float* __restrict__ out) {
    const int b = blockIdx.z, h = blockIdx.y, i = blockIdx.x * 64 + threadIdx.x, kvh = h >> 2;
    const float* qr = z1 + (size_t)(b * S + i) * ODD_IN + 672 + h * 64; float q[64], o[64];
#pragma unroll
    for (int d = 0; d < 64; ++d) { q[d] = qr[d] * 0.125f; o[d] = 0.f; }
    const float slope = exp2f(-(float)(h + 1)); float m = -1e30f, l = 0.f;
    for (int t = 0; t <= 127; ++t) { const int j = i - t; if (j < 0) break;
        const float* kr = z1 + (size_t)(b * S + j) * ODD_IN + 1184 + kvh * 64; const float* vr = kr + 128;
        float s = 0.f;
#pragma unroll
        for (int d = 0; d < 64; ++d) s += q[d] * kr[d];
        s -= slope * (float)t;
        NV_STEP(s, vr, 64); }
    const float sk = sinks[h]; const float mm = fmaxf(m, sk); const float f = __expf(m - mm); l = l * f + __expf(sk - mm);
    float* orow = out + (size_t)(b * S + i) * D + 512 + h * 64; const float il = f / l;
#pragma unroll
    for (int d = 0; d < 64; ++d) orow[d] = o[d] * il;
}
__global__ void __launch_bounds__(256) moe_token(float* __restrict__ h, const float* __restrict__ g, const float* __restrict__ wg, const float* __restrict__ bg,
                                                 const float* __restrict__ wr, const float* __restrict__ br, const float* __restrict__ wgate, const float* __restrict__ wup, const float* __restrict__ wdown) {
    __shared__ float hn[D]; __shared__ float red[4]; __shared__ float logit[36]; __shared__ float act[256]; __shared__ int sel[2]; __shared__ float selw[2];
    const size_t row = blockIdx.x; const int t = threadIdx.x; float* hr = h + row * D;
    const float4 v = ((const float4*)hr)[t];
    const float ss = block_sum256(v.x * v.x + v.y * v.y + v.z * v.z + v.w * v.w, red);
    const float r = 1.0f / sqrtf(ss * (1.0f / D) + EPS); const float4 gg = ((const float4*)g)[t];
    hn[4 * t] = v.x * r * gg.x; hn[4 * t + 1] = v.y * r * gg.y; hn[4 * t + 2] = v.z * r * gg.z; hn[4 * t + 3] = v.w * r * gg.w;
    __syncthreads();
    if (t < 36) { float a = 0.f; if (t < 4) { for (int k = 0; k < D; ++k) a += hn[k] * wg[k * 4 + t]; a += bg[t]; } else { const int e = t - 4; for (int k = 0; k < D; ++k) a += hn[k] * wr[k * 32 + e]; a += br[e]; } logit[t] = a; }
    __syncthreads();
    if (t == 0) { int gi = 0; float gm = logit[0]; for (int i = 1; i < 4; ++i) if (logit[i] > gm) { gm = logit[i]; gi = i; }
        float den = 0.f; for (int i = 0; i < 4; ++i) den += expf(logit[i] - gm); const float gw = 1.0f / den;
        const float* el = logit + 4 + gi * 8; int i1 = 0; float v1 = el[0]; for (int i = 1; i < 8; ++i) if (el[i] > v1) { v1 = el[i]; i1 = i; }
        int i2 = -1; float v2 = -INFINITY; for (int i = 0; i < 8; ++i) if (i != i1 && el[i] > v2) { v2 = el[i]; i2 = i; }
        const float e2 = expf(v2 - v1); const float w1 = 1.0f / (1.0f + e2), w2 = e2 / (1.0f + e2);
        sel[0] = gi * 8 + i1; sel[1] = gi * 8 + i2; selw[0] = w1 * gw; selw[1] = w2 * gw; }
    __syncthreads();
    float y[4] = {0.f, 0.f, 0.f, 0.f};
    for (int s = 0; s < 2; ++s) { const int e = sel[s]; const float w = selw[s];
        const float* G = wgate + (size_t)e * D * 256; const float* U = wup + (size_t)e * D * 256; const float* Dn = wdown + (size_t)e * 256 * D;
        float a = 0.f, u = 0.f;
        for (int k = 0; k < D; ++k) { const float x = hn[k]; a += x * G[k * 256 + t]; u += x * U[k * 256 + t]; }
        __syncthreads();
        act[t] = a / (1.0f + __expf(-a)) * u * w;
        __syncthreads();
        for (int f = 0; f < 256; ++f) { const float av = act[f]; const float* dr = Dn + (size_t)f * D;
#pragma unroll
            for (int j = 0; j < 4; ++j) y[j] += av * dr[t + 256 * j]; } }
#pragma unroll
    for (int j = 0; j < 4; ++j) hr[t + 256 * j] += y[j];
}
}

#define LAS __attribute__((address_space(3)))
#define GAS __attribute__((address_space(1)))
typedef unsigned short bf16_t;
typedef short bf16x8 __attribute__((ext_vector_type(8)));
typedef short s16x4 __attribute__((ext_vector_type(4)));
typedef float f32x2 __attribute__((ext_vector_type(2)));
typedef float f32x4 __attribute__((ext_vector_type(4)));
typedef float f32x16 __attribute__((ext_vector_type(16)));
typedef unsigned u32x2 __attribute__((ext_vector_type(2)));
typedef unsigned u32x4 __attribute__((ext_vector_type(4)));
typedef __bf16 bf16x2_t __attribute__((ext_vector_type(2)));
__device__ __forceinline__ unsigned cvtpk(float lo, float hi) { f32x2 v = {lo, hi}; bf16x2_t b = __builtin_convertvector(v, bf16x2_t); return __builtin_bit_cast(unsigned, b); }
__device__ __forceinline__ float bf2f(unsigned short u) { return __uint_as_float((unsigned)u << 16); }
__device__ __forceinline__ float bflo(unsigned u) { return __uint_as_float(u << 16); }
__device__ __forceinline__ float bfhi(unsigned u) { return __uint_as_float(u & 0xffff0000u); }

namespace pg8 {
constexpr int BM = 256, BK = 64, HALF = 128, HTB = HALF * BK * 2  , STAGE_BYTES = 8 * HTB, NXCD = 8, WGM = 8;
__host__ __device__ __forceinline__ int lds_byte(int r, int c) { const int st = (r >> 4) * 2 + (c >> 5), rr = r & 15, cc = c & 31, ob = rr * 64 + cc * 2; return st * 1024 + (ob ^ (((ob >> 9) & 1) << 5)); }
__host__ __device__ __forceinline__ void stage_rc(int b, int& R, int& C) { const int st = b / 1024, sb = b % 1024, swz = sb ^ (((sb >> 9) & 1) << 5); R = (st >> 1) * 16 + swz / 64; C = (st & 1) * 32 + (swz % 64) / 2; }
__host__ __device__ __forceinline__ int perm32(int rho) { const int n = rho >> 4, i = rho & 15; return 8 * (i >> 2) + 4 * n + (i & 3); }

struct Unit { int pm, pn, e, rt, rows; };

struct Dense {
    const bf16_t* A; const bf16_t* Bt; int lda, K; int nM, nN, nwg, G, c;
    __device__ void init(const bf16_t* A_, int lda_, const bf16_t* Bt_, int M, int N, int K_, int G_, int c_) { A = A_; lda = lda_; Bt = Bt_; K = K_; nM = M / BM; nN = N / BM; nwg = nM * nN; G = G_; c = c_; }
    __device__ __forceinline__ bool next(int i, Unit& u) const {
        const long L = (long)i * G + c; if (L >= nwg) return false;
        int wgid = (int)L; { const int q = nwg / NXCD, r = nwg % NXCD, xcd = wgid % NXCD, off = wgid / NXCD; wgid = (xcd < r ? xcd * (q + 1) : r * (q + 1) + (xcd - r) * q) + off; }
        const int nig = WGM * nN, gid = wgid / nig, fm = gid * WGM, gsz = (nM - fm) < WGM ? (nM - fm) : WGM;
        u.pm = fm + ((wgid % nig) % gsz); u.pn = (wgid % nig) / gsz; u.e = 0; u.rt = 0; u.rows = 256; return true;
    }
    __device__ __forceinline__ const char* a_base(const Unit& u) const { return (const char*)A + (size_t)u.pm * BM * lda * 2; }
    __device__ __forceinline__ const char* b_base(const Unit& u) const { return (const char*)Bt + (size_t)u.pn * BM * K * 2; }
    __device__ __forceinline__ void a_voff(const Unit&, int R0, int C0, int R1, int C1, unsigned (&vo)[2][2]) const {
        vo[0][0] = (unsigned)(R0 * lda + C0) * 2u; vo[0][1] = (unsigned)(R1 * lda + C1) * 2u; vo[1][0] = vo[0][0]; vo[1][1] = vo[0][1]; }
    __device__ __forceinline__ size_t a_hstep() const { return (size_t)HALF * lda * 2; }
};

__device__ __forceinline__ void glds_s(const char* sbase, unsigned voff, unsigned lds_dst) { unsigned keep;
    asm volatile("s_mov_b32 %0, m0\n\ts_mov_b32 m0, %2\n\ts_nop 0\n\tglobal_load_lds_dwordx4 %1, %3\n\ts_mov_b32 m0, %0" : "=&s"(keep) : "v"(voff), "s"(lds_dst), "s"(sbase) : "memory"); }
template <class Epi, class Prob, bool GATHER>
__device__ __forceinline__ void gemm_phase(LAS unsigned char* lds, const Prob& S, const Epi& E, const int tid, LAS unsigned* stash = nullptr) {
    const int wid = __builtin_amdgcn_readfirstlane(tid >> 6), lane = tid & 63, wr = wid >> 2, wc = wid & 3, fr = lane & 15, fq = lane >> 4;
    const int K = S.K, nt = K / BK;
    int R0, C0, R1, C1; stage_rc(tid * 16, R0, C0); stage_rc(tid * 16 + 8192, R1, C1);
    unsigned voffB[2];
    { const int Rb0 = Epi::PERM ? ((R0 & ~31) + perm32(R0 & 31)) : R0, Rb1 = Epi::PERM ? ((R1 & ~31) + perm32(R1 & 31)) : R1;
      voffB[0] = (unsigned)(Rb0 * K + C0) * 2u; voffB[1] = (unsigned)(Rb1 * K + C1) * 2u; }
    const size_t kstep = (size_t)(BK * 2);
    const size_t hstepB = (size_t)HALF * K * 2;
    const size_t hstepA = GATHER ? 0 : S.a_hstep();
    const unsigned ldsb = (unsigned)(uintptr_t)lds + (unsigned)wid * 1024u;
    const int aoff = lds_byte(wr * 64 + fr, fq * 8), boff = lds_byte(wc * 32 + fr, fq * 8);
#define PG8_SA(b, h) (((b) * 2 + (h)) * HTB)
#define PG8_SB(b, h) ((4 + (b) * 2 + (h)) * HTB)
#define PG8_STAGE(bufoff, gbase, voff) do { _Pragma("unroll") for (int _i = 0; _i < 2; ++_i) \
        glds_s((const char*)(gbase), (voff)[_i], ldsb + (unsigned)((bufoff) + _i * 8192)); } while (0)
#define PG8_LDA(dst, b, h) do { _Pragma("unroll") for (int m = 0; m < 4; ++m) _Pragma("unroll") for (int k = 0; k < 2; ++k) dst[m][k] = *(const LAS bf16x8*)(lds + PG8_SA(b, h) + aoff + m * 2048 + k * 1024); } while (0)
#define PG8_LDB(dst, b, h) do { _Pragma("unroll") for (int n = 0; n < 2; ++n) _Pragma("unroll") for (int k = 0; k < 2; ++k) dst[n][k] = *(const LAS bf16x8*)(lds + PG8_SB(b, h) + boff + n * 2048 + k * 1024); } while (0)
#define PG8_MMA(ai, bj, At, Bt) do { __builtin_amdgcn_s_setprio(1); _Pragma("unroll") for (int m = 0; m < 4; ++m) _Pragma("unroll") for (int n = 0; n < 2; ++n) _Pragma("unroll") for (int k = 0; k < 2; ++k) \
        acc[ai][bj][m][n] = __builtin_amdgcn_mfma_f32_16x16x32_bf16(Bt[n][k], At[m][k], acc[ai][bj][m][n], 0, 0, 0); __builtin_amdgcn_s_setprio(0); } while (0)
#define PG8_WAIT_V(n) asm volatile("s_waitcnt vmcnt(" #n ")" ::: "memory")
#define PG8_WAIT_L(n) asm volatile("s_waitcnt lgkmcnt(" #n ")" ::: "memory")
#define PG8_BAR __builtin_amdgcn_s_barrier()
#define PG8_SCHED __builtin_amdgcn_sched_barrier(0)
    Unit cur, nxt; int ui = 0;
    if (!S.next(0, cur)) return;
    bool has_next = S.next(1, nxt);
    unsigned voffA[2][2];
    S.a_voff(cur, R0, C0, R1, C1, voffA);
    LAS u32x4* const st4 = (LAS u32x4*)stash + tid;
    if (GATHER) { unsigned vn[2][2]; if (has_next) S.a_voff(nxt, R0, C0, R1, C1, vn); else { vn[0][0] = voffA[0][0]; vn[0][1] = voffA[0][1]; vn[1][0] = voffA[1][0]; vn[1][1] = voffA[1][1]; }
        *st4 = (u32x4){vn[0][0], vn[0][1], vn[1][0], vn[1][1]};
        asm volatile("s_waitcnt vmcnt(0)" : "+v"(voffA[0][0]), "+v"(voffA[0][1]), "+v"(voffA[1][0]), "+v"(voffA[1][1]) :: "memory"); }
    f32x4 acc[2][2][4][2];
#pragma unroll
    for (int a = 0; a < 2; ++a)
#pragma unroll
        for (int b = 0; b < 2; ++b)
#pragma unroll
            for (int m = 0; m < 4; ++m)
#pragma unroll
                for (int n = 0; n < 2; ++n) acc[a][b][m][n] = (f32x4){0.f, 0.f, 0.f, 0.f};
    bf16x8 At[4][2], B0[2][2], B1[2][2];
    const char* cA = S.a_base(cur); const char* cB = S.b_base(cur);
    PG8_STAGE(PG8_SB(0, 0), cB, voffB); PG8_STAGE(PG8_SB(0, 1), cB + hstepB, voffB); PG8_STAGE(PG8_SA(0, 0), cA, voffA[0]); PG8_STAGE(PG8_SA(0, 1), cA + hstepA, voffA[1]);
    if (wr == 1) PG8_BAR;
    PG8_WAIT_V(2); PG8_BAR;
    PG8_STAGE(PG8_SB(1, 0), cB + kstep, voffB); PG8_STAGE(PG8_SA(1, 0), cA + kstep, voffA[0]); PG8_STAGE(PG8_SB(1, 1), cB + hstepB + kstep, voffB);
    PG8_WAIT_V(6); PG8_BAR;
    for (;;) {
        const char* nA = has_next ? S.a_base(nxt) : cA; const char* nB = has_next ? S.b_base(nxt) : cB;
#pragma unroll 1
        for (int t = 0; t < nt; t += 2) {
            const bool last = (t == nt - 2);
            const char* a1 = cA + (size_t)(t + 1) * kstep;
            const char* a2 = last ? nA : cA + (size_t)(t + 2) * kstep; const char* b2 = last ? nB : cB + (size_t)(t + 2) * kstep;
            const char* a3 = a2 + kstep; const char* b3 = b2 + kstep;
            unsigned v20 = voffA[0][0], v21 = voffA[0][1], v30 = voffA[1][0], v31 = voffA[1][1];
            if (GATHER) { if (last) { const u32x4 n4 = *st4; v20 = n4.x; v21 = n4.y; v30 = n4.z; v31 = n4.w; } }
            const unsigned vh0[2] = {v20, v21}, vh1[2] = {v30, v31};
            PG8_LDB(B0, 0, 0); PG8_LDB(B1, 0, 1); PG8_SCHED; PG8_LDA(At, 0, 0); PG8_STAGE(PG8_SA(1, 1), a1 + hstepA, voffA[1]);
            PG8_WAIT_V(8); PG8_WAIT_L(0); PG8_BAR; PG8_MMA(0, 0, At, B0); PG8_MMA(0, 1, At, B1); PG8_BAR; PG8_SCHED;
            PG8_LDA(At, 0, 1); PG8_STAGE(PG8_SB(0, 0), b2, voffB); PG8_STAGE(PG8_SB(0, 1), b2 + hstepB, voffB); PG8_STAGE(PG8_SA(0, 0), a2, vh0);
            PG8_WAIT_V(8); PG8_WAIT_L(0); PG8_BAR; PG8_MMA(1, 0, At, B0); PG8_MMA(1, 1, At, B1); PG8_BAR; PG8_SCHED;
            PG8_LDB(B0, 1, 0); PG8_LDB(B1, 1, 1); PG8_SCHED; PG8_LDA(At, 1, 0); PG8_STAGE(PG8_SA(0, 1), a2 + hstepA, vh1);
            PG8_WAIT_V(8); PG8_WAIT_L(0); PG8_BAR; PG8_MMA(0, 0, At, B0); PG8_MMA(0, 1, At, B1); PG8_BAR; PG8_SCHED;
            PG8_LDA(At, 1, 1); PG8_STAGE(PG8_SB(1, 0), b3, voffB); PG8_STAGE(PG8_SB(1, 1), b3 + hstepB, voffB); PG8_STAGE(PG8_SA(1, 0), a3, vh0);
            PG8_WAIT_V(8); PG8_WAIT_L(0); PG8_BAR; PG8_MMA(1, 0, At, B0); PG8_MMA(1, 1, At, B1); PG8_BAR; PG8_SCHED;
        }
        if (wr == 0) PG8_BAR;
        { int fr_e = fr, fq_e = fq; asm volatile("" : "+v"(fr_e), "+v"(fq_e));
          E(acc, cur, wr, wc, fr_e, fq_e); }
        if (!has_next) break;
#pragma unroll
        for (int a = 0; a < 2; ++a)
#pragma unroll
            for (int b = 0; b < 2; ++b)
#pragma unroll
                for (int m = 0; m < 4; ++m)
#pragma unroll
                    for (int n = 0; n < 2; ++n) acc[a][b][m][n] = (f32x4){0.f, 0.f, 0.f, 0.f};
        cur = nxt; cA = nA; cB = nB; ++ui;
        has_next = S.next(ui + 1, nxt);
        if (GATHER) {
            { const u32x4 n4 = *st4; voffA[0][0] = n4.x; voffA[0][1] = n4.y; voffA[1][0] = n4.z; voffA[1][1] = n4.w; }
            if (has_next) { unsigned vn[2][2]; S.a_voff(nxt, R0, C0, R1, C1, vn);
                asm volatile("s_waitcnt vmcnt(0)" : "+v"(vn[0][0]), "+v"(vn[0][1]), "+v"(vn[1][0]), "+v"(vn[1][1]) :: "memory");
                *st4 = (u32x4){vn[0][0], vn[0][1], vn[1][0], vn[1][1]}; }
        }
        if (wr == 1) PG8_BAR;
    }
    PG8_WAIT_V(0);
    PG8_BAR;
#undef PG8_SA
#undef PG8_SB
#undef PG8_STAGE
#undef PG8_LDA
#undef PG8_LDB
#undef PG8_MMA
#undef PG8_WAIT_V
#undef PG8_WAIT_L
#undef PG8_BAR
#undef PG8_SCHED
}
}
namespace mk {
constexpr int NB = 4, S = 4096, D = 1024, N = NB * S;
constexpr float EPS = 1e-6f, LOG2E = 1.4426950408889634f;
constexpr float C2_64 = 0.125f * LOG2E, C2_96 = 0.10206207261596575f * LOG2E;
constexpr size_t MiB = 1u << 20;
constexpr size_t WS_CTL = 0, CTL_ZERO_BYTES = 1 * MiB;
constexpr size_t WS_SS = 1 * MiB;
constexpr size_t WS_RSTD = WS_SS + (size_t)N * 4;
constexpr size_t WS_SSP = WS_RSTD + (size_t)N * 4;
constexpr size_t WS_LOGF = WS_SSP + (size_t)N * 64;
constexpr size_t WS_CB2 = WS_LOGF + (size_t)N * 32;
constexpr size_t WS_ROPE = WS_CB2 + (size_t)32 * S * 4;
constexpr size_t WS_DLSE = WS_ROPE + (size_t)S * 16 * 8;
constexpr size_t WS_SSZ = WS_DLSE + (size_t)3 * N * 32;
constexpr size_t WS_LT = WS_SSZ + (size_t)N * 48;
constexpr size_t WS_LW = WS_LT + (size_t)32 * N * 4;
constexpr size_t WS_LR = WS_LW + (size_t)32 * N * 4;
constexpr size_t WS_SMALL_END = WS_LR + (size_t)32 * N * 4;
static_assert(WS_SMALL_END <= 13 * MiB, "small arrays");
constexpr size_t WS_WIN0 = 13 * MiB;
constexpr size_t WS_WOUT0 = WS_WIN0 + 6 * MiB;
constexpr size_t WS_WIN1 = WS_WOUT0 + 2 * MiB;
constexpr size_t WS_WUQ = WS_WIN1 + 3 * MiB;
constexpr size_t WS_WUKV = WS_WUQ + 768 * 384 * 2;
constexpr size_t WS_WOUT1 = WS_WUKV + 1024 * 256 * 2;
constexpr size_t WS_WR = WS_WOUT1 + 2 * MiB;
static_assert(WS_WR + 2 * 64 * 1024 * 2 <= 28 * MiB, "weights");
constexpr size_t WS_XB = 28 * MiB;
constexpr size_t WS_R1 = 60 * MiB;
constexpr size_t WS_R2 = 164 * MiB;
constexpr size_t WS_END = 244 * MiB;
constexpr size_t R1_QKV0 = WS_R1;
constexpr size_t R1_Z1 = WS_R1, R1_Q1 = WS_R1 + 48 * MiB, R1_KV1 = WS_R1 + 72 * MiB;
constexpr size_t R1_WGU = WS_R1, R1_WD = WS_R1 + 32 * MiB, R1_ACT = WS_R1 + 48 * MiB;
constexpr size_t R2_AO = WS_R2, R2_DPART = WS_R2 + 32 * MiB;
constexpr size_t R2_Y = WS_R2;
constexpr int CW_CNT = 64;
constexpr int CW_BAR = 4096;
}

namespace pg8 {
using mk::EPS;
struct EpiQkv0 {
    static constexpr bool PERM = true;
    bf16_t* O; const float* ss;
    __device__ __forceinline__ void operator()(const f32x4 (&acc)[2][2][4][2], const Unit& u, int wr, int wc, int fr, int fq) const {
        const int row0 = u.pm * BM + wr * 64 + fr, col0 = u.pn * BM + wc * 32 + 8 * fq;
        const float sc = (u.pn < 2 || u.pn == 6 || u.pn == 7) ? mk::C2_64 : 1.f;
#pragma unroll
        for (int ai = 0; ai < 2; ++ai)
#pragma unroll
            for (int m = 0; m < 4; ++m) { const int row = row0 + ai * HALF + m * 16; const float rs = sc / sqrtf(ss[row] * (1.f / 1024.f) + EPS);
                bf16_t* rowp = O + (size_t)row * 3072 + col0;
#pragma unroll
                for (int bj = 0; bj < 2; ++bj) { const f32x4 v0 = acc[ai][bj][m][0] * rs, v1 = acc[ai][bj][m][1] * rs;
                    u32x4 w; w.x = cvtpk(v0[0], v0[1]); w.y = cvtpk(v0[2], v0[3]); w.z = cvtpk(v1[0], v1[1]); w.w = cvtpk(v1[2], v1[3]);
                    *(u32x4*)(rowp + bj * HALF) = w; }
                asm volatile("" ::: "memory"); }
    }
};
struct EpiOut {
    static constexpr bool PERM = false;
    const float* R; float* H; bf16_t* HB; float* ssp;
    __device__ __forceinline__ void operator()(const f32x4 (&acc)[2][2][4][2], const Unit& u, int wr, int wc, int fr, int fq) const {
        const int row0 = u.pm * BM + wr * 64 + fr, col0 = u.pn * BM + wc * 32 + 4 * fq;
#pragma unroll
        for (int ai = 0; ai < 2; ++ai)
#pragma unroll
            for (int m = 0; m < 4; ++m) { const int row = row0 + ai * HALF + m * 16; const size_t off = (size_t)row * 1024 + col0; float q = 0.f;
#pragma unroll
                for (int bj = 0; bj < 2; ++bj)
#pragma unroll
                    for (int n = 0; n < 2; ++n) { const f32x4 v = *(const f32x4*)(R + off + bj * HALF + n * 16) + acc[ai][bj][m][n];
                        *(f32x4*)(H + off + bj * HALF + n * 16) = v; u32x2 w; w.x = cvtpk(v[0], v[1]); w.y = cvtpk(v[2], v[3]); *(u32x2*)(HB + off + bj * HALF + n * 16) = w;
                        q += (v[0] * v[0] + v[1] * v[1]) + (v[2] * v[2] + v[3] * v[3]); }
                q += __shfl_xor(q, 16); q += __shfl_xor(q, 32);
                if (fq == 0) ssp[(size_t)row * 16 + u.pn * 4 + wc] = q;
                asm volatile("" ::: "memory"); }
    }
};
struct EpiWin1 {
    static constexpr bool PERM = false;
    bf16_t* Z; const float* ss; float* ssz; const f32x2* rope;
    __device__ __forceinline__ void operator()(const f32x4 (&acc)[2][2][4][2], const Unit& u, int wr, int wc, int fr, int fq) const {
        const int row0 = u.pm * BM + wr * 64 + fr, col0 = u.pn * BM + wc * 32 + 4 * fq; const int pn = u.pn;
        const float sc = (pn == 3 || pn == 4) ? mk::C2_64 : 1.f;
#pragma unroll
        for (int ai = 0; ai < 2; ++ai)
#pragma unroll
            for (int m = 0; m < 4; ++m) { const int row = row0 + ai * HALF + m * 16; const float rs = sc / sqrtf(ss[row] * (1.f / 1024.f) + EPS);
                bf16_t* rowp = Z + (size_t)row * 1536 + col0; float q = 0.f;
#pragma unroll
                for (int bj = 0; bj < 2; ++bj) { f32x4 v0 = acc[ai][bj][m][0] * rs, v1 = acc[ai][bj][m][1] * rs;
                    if (pn == 1 && bj == 1) {
                        if (wc != 0) continue;
                        const f32x2* rp = rope + (size_t)(row & (mk::S - 1)) * 16 + 4 * fq;
#pragma unroll
                        for (int j = 0; j < 4; ++j) { const f32x2 cs = rp[j]; const float t1 = v0[j], t2 = v1[j]; v0[j] = t1 * cs.x - t2 * cs.y; v1[j] = t1 * cs.y + t2 * cs.x; }
                    } else if (pn < 3) q += (v0[0] * v0[0] + v0[1] * v0[1]) + (v0[2] * v0[2] + v0[3] * v0[3]) + (v1[0] * v1[0] + v1[1] * v1[1]) + (v1[2] * v1[2] + v1[3] * v1[3]);
                    u32x2 w0, w1; w0.x = cvtpk(v0[0], v0[1]); w0.y = cvtpk(v0[2], v0[3]); w1.x = cvtpk(v1[0], v1[1]); w1.y = cvtpk(v1[2], v1[3]);
                    *(u32x2*)(rowp + bj * HALF) = w0; *(u32x2*)(rowp + bj * HALF + 16) = w1; }
                if (pn < 3) { q += __shfl_xor(q, 16); q += __shfl_xor(q, 32); if (fq == 0) ssz[(size_t)row * 12 + pn * 4 + wc] = q; }
                asm volatile("" ::: "memory"); }
    }
};
struct EpiUq {
    static constexpr bool PERM = false;
    bf16_t* Q; const float* ssz; const f32x2* rope;
    __device__ __forceinline__ void operator()(const f32x4 (&acc)[2][2][4][2], const Unit& u, int wr, int wc, int fr, int fq) const {
        const int row0 = u.pm * BM + wr * 64 + fr, col0 = u.pn * BM + wc * 32 + 4 * fq;
#pragma unroll
        for (int ai = 0; ai < 2; ++ai)
#pragma unroll
            for (int m = 0; m < 4; ++m) { const int row = row0 + ai * HALF + m * 16; const f32x4* sp = (const f32x4*)(ssz + (size_t)row * 12); const f32x4 s0 = sp[0], s1 = sp[1];
                const float rs = mk::C2_96 / sqrtf(((s0[0] + s0[1]) + (s0[2] + s0[3]) + (s1[0] + s1[1]) + (s1[2] + s1[3])) * (1.f / 384.f) + EPS);
                bf16_t* rowp = Q + (size_t)row * 768 + col0;
#pragma unroll
                for (int bj = 0; bj < 2; ++bj) { f32x4 v0 = acc[ai][bj][m][0] * rs, v1 = acc[ai][bj][m][1] * rs;
                    const int g32 = u.pn * 8 + bj * 4 + wc;
                    if (g32 % 3 == 2) { const f32x2* rp = rope + (size_t)(row & (mk::S - 1)) * 16 + 4 * fq;
#pragma unroll
                        for (int j = 0; j < 4; ++j) { const f32x2 cs = rp[j]; const float t1 = v0[j], t2 = v1[j]; v0[j] = t1 * cs.x - t2 * cs.y; v1[j] = t1 * cs.y + t2 * cs.x; } }
                    u32x2 w0, w1; w0.x = cvtpk(v0[0], v0[1]); w0.y = cvtpk(v0[2], v0[3]); w1.x = cvtpk(v1[0], v1[1]); w1.y = cvtpk(v1[2], v1[3]);
                    *(u32x2*)(rowp + bj * HALF) = w0; *(u32x2*)(rowp + bj * HALF + 16) = w1; }
                asm volatile("" ::: "memory"); }
    }
};
struct EpiUkv {
    static constexpr bool PERM = true;
    bf16_t* O; const float* ssz;
    __device__ __forceinline__ void operator()(const f32x4 (&acc)[2][2][4][2], const Unit& u, int wr, int wc, int fr, int fq) const {
        const int row0 = u.pm * BM + wr * 64 + fr, col0 = u.pn * BM + wc * 32 + 8 * fq;
#pragma unroll
        for (int ai = 0; ai < 2; ++ai)
#pragma unroll
            for (int m = 0; m < 4; ++m) { const int row = row0 + ai * HALF + m * 16; const f32x4 s2 = *(const f32x4*)(ssz + (size_t)row * 12 + 8);
                const float rs = 1.f / sqrtf(((s2[0] + s2[1]) + (s2[2] + s2[3])) * (1.f / 256.f) + EPS);
                bf16_t* rowp = O + (size_t)row * 1024 + col0;
#pragma unroll
                for (int bj = 0; bj < 2; ++bj) { const f32x4 v0 = acc[ai][bj][m][0] * rs, v1 = acc[ai][bj][m][1] * rs;
                    u32x4 w; w.x = cvtpk(v0[0], v0[1]); w.y = cvtpk(v0[2], v0[3]); w.z = cvtpk(v1[0], v1[1]); w.w = cvtpk(v1[2], v1[3]);
                    *(u32x4*)(rowp + bj * HALF) = w; }
                asm volatile("" ::: "memory"); }
    }
};
struct MoeProb {
    const LAS int* pre; const LAS int* cnt; int NT, G, c, K, lda;
    const bf16_t* A; const bf16_t* Bt; size_t bstride;
    const unsigned* lt;
    bool gather;
    __device__ __forceinline__ bool next(int i, Unit& u) const {
        const long L = (long)i * G + c; const int total = pre[32] * NT; if (L >= total) return false;
        const int rtg = (int)L / NT; u.pn = (int)L % NT; int e = 0;
#pragma unroll 1
        for (int j = 1; j < 32; ++j) if (pre[j] <= rtg) e = j;
        u.e = e; u.rt = rtg - pre[e]; u.pm = rtg; const int rem = cnt[e] - u.rt * 256; u.rows = rem < 256 ? rem : 256; return true;
    }
    __device__ __forceinline__ const char* a_base(const Unit& u) const { return gather ? (const char*)A : (const char*)A + (size_t)u.pm * BM * lda * 2; }
    __device__ __forceinline__ size_t a_hstep() const { return (size_t)HALF * lda * 2; }
    __device__ __forceinline__ const char* b_base(const Unit& u) const { return (const char*)Bt + ((size_t)u.e * bstride + (size_t)u.pn * BM * K) * 2; }
    __device__ __forceinline__ void a_voff(const Unit& u, int R0, int C0, int R1, int C1, unsigned (&vo)[2][2]) const {
        if (gather) { const unsigned* l = lt + (size_t)u.e * mk::N + u.rt * 256;
            const unsigned t00 = (R0 < u.rows) ? (l[R0] & 0x7fffffffu) : 0u, t01 = (R1 < u.rows) ? (l[R1] & 0x7fffffffu) : 0u;
            const unsigned t10 = (R0 + HALF < u.rows) ? (l[R0 + HALF] & 0x7fffffffu) : 0u, t11 = (R1 + HALF < u.rows) ? (l[R1 + HALF] & 0x7fffffffu) : 0u;
            vo[0][0] = (t00 * (unsigned)lda + C0) * 2u; vo[0][1] = (t01 * (unsigned)lda + C1) * 2u; vo[1][0] = (t10 * (unsigned)lda + C0) * 2u; vo[1][1] = (t11 * (unsigned)lda + C1) * 2u;
        } else { vo[0][0] = (unsigned)(R0 * lda + C0) * 2u; vo[0][1] = (unsigned)(R1 * lda + C1) * 2u; vo[1][0] = vo[0][0]; vo[1][1] = vo[0][1]; }
    }
};
struct EpiGateUp {
    static constexpr bool PERM = true;
    bf16_t* act; const float* lw; const float* lr;
    __device__ __forceinline__ void operator()(const f32x4 (&acc)[2][2][4][2], const Unit& u, int wr, int wc, int fr, int fq) const {
        const int rl0 = wr * 64 + fr, col0 = u.pn * 128 + wc * 32 + 8 * fq; const size_t lbase = (size_t)u.e * mk::N + u.rt * 256;
#pragma unroll
        for (int ai = 0; ai < 2; ++ai)
#pragma unroll
            for (int m = 0; m < 4; ++m) { const int rl = rl0 + ai * HALF + m * 16; if (rl >= u.rows) continue;
                const float w = lw[lbase + rl], rs = lr[lbase + rl]; float o[8];
#pragma unroll
                for (int n = 0; n < 2; ++n)
#pragma unroll
                    for (int j = 0; j < 4; ++j) { const float g = acc[ai][0][m][n][j] * rs, up = acc[ai][1][m][n][j] * rs;
                        o[n * 4 + j] = g * __builtin_amdgcn_rcpf(1.f + __builtin_amdgcn_exp2f(-g * mk::LOG2E)) * up * w; }
                u32x4 pk; pk.x = cvtpk(o[0], o[1]); pk.y = cvtpk(o[2], o[3]); pk.z = cvtpk(o[4], o[5]); pk.w = cvtpk(o[6], o[7]);
                *(u32x4*)(act + ((size_t)u.pm * 256 + rl) * 256 + col0) = pk;
                asm volatile("" ::: "memory"); }
    }
};
struct EpiDown {
    static constexpr bool PERM = true;
    bf16_t* Y; const unsigned* lt;
    __device__ __forceinline__ void operator()(const f32x4 (&acc)[2][2][4][2], const Unit& u, int wr, int wc, int fr, int fq) const {
        const int rl0 = wr * 64 + fr, col0 = u.pn * BM + wc * 32 + 8 * fq; const size_t lbase = (size_t)u.e * mk::N + u.rt * 256;
#pragma unroll
        for (int ai = 0; ai < 2; ++ai)
#pragma unroll
            for (int m = 0; m < 4; ++m) { const int rl = rl0 + ai * HALF + m * 16; if (rl >= u.rows) continue;
                const unsigned tk = lt[lbase + rl]; bf16_t* rowp = Y + ((size_t)(tk >> 31) * mk::N + (tk & 0x7fffffffu)) * 1024 + col0;
#pragma unroll
                for (int bj = 0; bj < 2; ++bj) { const f32x4 v0 = acc[ai][bj][m][0], v1 = acc[ai][bj][m][1];
                    u32x4 w; w.x = cvtpk(v0[0], v0[1]); w.y = cvtpk(v0[2], v0[3]); w.z = cvtpk(v1[0], v1[1]); w.w = cvtpk(v1[2], v1[3]);
                    *(u32x4*)(rowp + bj * HALF) = w; }
                asm volatile("" ::: "memory"); }
    }
};
}
namespace att {
constexpr int SLOT_K = 12288, SLOT_V = 8192, SLOT_KB = 256, SLOT = SLOT_K + SLOT_V + SLOT_KB;
constexpr int LDS_WS = 2 * SLOT, LDS_OST = LDS_WS + 8 * 256, LDS_BYTES = LDS_OST + 8 * 4096;
struct UnitDesc {
    const bf16_t* q; long qstride;
    const bf16_t* k; const bf16_t* v; long kstride;
    const bf16_t* kx; long kxstride;
    bf16_t* o; long ostride;
    float* lse; long lsestride;
    const float* kbias;
    int q0, W; float alibi, sink;
    bool has_sink, has_lse;
};
__device__ __forceinline__ int crow(int r, int hi) { return (r & 3) + 8 * (r >> 2) + 4 * hi; }
#define ATT_MX3(a, b, c) __builtin_fmaxf(__builtin_fmaxf((a), (b)), (c))
__device__ __forceinline__ float rowmax(const f32x16& p0, const f32x16& p1) {
    float a = ATT_MX3(p0[0], p0[1], p1[0]), b = ATT_MX3(p0[2], p0[3], p1[1]); a = ATT_MX3(a, p1[2], p1[3]);
#pragma unroll
    for (int r = 4; r < 16; r += 4) { a = ATT_MX3(a, p0[r], p0[r + 1]); b = ATT_MX3(b, p0[r + 2], p0[r + 3]); a = ATT_MX3(a, p1[r], p1[r + 1]); b = ATT_MX3(b, p1[r + 2], p1[r + 3]); }
    float m = __builtin_fmaxf(a, b); auto rr = __builtin_amdgcn_permlane32_swap(__float_as_uint(m), __float_as_uint(m), false, false);
    return __builtin_fmaxf(__uint_as_float(rr[0]), __uint_as_float(rr[1])); }
typedef short v4i16_t __attribute__((ext_vector_type(4)));
__device__ __forceinline__ s16x4 vtr(const LAS unsigned char* p) { return __builtin_bit_cast(s16x4, __builtin_amdgcn_ds_read_tr16_b64_v4i16((LAS v4i16_t*)p)); }

template <int NDQ, bool FOX, bool BAND>
__device__ __forceinline__ void attn_unit(const UnitDesc& u, LAS unsigned char* lds, const int tid) {
    const int lane = tid & 63, r32 = lane & 31, hi = lane >> 5; const int w = __builtin_amdgcn_readfirstlane(tid >> 6);
    const int q0 = u.q0, Qw = q0 + 32 * w;
    const int t_lo = BAND ? ((q0 - u.W) > 0 ? ((q0 - u.W) >> 6) : 0) : 0, t_hi = (q0 + 255) >> 6;
    LAS float* wsf = (LAS float*)(lds + LDS_WS) + w * 64;
    const bf16_t* ksrc = u.k + (long)lane * u.kstride + w * 8;
    const bf16_t* kxsrc = (NDQ == 6) ? u.kx + (long)lane * u.kxstride + (w & 3) * 8 : nullptr;
    const bf16_t* vsrc = u.v + (long)(16 * (w & 3) + (lane >> 2)) * u.kstride + (w >> 2) * 32 + (lane & 3) * 8;
#define ATT_DMA(t, bsel) do { LAS unsigned char* kb_ = lds + (bsel) * SLOT; \
        __builtin_amdgcn_global_load_lds((const unsigned*)(ksrc + (long)(t) * 64 * u.kstride), (LAS unsigned*)(kb_ + w * 1024), 16, 0, 0); \
        if (NDQ == 6) { if (w < 4) __builtin_amdgcn_global_load_lds((const unsigned*)(kxsrc + (long)(t) * 64 * u.kxstride), (LAS unsigned*)(kb_ + (8 + w) * 1024), 16, 0, 0); } \
        __builtin_amdgcn_global_load_lds((const unsigned*)(vsrc + (long)(t) * 64 * u.kstride), (LAS unsigned*)(kb_ + SLOT_K + w * 1024), 16, 0, 0); \
        if (FOX) { if (w == 7) __builtin_amdgcn_global_load_lds((const unsigned*)(u.kbias + (t) * 64 + lane), (LAS unsigned*)(kb_ + SLOT_K + SLOT_V), 4, 0, 0); } } while (0)
    ATT_DMA(t_lo, 0);
    bf16x8 qr[NDQ];
    { const bf16_t* Qw_ = u.q + (long)(32 * w + r32) * u.qstride + hi * 8;
#pragma unroll
      for (int d0 = 0; d0 < NDQ; ++d0) qr[d0] = *(const bf16x8*)(Qw_ + d0 * 16); }
    float ci = 0.f; if (FOX) ci = -u.kbias[Qw + r32];
    float m_run = -1e30f, l_run = 0.f; f32x16 o[2]; o[0] = f32x16{}; o[1] = f32x16{};
    const int koff = hi * 1024 + r32 * 16;
    const int voff = SLOT_K + ((lane >> 4) & 1) * 32 + (lane & 3) * 8 + (4 * hi + ((lane & 15) >> 2)) * 64;
    for (int t = t_lo; t <= t_hi; ++t) {
        const int bsel = (t - t_lo) & 1;
        asm volatile("s_waitcnt vmcnt(0)" ::: "memory");
        __syncthreads();
        if (t < t_hi) ATT_DMA(t + 1, bsel ^ 1);
        const int k0 = 64 * t;
        bool active = (k0 <= Qw + 31); if (BAND) active = active && (Qw - (k0 + 63) <= u.W);
        if (!active) continue;
        const LAS unsigned char* kb = lds + bsel * SLOT;
        f32x16 p0, p1;
#pragma unroll
        for (int r = 0; r < 16; ++r) { p0[r] = ci; p1[r] = ci; }
#pragma unroll
        for (int d0 = 0; d0 < NDQ; ++d0) { const bf16x8 a0 = *(const LAS bf16x8*)(kb + koff + d0 * 2048), a1 = *(const LAS bf16x8*)(kb + koff + d0 * 2048 + 512);
            p0 = __builtin_amdgcn_mfma_f32_32x32x16_bf16(a0, qr[d0], p0, 0, 0, 0); p1 = __builtin_amdgcn_mfma_f32_32x32x16_bf16(a1, qr[d0], p1, 0, 0, 0); }
        if (FOX) { const LAS float* kbp = (const LAS float*)(kb + SLOT_K + SLOT_V) + 4 * hi;
#pragma unroll
            for (int g = 0; g < 4; ++g) { const f32x4 b0 = *(const LAS f32x4*)(kbp + 8 * g), b1 = *(const LAS f32x4*)(kbp + 32 + 8 * g);
#pragma unroll
                for (int j = 0; j < 4; ++j) { p0[4 * g + j] += b0[j]; p1[4 * g + j] += b1[j]; } } }
        const int dbase = Qw + r32 - k0 - 4 * hi;
        if (BAND) {
#pragma unroll
            for (int r = 0; r < 16; ++r) { const int d0_ = dbase - ((r & 3) + 8 * (r >> 2)), d1_ = d0_ - 32;
                p0[r] = ((unsigned)d0_ <= (unsigned)u.W) ? p0[r] - u.alibi * (float)d0_ : -INFINITY;
                p1[r] = ((unsigned)d1_ <= (unsigned)u.W) ? p1[r] - u.alibi * (float)d1_ : -INFINITY; }
        } else if (k0 + 63 > Qw) {
#pragma unroll
            for (int r = 0; r < 16; ++r) { const int d0_ = dbase - ((r & 3) + 8 * (r >> 2));
                if (d0_ < 0) p0[r] = -INFINITY; if (d0_ < 32) p1[r] = -INFINITY; }
        }
        const float rm = rowmax(p0, p1), m_new = __builtin_fmaxf(m_run, rm);
        const float alpha = __builtin_amdgcn_exp2f(m_run - m_new);
        if (__any(m_new > m_run)) {
            if (hi == 0) wsf[r32] = alpha;
#pragma unroll
            for (int g = 0; g < 4; ++g) { const f32x4 a = *(const LAS f32x4*)(wsf + 8 * g + 4 * hi);
#pragma unroll
                for (int j = 0; j < 4; ++j) { o[0][4 * g + j] *= a[j]; o[1][4 * g + j] *= a[j]; } }
        }
        m_run = m_new; float sacc = 0.f;
#pragma unroll
        for (int r = 0; r < 16; ++r) { p0[r] = __builtin_amdgcn_exp2f(p0[r] - m_new); p1[r] = __builtin_amdgcn_exp2f(p1[r] - m_new); sacc += p0[r] + p1[r]; }
        l_run = l_run * alpha + sacc;
        u32x4 pw[4];
#pragma unroll
        for (int j = 0; j < 4; ++j) { pw[0][j] = cvtpk(p0[2 * j], p0[2 * j + 1]); pw[1][j] = cvtpk(p0[8 + 2 * j], p0[9 + 2 * j]); pw[2][j] = cvtpk(p1[2 * j], p1[2 * j + 1]); pw[3][j] = cvtpk(p1[8 + 2 * j], p1[9 + 2 * j]); }
        const LAS unsigned char* vp = kb + voff;
#pragma unroll
        for (int d0 = 0; d0 < 2; ++d0)
#pragma unroll
            for (int ks = 0; ks < 4; ++ks) { const s16x4 lo = vtr(vp + d0 * 4096 + ks * 1024), hh = vtr(vp + d0 * 4096 + ks * 1024 + 512);
                const bf16x8 vf = (bf16x8){lo[0], lo[1], lo[2], lo[3], hh[0], hh[1], hh[2], hh[3]};
                o[d0] = __builtin_amdgcn_mfma_f32_32x32x16_bf16(__builtin_bit_cast(bf16x8, pw[ks]), vf, o[d0], 0, 0, 0); }
    }
#undef ATT_DMA
    { auto rr = __builtin_amdgcn_permlane32_swap(__float_as_uint(l_run), __float_as_uint(l_run), false, false); l_run = __uint_as_float(rr[0]) + __uint_as_float(rr[1]); }
    if (BAND) { if (u.has_sink) l_run += __builtin_amdgcn_exp2f(u.sink - m_run);
                if (u.has_lse) { if (hi == 0) u.lse[(long)(32 * w + r32) * u.lsestride] = m_run + __builtin_amdgcn_logf(l_run); } }
    if (hi == 0) wsf[32 + r32] = __builtin_amdgcn_rcpf(l_run);
    LAS bf16_t* stg = (LAS bf16_t*)(lds + LDS_OST) + w * 2048;
#pragma unroll
    for (int g = 0; g < 4; ++g) { const f32x4 a = *(const LAS f32x4*)(wsf + 32 + 8 * g + 4 * hi);
#pragma unroll
        for (int j = 0; j < 4; ++j) { const int r = 4 * g + j, orow = crow(r, hi);
#pragma unroll
            for (int d0 = 0; d0 < 2; ++d0) { const float v = o[d0][r] * a[j]; stg[orow * 64 + d0 * 32 + r32] = (bf16_t)(cvtpk(v, v) & 0xffffu); } } }
    bf16_t* Ow = u.o + (long)(32 * w) * u.ostride;
#pragma unroll
    for (int i = 0; i < 4; ++i) { const int row = i * 8 + (lane >> 3), ch = lane & 7; const u32x4 v = *(const LAS u32x4*)(stg + row * 64 + ch * 8); *(u32x4*)(Ow + (long)row * u.ostride + ch * 8) = v; }
    __syncthreads();
}
}
namespace mk {
constexpr int NWAVES = 8, NTHREADS = 512;
constexpr int RING_BYTES = 131072, MISC_OFF = RING_BYTES, LDS_BYTES = 147456;
constexpr int MISC_PRE = MISC_OFF + 1024, MISC_CNT = MISC_PRE + 256, MISC_STASH = MISC_OFF + 2048;
constexpr int NPHASE = 17;
#define LDS_WAIT() asm volatile("s_waitcnt lgkmcnt(0)" ::: "memory")

struct Args { const float* in[21]; float* out; unsigned char* ws; float* H; int ph_lo, ph_hi; int use_bar, pad; };

typedef const __attribute__((address_space(4))) Args* cargs_t;
__device__ __forceinline__ Args load_args() {
#if defined(__HIP_DEVICE_COMPILE__)
    cargs_t p = (cargs_t)__builtin_amdgcn_kernarg_segment_ptr(); asm volatile("" : "+s"(p)); Args a;
#pragma unroll
    for (int i = 0; i < 21; ++i) a.in[i] = p->in[i];
    a.out = p->out; a.ws = p->ws; a.H = p->H; a.ph_lo = p->ph_lo; a.ph_hi = p->ph_hi; a.use_bar = p->use_bar; a.pad = 0; return a;
#else
    return Args{};
#endif
}
__device__ __forceinline__ void grid_barrier(const Args&, LAS unsigned char*) { cooperative_groups::this_grid().sync(); }
__device__ __forceinline__ float wave_sum(float v) {
#pragma unroll
    for (int o = 1; o < 64; o <<= 1) v += __shfl_xor(v, o);
    return v;
}
__device__ __forceinline__ void tr_item(const float* src, int lds_, int ncols, const float* scale, bf16_t* dst, int ldd, LAS float* scr, int lane) {
#pragma unroll 8
    for (int i = 0; i < 32; ++i) { const int kk = 2 * i + (lane >> 5), c = lane & 31; float v = 0.f;
        if (src && c < ncols) { v = src[(size_t)kk * lds_ + c]; if (scale) v *= scale[kk]; }
        scr[kk * 33 + c] = v; }
    LDS_WAIT(); asm volatile("" ::: "memory");
    const int c = lane & 7;
#pragma unroll
    for (int j = 0; j < 4; ++j) { const int n = (lane >> 3) + 8 * j; const LAS float* s = scr + (8 * c) * 33 + n;
        u32x4 o; o.x = cvtpk(s[0 * 33], s[1 * 33]); o.y = cvtpk(s[2 * 33], s[3 * 33]); o.z = cvtpk(s[4 * 33], s[5 * 33]); o.w = cvtpk(s[6 * 33], s[7 * 33]);
        *(u32x4*)(dst + (size_t)n * ldd + 8 * c) = o; }
    LDS_WAIT(); asm volatile("" ::: "memory");
}
struct TrMat { const float* W; int K, ldw; const float* scale; bf16_t* WT; int nblk; int kind; };
__device__ __forceinline__ int tr_srccol(int kind, int n0) {
    switch (kind) {
    case 0: return n0;
    case 1: return n0 < 1536 ? n0 : n0 + 8;
    case 2: return n0 < 384 ? n0 : (n0 < 416 ? n0 + 256 : (n0 < 512 ? -1 : (n0 < 768 ? n0 - 128 : n0 - 96)));
    default: return n0; }
}
__device__ __forceinline__ void tr_mat_item(const TrMat& m, int item, LAS float* scr, int lane) {
    const int kb = item / m.nblk, nb = item % m.nblk, k0 = 64 * kb, n0 = 32 * nb; const int sc = tr_srccol(m.kind, n0);
    tr_item(sc < 0 ? nullptr : m.W + (size_t)k0 * m.ldw + sc, m.ldw, 32, m.scale ? m.scale + k0 : nullptr, m.WT + (size_t)n0 * m.K + k0, m.K, scr, lane);
}

__device__ __forceinline__ void p0_prologue(const Args& a, LAS unsigned char* lds, int gw, int NGW, int wave, int lane) {
    unsigned char* ws = a.ws; LAS float* scr = (LAS float*)(lds + wave * 16384);
    const float* attn_norm = a.in[1]; const float* ffn_norm = a.in[2];
    TrMat M[6];
    M[0] = TrMat{a.in[4], 1024, 3080, attn_norm, (bf16_t*)(ws + WS_WIN0), 96, 1};
    M[1] = TrMat{a.in[6], 1024, 1024, nullptr, (bf16_t*)(ws + WS_WOUT0), 32, 0};
    M[2] = TrMat{a.in[7], 1024, 1440, attn_norm + 1024, (bf16_t*)(ws + WS_WIN1), 48, 2};
    M[3] = TrMat{a.in[10], 384, 768, a.in[8], (bf16_t*)(ws + WS_WUQ), 24, 0};
    M[4] = TrMat{a.in[11], 256, 1024, a.in[9], (bf16_t*)(ws + WS_WUKV), 32, 0};
    M[5] = TrMat{a.in[13], 1024, 1024, nullptr, (bf16_t*)(ws + WS_WOUT1), 32, 0};
    const int cnt[6] = {16 * 96, 16 * 32, 16 * 48, 6 * 24, 4 * 32, 16 * 32};
    int base = 0;
#pragma unroll
    for (int mi = 0; mi < 6; ++mi) { for (int it = (gw + NGW - base % NGW) % NGW; it < cnt[mi]; it += NGW) tr_mat_item(M[mi], it, scr, lane); base += cnt[mi]; }
    for (int it = gw; it < 2 * 16 * 2; it += NGW) { const int l = it >> 5, r = it & 31, kb = r >> 1, nb = r & 1, k0 = 64 * kb;
        bf16_t* dst = (bf16_t*)(ws + WS_WR) + (size_t)l * 64 * 1024 + (size_t)(32 * nb) * 1024 + k0;
        if (nb == 0) tr_item(a.in[16] + (size_t)l * 1024 * 32 + (size_t)k0 * 32, 32, 32, ffn_norm + l * 1024 + k0, dst, 1024, scr, lane);
        else tr_item(a.in[14] + (size_t)l * 1024 * 4 + (size_t)k0 * 4, 4, 4, ffn_norm + l * 1024 + k0, dst, 1024, scr, lane); }
    { f32x2* rope = (f32x2*)(ws + WS_ROPE);
      for (int i = gw * 64 + lane; i < S * 16; i += NGW * 64) { const int pos = i >> 4, j = i & 15; const float inv = powf(10000.0f, -(float)(2 * j) / 32.0f), ang = (float)pos * inv; float sn, cs; sincosf(ang, &sn, &cs); rope[i] = (f32x2){cs, sn}; } }
    { const float* x = a.in[0]; const float* win = a.in[4]; const float* bfp = a.in[5];
      bf16_t* XB = (bf16_t*)(ws + WS_XB); float* SS = (float*)(ws + WS_SS); float* LOGF = (float*)(ws + WS_LOGF);
      float wz[4][4][8];
#pragma unroll
      for (int j = 0; j < 4; ++j)
#pragma unroll
          for (int e = 0; e < 4; ++e) { const int k = 256 * j + 4 * lane + e; const float g = attn_norm[k]; const f32x4 w0 = *(const f32x4*)(win + (size_t)k * 3080 + 1536), w1 = *(const f32x4*)(win + (size_t)k * 3080 + 1540);
#pragma unroll
              for (int h = 0; h < 4; ++h) { wz[j][e][h] = w0[h] * g; wz[j][e][4 + h] = w1[h] * g; } }
      for (int row = gw; row < N; row += NGW) {
          const f32x4* xr = (const f32x4*)(x + (size_t)row * D) + lane; f32x4 v[4]; float ssq = 0.f; float zf[8];
#pragma unroll
          for (int h = 0; h < 8; ++h) zf[h] = 0.f;
#pragma unroll
          for (int j = 0; j < 4; ++j) { v[j] = xr[64 * j]; ssq += (v[j][0] * v[j][0] + v[j][1] * v[j][1]) + (v[j][2] * v[j][2] + v[j][3] * v[j][3]);
#pragma unroll
              for (int e = 0; e < 4; ++e)
#pragma unroll
                  for (int h = 0; h < 8; ++h) zf[h] += v[j][e] * wz[j][e][h]; }
          ssq = wave_sum(ssq);
#pragma unroll
          for (int h = 0; h < 8; ++h) zf[h] = wave_sum(zf[h]);
          u32x2* o8 = (u32x2*)(XB + (size_t)row * D) + lane;
#pragma unroll
          for (int j = 0; j < 4; ++j) { u32x2 wv; wv.x = cvtpk(v[j][0], v[j][1]); wv.y = cvtpk(v[j][2], v[j][3]); o8[64 * j] = wv; }
          if (lane == 0) SS[row] = ssq;
          const float rstd = 1.f / sqrtf(ssq * (1.f / D) + EPS);
          float zsel = zf[0];
#pragma unroll
          for (int h = 1; h < 8; ++h) zsel = (lane == h) ? zf[h] : zsel;
          if (lane < 8) { const float xg = zsel * rstd + bfp[lane]; LOGF[(size_t)row * 8 + lane] = fminf(xg, 0.f) - log1pf(expf(-fabsf(xg))); }
      } }
}
__device__ __forceinline__ void fox_cumsum(const Args& a, LAS unsigned char* lds, int G, const int tid) {
    const float* LOGF = (const float*)(a.ws + WS_LOGF); float* KB = (float*)(a.ws + WS_CB2); LAS float* part = (LAS float*)lds;
    const int t = tid, lane = t & 63, wv = t >> 6;
    for (int bh = blockIdx.x; bh < 32; bh += G) { const int b = bh >> 3, h = bh & 7; float loc[8]; float run = 0.f;
#pragma unroll
        for (int i = 0; i < 8; ++i) { run += LOGF[(size_t)(b * S + t * 8 + i) * 8 + h]; loc[i] = run; }
        float inc = run;
#pragma unroll
        for (int o = 1; o < 64; o <<= 1) { const float up = __shfl_up(inc, o); if (lane >= o) inc += up; }
        __syncthreads();
        if (lane == 63) part[wv] = inc;
        __syncthreads();
        float off = inc - run;
        for (int i = 0; i < wv; ++i) off += part[i];
#pragma unroll
        for (int i = 0; i < 8; ++i) KB[(size_t)bh * S + t * 8 + i] = -LOG2E * (loc[i] + off);
    }
    __syncthreads();
}
__device__ __forceinline__ void attn_phase0(const Args& a, LAS unsigned char* lds, int vcu, int G, const int tid) {
    const bf16_t* QKV = (const bf16_t*)(a.ws + R1_QKV0); bf16_t* AO = (bf16_t*)(a.ws + R2_AO); bf16_t* DP = (bf16_t*)(a.ws + R2_DPART);
    float* DLSE = (float*)(a.ws + WS_DLSE); const float* KB = (const float*)(a.ws + WS_CB2);
    for (int it = vcu; it < 256 + 1536; it += G) {
        if (it < 256) { const int bh = it >> 3, s = it & 7, b = bh >> 3, h = bh & 7;
            for (int half = 0; half < 2; ++half) { const int qb = half ? 15 - s : s; att::UnitDesc u{};
                const bf16_t* base = QKV + (size_t)b * S * 3072 + h * 64;
                u.q = base + (size_t)(qb * 256) * 3072; u.qstride = 3072; u.k = base + 512; u.v = base + 1024; u.kstride = 3072;
                u.o = AO + (size_t)(b * S + qb * 256) * 1024 + h * 64; u.ostride = 1024; u.kbias = KB + (size_t)bh * S; u.q0 = qb * 256; u.W = 1 << 30;
                att::attn_unit<4, true, false>(u, lds, tid); }
        } else { const int j = it - 256, bh = j / 48, rem = j % 48, br = rem >> 4, idx = rem & 15, b = bh >> 3, h = bh & 7;
            const int dil = br == 0 ? 1 : (br == 1 ? 4 : 16), c = br == 0 ? 0 : (br == 1 ? idx >> 2 : idx), qblk = br == 0 ? idx : (br == 1 ? idx & 3 : 0);
            att::UnitDesc u{}; const bf16_t* base = QKV + (size_t)(b * S + c) * 3072 + 1536 + h * 64; const long st = (long)dil * 3072;
            u.q = base + (size_t)(qblk * 256) * st; u.qstride = st; u.k = base + 512; u.v = base + 1024; u.kstride = st;
            const size_t tok0 = (size_t)b * S + c + (size_t)qblk * 256 * dil;
            u.o = DP + (size_t)br * N * 512 + tok0 * 512 + h * 64; u.ostride = (long)dil * 512;
            u.lse = DLSE + (size_t)br * N * 8 + tok0 * 8 + h; u.lsestride = (long)dil * 8; u.has_lse = true;
            u.q0 = qblk * 256; u.W = 128; u.alibi = exp2f(-(float)(h + 1)) * (float)dil * LOG2E;
            att::attn_unit<4, false, true>(u, lds, tid); }
    }
}
__device__ __forceinline__ void attn_phase1(const Args& a, LAS unsigned char* lds, int vcu, int G, const int tid) {
    const bf16_t* Z1 = (const bf16_t*)(a.ws + R1_Z1); const bf16_t* Q1 = (const bf16_t*)(a.ws + R1_Q1); const bf16_t* KV = (const bf16_t*)(a.ws + R1_KV1);
    bf16_t* AO = (bf16_t*)(a.ws + R2_AO); const float* sinks = a.in[12];
    for (int it = vcu; it < 256 + 512; it += G) {
        if (it < 256) { const int bh = it >> 3, s = it & 7, b = bh >> 3, h = bh & 7;
            for (int half = 0; half < 2; ++half) { const int qb = half ? 15 - s : s; att::UnitDesc u{};
                u.q = Q1 + (size_t)(b * S + qb * 256) * 768 + h * 96; u.qstride = 768;
                u.k = KV + (size_t)b * S * 1024 + h * 128; u.v = u.k + 64; u.kstride = 1024; u.kx = Z1 + (size_t)b * S * 1536 + 384; u.kxstride = 1536;
                u.o = AO + (size_t)(b * S + qb * 256) * 1024 + h * 64; u.ostride = 1024; u.q0 = qb * 256; u.W = 1 << 30;
                att::attn_unit<6, false, false>(u, lds, tid); }
        } else { const int j = it - 256, b = j >> 7, hq = (j >> 4) & 7, qb = j & 15, kvh = hq >> 2; att::UnitDesc u{};
            const bf16_t* base = Z1 + (size_t)b * S * 1536;
            u.q = base + (size_t)(qb * 256) * 1536 + 768 + hq * 64; u.qstride = 1536; u.k = base + 1280 + kvh * 64; u.v = base + 1408 + kvh * 64; u.kstride = 1536;
            u.o = AO + (size_t)(b * S + qb * 256) * 1024 + 512 + hq * 64; u.ostride = 1024; u.q0 = qb * 256; u.W = 127;
            u.alibi = exp2f(-(float)(hq + 1)) * LOG2E; u.has_sink = true; u.sink = sinks[hq] * LOG2E;
            att::attn_unit<4, false, true>(u, lds, tid); }
    }
}
__device__ __forceinline__ void merge_phase(const Args& a, int gw, int NGW, int lane) {
    const bf16_t* DP = (const bf16_t*)(a.ws + R2_DPART); const float* DLSE = (const float*)(a.ws + WS_DLSE); bf16_t* AO = (bf16_t*)(a.ws + R2_AO);
    for (int tok = gw; tok < N; tok += NGW) { const int h = lane >> 3;
        const float l0 = DLSE[(size_t)tok * 8 + h], l1 = DLSE[(size_t)N * 8 + (size_t)tok * 8 + h], l2 = DLSE[(size_t)2 * N * 8 + (size_t)tok * 8 + h];
        const float mx = fmaxf(l0, fmaxf(l1, l2)); float w0 = exp2f(l0 - mx), w1 = exp2f(l1 - mx), w2 = exp2f(l2 - mx); const float inv = 1.f / (w0 + w1 + w2); w0 *= inv; w1 *= inv; w2 *= inv;
        const u32x4 a0 = *(const u32x4*)(DP + (size_t)tok * 512 + lane * 8), a1 = *(const u32x4*)(DP + (size_t)N * 512 + (size_t)tok * 512 + lane * 8), a2 = *(const u32x4*)(DP + (size_t)2 * N * 512 + (size_t)tok * 512 + lane * 8);
        u32x4 o;
#pragma unroll
        for (int i = 0; i < 4; ++i) { const float lo = w0 * bflo(a0[i]) + w1 * bflo(a1[i]) + w2 * bflo(a2[i]), hi = w0 * bfhi(a0[i]) + w1 * bfhi(a1[i]) + w2 * bfhi(a2[i]); o[i] = cvtpk(lo, hi); }
        *(u32x4*)(AO + (size_t)tok * 1024 + 512 + lane * 8) = o; }
}
__device__ __forceinline__ void route_phase(const Args& a, int layer, int gw, int NGW, int lane) {
    const bf16_t* HB = (const bf16_t*)(a.ws + WS_XB); const bf16_t* WR = (const bf16_t*)(a.ws + WS_WR) + (size_t)layer * 64 * 1024;
    const float* SSP = (const float*)(a.ws + WS_SSP); const float* bg = a.in[15] + layer * 4; const float* br = a.in[17] + layer * 32;
    unsigned* cnt = (unsigned*)(a.ws + WS_CTL) + CW_CNT + layer * 1024;
    unsigned* LT = (unsigned*)(a.ws + WS_LT); float* LW = (float*)(a.ws + WS_LW); float* LR = (float*)(a.ws + WS_LR);
    const int r32 = lane & 31, hi = lane >> 5;
    for (int blk = gw; blk < N / 32; blk += NGW) { const int tok = blk * 32 + r32;
        f32x16 c0 = f32x16{}, c1 = f32x16{};
        const bf16_t* xb = HB + (size_t)tok * 1024 + hi * 8; const bf16_t* wa = WR + (size_t)r32 * 1024 + hi * 8;
#pragma unroll 4
        for (int k0 = 0; k0 < 1024; k0 += 16) { const bf16x8 bx = *(const bf16x8*)(xb + k0), a0 = *(const bf16x8*)(wa + k0), a1 = *(const bf16x8*)(wa + 32 * 1024 + k0);
            c0 = __builtin_amdgcn_mfma_f32_32x32x16_bf16(a0, bx, c0, 0, 0, 0); c1 = __builtin_amdgcn_mfma_f32_32x32x16_bf16(a1, bx, c1, 0, 0, 0); }
        const f32x4* sp = (const f32x4*)(SSP + (size_t)tok * 16); const f32x4 s0 = sp[0], s1 = sp[1], s2 = sp[2], s3 = sp[3];
        const float ssq = ((s0[0] + s0[1]) + (s0[2] + s0[3])) + ((s1[0] + s1[1]) + (s1[2] + s1[3])) + ((s2[0] + s2[1]) + (s2[2] + s2[3])) + ((s3[0] + s3[1]) + (s3[2] + s3[3]));
        const float rstd = 1.f / sqrtf(ssq * (1.f / 1024.f) + EPS);
        float gl[4];
#pragma unroll
        for (int j = 0; j < 4; ++j) { const float mine = c1[j]; const float other = __shfl_xor(mine, 32); gl[j] = (hi == 0 ? mine : other) * rstd + bg[j]; }
        int gi = 0; float gm = gl[0];
#pragma unroll
        for (int j = 1; j < 4; ++j) if (gl[j] > gm) { gm = gl[j]; gi = j; }
        float den = 0.f;
#pragma unroll
        for (int j = 0; j < 4; ++j) den += __expf(gl[j] - gm);
        const float gwt = 1.f / den;
        float mine4[4];
#pragma unroll
        for (int j = 0; j < 4; ++j) { float v = c0[j]; v = (gi == 1) ? c0[4 + j] : v; v = (gi == 2) ? c0[8 + j] : v; v = (gi == 3) ? c0[12 + j] : v; mine4[j] = v; }
        float el[8];
#pragma unroll
        for (int j = 0; j < 4; ++j) { const float other = __shfl_xor(mine4[j], 32); el[j] = (hi == 0 ? mine4[j] : other); el[4 + j] = (hi == 0 ? other : mine4[j]); }
#pragma unroll
        for (int j = 0; j < 8; ++j) el[j] = el[j] * rstd + br[gi * 8 + j];
        int i1 = 0; float v1 = el[0];
#pragma unroll
        for (int j = 1; j < 8; ++j) if (el[j] > v1) { v1 = el[j]; i1 = j; }
        int i2 = -1; float v2 = -INFINITY;
#pragma unroll
        for (int j = 0; j < 8; ++j) if (j != i1 && el[j] > v2) { v2 = el[j]; i2 = j; }
        const float e2 = __expf(v2 - v1); const float w1 = gwt / (1.f + e2), w2 = gwt * e2 / (1.f + e2);
        const int E = gi * 8 + (hi == 0 ? i1 : i2); const float wsel = hi == 0 ? w1 : w2;
        int myrank = 0, mycnt = 0; const unsigned long long ltmask = (1ull << lane) - 1ull;
#pragma unroll 4
        for (int j = 0; j < 32; ++j) { const unsigned long long mj = __ballot(E == j); if (E == j) myrank = __popcll(mj & ltmask); if (lane == j) mycnt = __popcll(mj); }
        unsigned basev = 0; if (lane < 32 && mycnt > 0) basev = atomicAdd(cnt + lane * 16, (unsigned)mycnt);
        const unsigned base = (unsigned)__shfl((int)basev, E);
        const size_t pos = (size_t)E * N + base + myrank;
        LT[pos] = (unsigned)tok | ((unsigned)hi << 31); LW[pos] = wsel; LR[pos] = rstd;
    }
}
__device__ __forceinline__ void moe_convert(const Args& a, int layer, LAS unsigned char* lds, int gw, int NGW, int wave, int lane) {
    LAS float* scr = (LAS float*)(lds + wave * 16384);
    const float* wg = a.in[18] + (size_t)layer * 32 * 1024 * 256; const float* wu = a.in[19] + (size_t)layer * 32 * 1024 * 256; const float* wd = a.in[20] + (size_t)layer * 32 * 256 * 1024;
    const float* g = a.in[2] + layer * 1024; bf16_t* WGU = (bf16_t*)(a.ws + R1_WGU); bf16_t* WD = (bf16_t*)(a.ws + R1_WD);
    for (int it = gw; it < 32 * 256 + 32 * 128; it += NGW) {
        if (it < 32 * 256) { const int e = it >> 8, r = it & 255, kb = r >> 4, nb = r & 15, k0 = 64 * kb, n0 = 32 * nb;
            const int t = n0 >> 8, s = (n0 >> 7) & 1, j = n0 & 127; const float* src = (s ? wu : wg) + (size_t)e * 1024 * 256 + (size_t)k0 * 256 + 128 * t + j;
            tr_item(src, 256, 32, g + k0, WGU + ((size_t)e * 512 + n0) * 1024 + k0, 1024, scr, lane);
        } else { const int i2 = it - 32 * 256, e = i2 >> 7, r = i2 & 127, kb = r >> 5, nb = r & 31, k0 = 64 * kb, n0 = 32 * nb;
            tr_item(wd + (size_t)e * 256 * 1024 + (size_t)k0 * 1024 + n0, 1024, 32, nullptr, WD + ((size_t)e * 1024 + n0) * 256 + k0, 256, scr, lane); }
    }
}
__device__ __forceinline__ void combine_phase(const Args& a, bool last, int gw, int NGW, int lane) {
    const bf16_t* Y = (const bf16_t*)(a.ws + R2_Y); bf16_t* XB = (bf16_t*)(a.ws + WS_XB); float* SS = (float*)(a.ws + WS_SS); const float* g = a.in[3];
    for (int row = gw; row < N; row += NGW) {
        f32x4* hr = (f32x4*)(a.H + (size_t)row * D) + lane; const u32x2* y0 = (const u32x2*)(Y + (size_t)row * D) + lane; const u32x2* y1 = (const u32x2*)(Y + (size_t)N * D + (size_t)row * D) + lane;
        f32x4 v[4]; float ssq = 0.f;
#pragma unroll
        for (int j = 0; j < 4; ++j) { const u32x2 p = y0[64 * j], q = y1[64 * j]; v[j] = hr[64 * j];
            v[j][0] += bflo(p.x) + bflo(q.x); v[j][1] += bfhi(p.x) + bfhi(q.x); v[j][2] += bflo(p.y) + bflo(q.y); v[j][3] += bfhi(p.y) + bfhi(q.y);
            ssq += (v[j][0] * v[j][0] + v[j][1] * v[j][1]) + (v[j][2] * v[j][2] + v[j][3] * v[j][3]); }
        ssq = wave_sum(ssq);
        if (!last) { u32x2* o8 = (u32x2*)(XB + (size_t)row * D) + lane;
#pragma unroll
            for (int j = 0; j < 4; ++j) { hr[64 * j] = v[j]; u32x2 wv; wv.x = cvtpk(v[j][0], v[j][1]); wv.y = cvtpk(v[j][2], v[j][3]); o8[64 * j] = wv; }
            if (lane == 0) SS[row] = ssq;
        } else { const float rstd = 1.f / sqrtf(ssq * (1.f / D) + EPS); f32x4* orow = (f32x4*)(a.out + (size_t)row * D) + lane;
#pragma unroll
            for (int j = 0; j < 4; ++j) { const f32x4 gg = ((const f32x4*)g)[lane + 64 * j]; orow[64 * j] = v[j] * rstd * gg; } }
    }
}
__device__ __forceinline__ void moe_tables(const Args& a, int layer, LAS unsigned char* lds, const int tid) {
    LAS int* pre = (LAS int*)(lds + MISC_PRE); LAS int* cn = (LAS int*)(lds + MISC_CNT);
    const unsigned* cnt = (const unsigned*)(a.ws + WS_CTL) + CW_CNT + layer * 1024;
    __syncthreads();
    if (tid == 0) { int run = 0; for (int e = 0; e < 32; ++e) { const int c = (int)__hip_atomic_load(cnt + e * 16, __ATOMIC_RELAXED, __HIP_MEMORY_SCOPE_AGENT); cn[e] = c; pre[e] = run; run += (c + 255) >> 8; } pre[32] = run; }
    __syncthreads();
}

__global__ void __launch_bounds__(NTHREADS, 2) mega(Args args) {
    extern __shared__ __attribute__((aligned(16))) unsigned char lds_raw[];
    LAS unsigned char* lds = (LAS unsigned char*)lds_raw;
    const int G = gridDim.x;
    const int lo = args.ph_lo, hi = args.ph_hi;
#ifndef PH_MASK
#define PH_MASK 0x1ffff
#endif
#define IN(k) (((PH_MASK >> (k)) & 1) && lo <= (k) && (k) < hi)
#define SEAM(k) do { if (IN(k) && IN((k) + 1)) grid_barrier(args, lds); } while (0)
#define LA() const Args args = load_args(); unsigned char* ws = args.ws; (void)ws; int tid = threadIdx.x; asm volatile("" : "+v"(tid)); int bx = blockIdx.x; asm volatile("" : "+s"(bx)); \
    const int lane = tid & 63, wave = __builtin_amdgcn_readfirstlane(tid >> 6), vcu = (G % 8 == 0) ? (bx % 8) * (G / 8) + bx / 8 : bx, gw = vcu * NWAVES + wave, NGW = G * NWAVES; (void)lane; (void)gw; (void)NGW
    if (IN(0)) { LA(); p0_prologue(args, lds, gw, NGW, wave, lane); }
    SEAM(0);
    if (IN(1)) { LA(); fox_cumsum(args, lds, G, tid);
        pg8::Dense P; P.init((const bf16_t*)(ws + WS_XB), 1024, (const bf16_t*)(ws + WS_WIN0), N, 3072, 1024, G, bx);
        pg8::EpiQkv0 E{(bf16_t*)(ws + R1_QKV0), (const float*)(ws + WS_SS)};
        pg8::gemm_phase<pg8::EpiQkv0, pg8::Dense, false>(lds, P, E, tid); }
    SEAM(1);
    if (IN(2)) { LA(); attn_phase0(args, lds, vcu, G, tid); }
    SEAM(2);
    if (IN(3)) { LA(); merge_phase(args, gw, NGW, lane); }
    SEAM(3);
    for (int layer = 0; layer < 2; ++layer) {
        const int pb = layer == 0 ? 4 : 12;
        if (layer == 1) {
            if (IN(9)) { LA(); pg8::Dense P; P.init((const bf16_t*)(ws + WS_XB), 1024, (const bf16_t*)(ws + WS_WIN1), N, 1536, 1024, G, bx);
                pg8::EpiWin1 E{(bf16_t*)(ws + R1_Z1), (const float*)(ws + WS_SS), (float*)(ws + WS_SSZ), (const f32x2*)(ws + WS_ROPE)};
                pg8::gemm_phase<pg8::EpiWin1, pg8::Dense, false>(lds, P, E, tid); }
            SEAM(9);
            if (IN(10)) { LA();
#ifndef NO_UQ
 { pg8::Dense P; P.init((const bf16_t*)(ws + R1_Z1), 1536, (const bf16_t*)(ws + WS_WUQ), N, 768, 384, G, bx);
                  pg8::EpiUq E{(bf16_t*)(ws + R1_Q1), (const float*)(ws + WS_SSZ), (const f32x2*)(ws + WS_ROPE)};
                  pg8::gemm_phase<pg8::EpiUq, pg8::Dense, false>(lds, P, E, tid); }
#endif
#ifndef NO_UKV
                { pg8::Dense P; P.init((const bf16_t*)(ws + R1_Z1) + 512, 1536, (const bf16_t*)(ws + WS_WUKV), N, 1024, 256, G, bx);
                  pg8::EpiUkv E{(bf16_t*)(ws + R1_KV1), (const float*)(ws + WS_SSZ)};
                  pg8::gemm_phase<pg8::EpiUkv, pg8::Dense, false>(lds, P, E, tid); }
#endif
 }
            SEAM(10);
            if (IN(11)) { LA(); attn_phase1(args, lds, vcu, G, tid); }
            SEAM(11);
        }
        if (IN(pb)) { LA(); pg8::Dense P; P.init((const bf16_t*)(ws + R2_AO), 1024, (const bf16_t*)(ws + (layer == 0 ? WS_WOUT0 : WS_WOUT1)), N, 1024, 1024, G, bx);
            pg8::EpiOut E{layer == 0 ? args.in[0] : args.H, args.H, (bf16_t*)(ws + WS_XB), (float*)(ws + WS_SSP)};
            pg8::gemm_phase<pg8::EpiOut, pg8::Dense, false>(lds, P, E, tid); }
        SEAM(pb);
        if (IN(pb + 1)) { LA(); route_phase(args, layer, gw, NGW, lane); moe_convert(args, layer, lds, gw, NGW, wave, lane); }
        SEAM(pb + 1);
        if (IN(pb + 2)) { LA(); moe_tables(args, layer, lds, tid);
            pg8::MoeProb P{(const LAS int*)(lds + MISC_PRE), (const LAS int*)(lds + MISC_CNT), 2, G, vcu, 1024, 1024, (const bf16_t*)(ws + WS_XB), (const bf16_t*)(ws + R1_WGU), (size_t)512 * 1024, (const unsigned*)(ws + WS_LT), true};
            pg8::EpiGateUp E{(bf16_t*)(ws + R1_ACT), (const float*)(ws + WS_LW), (const float*)(ws + WS_LR)};
            pg8::gemm_phase<pg8::EpiGateUp, pg8::MoeProb, true>(lds, P, E, tid, (LAS unsigned*)(lds + MISC_STASH)); }
        SEAM(pb + 2);
        if (IN(pb + 3)) { LA(); moe_tables(args, layer, lds, tid);
            pg8::MoeProb P{(const LAS int*)(lds + MISC_PRE), (const LAS int*)(lds + MISC_CNT), 4, G, vcu, 256, 256, (const bf16_t*)(ws + R1_ACT), (const bf16_t*)(ws + R1_WD), (size_t)1024 * 256, (const unsigned*)(ws + WS_LT), false};
            pg8::EpiDown E{(bf16_t*)(ws + R2_Y), (const unsigned*)(ws + WS_LT)};
            pg8::gemm_phase<pg8::EpiDown, pg8::MoeProb, false>(lds, P, E, tid); }
        SEAM(pb + 3);
        if (IN(pb + 4)) { LA(); combine_phase(args, layer == 1, gw, NGW, lane); }
        if (layer == 0) SEAM(8);
    }
#undef IN
#undef SEAM
}
}
#ifndef HY
#define HY 15
#endif
#ifndef ONE_LAUNCH
#define ONE_LAUNCH 0
#endif
namespace mk {
__global__ void h_to_bf16(const float* __restrict__ H, bf16_t* __restrict__ XB, float* __restrict__ SS, float* __restrict__ SSP) {
    __shared__ float red[4];
    const size_t row = blockIdx.x; const float4 v = ((const float4*)(H + row * D))[threadIdx.x];
    const float ss = nv::block_sum256(v.x * v.x + v.y * v.y + v.z * v.z + v.w * v.w, red);
    u32x2 w; w.x = cvtpk(v.x, v.y); w.y = cvtpk(v.z, v.w); ((u32x2*)(XB + row * D))[threadIdx.x] = w;
    if (threadIdx.x == 0) SS[row] = ss;
    if (threadIdx.x < 16) SSP[row * 16 + threadIdx.x] = threadIdx.x == 0 ? ss : 0.f;
}
}

extern "C" void kernel_launch(void* const* d_in, const int* in_sizes, int n_in, void* d_out, int out_size, void* d_ws, size_t ws_size, hipStream_t stream) {
    using namespace mk;
    static int grid = 0;
    if (grid == 0) {
        if (n_in != 21 || out_size != N * D || ws_size < 283 * MiB) { fprintf(stderr, "kernel_launch: unexpected problem (n_in %d out %d ws %zu)\n", n_in, out_size, ws_size); grid = -1; return; }
        int dev = 0, cus = 0, per_cu = 0;
        if (hipGetDevice(&dev) != hipSuccess || hipDeviceGetAttribute(&cus, hipDeviceAttributeMultiprocessorCount, dev) != hipSuccess) { grid = -1; return; }
        if (hipFuncSetAttribute((const void*)mega, hipFuncAttributeMaxDynamicSharedMemorySize, LDS_BYTES) != hipSuccess) { fprintf(stderr, "kernel_launch: hipFuncSetAttribute failed\n"); grid = -1; return; }
        if (hipOccupancyMaxActiveBlocksPerMultiprocessor(&per_cu, (const void*)mega, NTHREADS, LDS_BYTES) != hipSuccess || per_cu < 1) { fprintf(stderr, "kernel_launch: occupancy query says %d blocks per CU\n", per_cu); (void)hipGetLastError(); grid = -1; return; }
        grid = cus;
    }
    if (grid < 0) return;
    Args a{};
    for (int i = 0; i < 21; ++i) a.in[i] = (const float*)d_in[i];
    a.out = (float*)d_out; a.ws = (unsigned char*)d_ws; a.H = (float*)d_out; a.use_bar = ONE_LAUNCH;
    float* ws = (float*)d_ws; float* out = (float*)d_out;
#if ONE_LAUNCH
    (void)hipMemsetAsync((char*)d_ws + WS_CTL, 0, CTL_ZERO_BYTES, stream);
    a.ph_lo = 0; a.ph_hi = NPHASE;
    { void* params[] = {&a}; hipError_t e = hipLaunchCooperativeKernel((const void*)mega, dim3(grid), dim3(NTHREADS), params, LDS_BYTES, stream);
      if (e != hipSuccess) fprintf(stderr, "cooperative launch failed: %s\n", hipGetErrorString(e)); }
#else
    const float* x = a.in[0]; const float* attn_norm = a.in[1]; const float* ffn_norm = a.in[2]; const float* final_norm = a.in[3];
    float* H = out; float* T = ws + 4 * MiB; float* Z = ws + 20 * MiB; float* CB = Z + (size_t)N * 3080;
    float* Z1 = Z; float* Q1 = Z1 + (size_t)N * 1440; float* KV = Q1 + (size_t)N * 768;
    const int plo[4] = {1, 5, 9, 13}, phi[4] = {5, 9, 13, 17};
    bool prev_naive = false;
    for (int part = 0; part < 4; ++part) {
        if ((HY >> part) & 1) {
            if (part == 0 || prev_naive) {
                (void)hipMemsetAsync((char*)d_ws + WS_CTL, 0, CTL_ZERO_BYTES, stream);
                a.ph_lo = 0; a.ph_hi = 1; hipLaunchKernelGGL(mega, dim3(grid), dim3(NTHREADS), LDS_BYTES, stream, a);
                if (part != 0) h_to_bf16<<<N, 256, 0, stream>>>(H, (bf16_t*)((char*)d_ws + WS_XB), (float*)((char*)d_ws + WS_SS), (float*)((char*)d_ws + WS_SSP));
            }
            for (int p = plo[part]; p < phi[part]; ++p) { a.ph_lo = p; a.ph_hi = p + 1; hipLaunchKernelGGL(mega, dim3(grid), dim3(NTHREADS), LDS_BYTES, stream, a); }
            prev_naive = false;
        } else {
            if (part == 0) {
                nv::rmsnorm_rows<<<N, 256, 0, stream>>>(x, attn_norm, T);
                nv::gemm_f32<<<dim3((3080 + 63) / 64, N / 64), 256, 0, stream>>>(T, 1024, a.in[4], 3080, Z, 3080, N, 3080, 1024, nullptr, 0);
                nv::fox_cumsum<<<32, 256, 0, stream>>>(Z, a.in[5], CB);
                nv::fox_attn<<<dim3(S / 64, 8, 4), 64, 0, stream>>>(Z, CB, T);
                nv::dil_attn<<<dim3(S / 64, 8, 4), 64, 0, stream>>>(Z, T);
                nv::gemm_f32<<<dim3(1024 / 64, N / 64), 256, 0, stream>>>(T, 1024, a.in[6], 1024, H, 1024, N, 1024, 1024, x, 1024);
            } else if (part == 1) {
                nv::moe_token<<<N, 256, 0, stream>>>(H, ffn_norm, a.in[14], a.in[15], a.in[16], a.in[17], a.in[18], a.in[19], a.in[20]);
            } else if (part == 2) {
                nv::rmsnorm_rows<<<N, 256, 0, stream>>>(H, attn_norm + 1024, T);
                nv::gemm_f32<<<dim3((1440 + 63) / 64, N / 64), 256, 0, stream>>>(T, 1024, a.in[7], 1440, Z1, 1440, N, 1440, 1024, nullptr, 0);
                nv::rmsnorm_sub<<<N, 64, 0, stream>>>(Z1, 1440, a.in[8], Z1, 1440, 384);
                nv::rmsnorm_sub<<<N, 64, 0, stream>>>(Z1 + 384, 1440, a.in[9], Z1 + 384, 1440, 256);
                nv::gemm_f32<<<dim3(768 / 64, N / 64), 256, 0, stream>>>(Z1, 1440, a.in[10], 768, Q1, 768, N, 768, 384, nullptr, 0);
                nv::gemm_f32<<<dim3(1024 / 64, N / 64), 256, 0, stream>>>(Z1 + 384, 1440, a.in[11], 1024, KV, 1024, N, 1024, 256, nullptr, 0);
                nv::rope32<<<(N * 8 * 16 + 255) / 256, 256, 0, stream>>>(Q1, 768, 8, 96, 64);
                nv::rope32<<<(N * 16 + 255) / 256, 256, 0, stream>>>(Z1, 1440, 1, 0, 640);
                nv::mla_attn<<<dim3(S / 64, 8, 4), 64, 0, stream>>>(Q1, KV, Z1, T);
                nv::swa_attn<<<dim3(S / 64, 8, 4), 64, 0, stream>>>(Z1, a.in[12], T);
                nv::gemm_f32<<<dim3(1024 / 64, N / 64), 256, 0, stream>>>(T, 1024, a.in[13], 1024, H, 1024, N, 1024, 1024, H, 1024);
            } else {
                nv::moe_token<<<N, 256, 0, stream>>>(H, ffn_norm + 1024, a.in[14] + 1024 * 4, a.in[15] + 4, a.in[16] + 1024 * 32, a.in[17] + 32, a.in[18] + (size_t)32 * 1024 * 256, a.in[19] + (size_t)32 * 1024 * 256, a.in[20] + (size_t)32 * 256 * 1024);
                nv::rmsnorm_rows<<<N, 256, 0, stream>>>(H, final_norm, out);
            }
            prev_naive = true;
        }
    }
#endif
}
```

```cpp
#define CONV_IN_WOUT 3
#include <hip/hip_runtime.h>
#include <cstdio>
#include <cstdint>
#include <cmath>
#define LAS __attribute__((address_space(3)))
#define GAS __attribute__((address_space(1)))
typedef unsigned short bf16_t;
typedef short bf16x8 __attribute__((ext_vector_type(8)));
typedef short s16x4 __attribute__((ext_vector_type(4)));
typedef float f32x2 __attribute__((ext_vector_type(2)));
typedef float f32x4 __attribute__((ext_vector_type(4)));
typedef float f32x16 __attribute__((ext_vector_type(16)));
typedef unsigned u32x2 __attribute__((ext_vector_type(2)));
typedef unsigned u32x4 __attribute__((ext_vector_type(4)));
typedef __bf16 bf16x2_t __attribute__((ext_vector_type(2)));
__device__ __forceinline__ unsigned cvtpk(float lo, float hi) { f32x2 v = {lo, hi}; bf16x2_t b = __builtin_convertvector(v, bf16x2_t); return __builtin_bit_cast(unsigned, b); }
__device__ __forceinline__ float bf2f(unsigned short u) { return __uint_as_float((unsigned)u << 16); }
__device__ __forceinline__ float bflo(unsigned u) { return __uint_as_float(u << 16); }
__device__ __forceinline__ float bfhi(unsigned u) { return __uint_as_float(u & 0xffff0000u); }
#ifndef WT_G
#define WT_G 0
#endif
#ifndef WT_A
#define WT_A 0
#endif
#ifndef WT_S
#define WT_S 0
#endif
template <int WTF> __device__ __forceinline__ void st16x(void* p, int off, u32x4 v) {
    if constexpr (WTF) asm volatile("global_store_dwordx4 %0, %1, off offset:%2 sc1\n\ts_nop 1" :: "v"(p), "v"(v), "i"(off) : "memory");
    else *(u32x4*)((char*)p + off) = v;
}
template <int WTF> __device__ __forceinline__ void st8x(void* p, int off, u32x2 v) {
    if constexpr (WTF) asm volatile("global_store_dwordx2 %0, %1, off offset:%2 sc1" :: "v"(p), "v"(v), "i"(off) : "memory");
    else *(u32x2*)((char*)p + off) = v;
}
template <int WTF> __device__ __forceinline__ void st4x(void* p, int off, unsigned v) {
    if constexpr (WTF) asm volatile("global_store_dword %0, %1, off offset:%2 sc1" :: "v"(p), "v"(v), "i"(off) : "memory");
    else *(unsigned*)((char*)p + off) = v;
}
#define st16g st16x<WT_G>
#define st8g  st8x<WT_G>
#define st16a st16x<WT_A>
#define st16s st16x<WT_S>
#define st8s  st8x<WT_S>
__device__ __forceinline__ void st16fs(void* p, int off, f32x4 v) { st16x<WT_S>(p, off, __builtin_bit_cast(u32x4, v)); }

namespace pg8 {
constexpr int BM = 256, BK = 64, HALF = 128, HTB = HALF * BK * 2  , STAGE_BYTES = 8 * HTB, NXCD = 8, WGM = 8;
__host__ __device__ __forceinline__ int lds_byte(int r, int c) { const int st = (r >> 4) * 2 + (c >> 5), rr = r & 15, cc = c & 31, ob = rr * 64 + cc * 2; return st * 1024 + (ob ^ (((ob >> 9) & 1) << 5)); }
__host__ __device__ __forceinline__ void stage_rc(int b, int& R, int& C) { const int st = b / 1024, sb = b % 1024, swz = sb ^ (((sb >> 9) & 1) << 5); R = (st >> 1) * 16 + swz / 64; C = (st & 1) * 32 + (swz % 64) / 2; }
__host__ __device__ __forceinline__ int perm32(int rho) { const int n = rho >> 4, i = rho & 15; return 8 * (i >> 2) + 4 * n + (i & 3); }

struct Unit { int pm, pn, e, rt, rows; };

template <int MODE>
struct DenseT {
    static constexpr bool ROWSKIP = false;
    const bf16_t* A; const bf16_t* Bt; int lda, K; int nM, nN, nwg, G, c; unsigned* ready; unsigned need; int sel;
    __device__ void init(const bf16_t* A_, int lda_, const bf16_t* Bt_, int M, int N, int K_, int G_, int c_) { A = A_; lda = lda_; Bt = Bt_; K = K_; nM = M / BM; nN = N / BM; nwg = nM * nN; G = G_; c = c_; ready = nullptr; need = 0u; sel = 0; }
    __device__ __forceinline__ bool next(int i, Unit& u) const {
        const long L = (long)i * G + c; if (L >= nwg) return false;
        int wgid = (int)L; { const int q = nwg / NXCD, r = nwg % NXCD, xcd = wgid % NXCD, off = wgid / NXCD; wgid = (xcd < r ? xcd * (q + 1) : r * (q + 1) + (xcd - r) * q) + off; }
        const int nig = WGM * nN, gid = wgid / nig, fm = gid * WGM, gsz = (nM - fm) < WGM ? (nM - fm) : WGM;
        u.pm = fm + ((wgid % nig) % gsz); u.pn = (wgid % nig) / gsz; u.e = 0; u.rt = 0; u.rows = 256; return true;
    }
    __device__ __forceinline__ const char* a_base(const Unit& u) const { return (const char*)A + (size_t)u.pm * BM * lda * 2; }
    __device__ __forceinline__ const char* b_base(const Unit& u) const { return (const char*)Bt + (size_t)u.pn * BM * K * 2; }
    __device__ __forceinline__ void a_ready(const Unit& u) const {
        if constexpr (MODE == 2) {
            if (threadIdx.x < 64) {
                unsigned polls = 0;
                while ((unsigned)__builtin_amdgcn_readfirstlane((int)__hip_atomic_load(ready + 32 * (2 * u.pm + sel), __ATOMIC_RELAXED, __HIP_MEMORY_SCOPE_AGENT)) < need) {
                    __builtin_amdgcn_s_sleep(2); if (++polls > (1u << 19)) break; }
                __builtin_amdgcn_fence(__ATOMIC_ACQUIRE, "agent");
                asm volatile("s_waitcnt vmcnt(0)" ::: "memory");
            }
            asm volatile("" ::: "memory"); __builtin_amdgcn_s_barrier(); asm volatile("" ::: "memory");
        }
    }
    __device__ __forceinline__ void done(const Unit& u) const {
        if constexpr (MODE == 1) {
            if (u.pn < 3) {
                asm volatile("s_waitcnt vmcnt(0)" ::: "memory");
                if ((threadIdx.x & 63) == 0) __hip_atomic_fetch_add(ready + 32 * (2 * u.pm + (u.pn == 2 ? 1 : 0)), 1u, __ATOMIC_RELAXED, __HIP_MEMORY_SCOPE_AGENT); }
        }
    }
    __device__ __forceinline__ void a_voff(const Unit&, int R0, int C0, int R1, int C1, unsigned (&vo)[2][2]) const {
        vo[0][0] = (unsigned)(R0 * lda + C0) * 2u; vo[0][1] = (unsigned)(R1 * lda + C1) * 2u; vo[1][0] = vo[0][0]; vo[1][1] = vo[0][1]; }
    __device__ __forceinline__ size_t a_hstep() const { return (size_t)HALF * lda * 2; }
};
using Dense = DenseT<0>;

__device__ __forceinline__ void glds_s(const char* sbase, unsigned voff, unsigned lds_dst) { unsigned keep;
    asm volatile("s_mov_b32 %0, m0\n\ts_mov_b32 m0, %2\n\ts_nop 0\n\tglobal_load_lds_dwordx4 %1, %3\n\ts_mov_b32 m0, %0" : "=&s"(keep) : "v"(voff), "s"(lds_dst), "s"(sbase) : "memory"); }
template <class Epi, class Prob, bool GATHER>
__device__ __forceinline__ void gemm_phase(LAS unsigned char* lds, const Prob& S, const Epi& E, const int tid, LAS unsigned* stash = nullptr) {
    const int wid = __builtin_amdgcn_readfirstlane(tid >> 6), lane = tid & 63, wr = wid >> 2, wc = wid & 3, fr = lane & 15, fq = lane >> 4;
    const int K = S.K, nt = K / BK;
    int R0, C0, R1, C1; stage_rc(tid * 16, R0, C0); stage_rc(tid * 16 + 8192, R1, C1);
    unsigned voffB[2];
    { const int Rb0 = Epi::WIDE ? ((R0 >> 5) * 64 + perm32(R0 & 31)) : Epi::PERM ? ((R0 & ~31) + perm32(R0 & 31)) : R0, Rb1 = Epi::WIDE ? ((R1 >> 5) * 64 + perm32(R1 & 31)) : Epi::PERM ? ((R1 & ~31) + perm32(R1 & 31)) : R1;
      voffB[0] = (unsigned)(Rb0 * K + C0) * 2u; voffB[1] = (unsigned)(Rb1 * K + C1) * 2u; }
    const size_t kstep = (size_t)(BK * 2);
    const size_t hstepB = (size_t)(Epi::WIDE ? 32 : HALF) * K * 2;
    const size_t hstepA = GATHER ? 0 : S.a_hstep();
    const unsigned ldsb = (unsigned)(uintptr_t)lds + (unsigned)wid * 1024u;
    const int aoff = lds_byte(wr * 64 + fr, fq * 8), boff = lds_byte(wc * 32 + fr, fq * 8);
#define PG8_SA(b, h) (((b) * 2 + (h)) * HTB)
#define PG8_SB(b, h) ((4 + (b) * 2 + (h)) * HTB)
#define PG8_STAGE(bufoff, gbase, voff) do { _Pragma("unroll") for (int _i = 0; _i < 2; ++_i) \
        glds_s((const char*)(gbase), (voff)[_i], ldsb + (unsigned)((bufoff) + _i * 8192)); } while (0)
#define PG8_LDA(dst, b, h) do { _Pragma("unroll") for (int m = 0; m < 4; ++m) _Pragma("unroll") for (int k = 0; k < 2; ++k) dst[m][k] = *(const LAS bf16x8*)(lds + PG8_SA(b, h) + aoff + m * 2048 + k * 1024); } while (0)
#define PG8_LDB(dst, b, h) do { _Pragma("unroll") for (int n = 0; n < 2; ++n) _Pragma("unroll") for (int k = 0; k < 2; ++k) dst[n][k] = *(const LAS bf16x8*)(lds + PG8_SB(b, h) + boff + n * 2048 + k * 1024); } while (0)
#define PG8_MMA(ai, bj, At, Bt) do { __builtin_amdgcn_s_setprio(1); _Pragma("unroll") for (int m = 0; m < 4; ++m) { if (!Prob::ROWSKIP || (ai) * HALF + wr * 64 + m * 16 < rows_cur) { _Pragma("unroll") for (int n = 0; n < 2; ++n) _Pragma("unroll") for (int k = 0; k < 2; ++k) \
        acc[ai][bj][m][n] = __builtin_amdgcn_mfma_f32_16x16x32_bf16(Bt[n][k], At[m][k], acc[ai][bj][m][n], 0, 0, 0); } } __builtin_amdgcn_s_setprio(0); } while (0)
#define PG8_WAIT_V(n) asm volatile("s_waitcnt vmcnt(" #n ")" ::: "memory")
#define PG8_WAIT_L(n) asm volatile("s_waitcnt lgkmcnt(" #n ")" ::: "memory")
#define PG8_BAR __builtin_amdgcn_s_barrier()
#define PG8_SCHED __builtin_amdgcn_sched_barrier(0)
    Unit cur, nxt; int ui = 0;
    if (!S.next(0, cur)) return;
    bool has_next = S.next(1, nxt);
    unsigned voffA[2][2];
    S.a_voff(cur, R0, C0, R1, C1, voffA);
    LAS u32x4* const st4 = (LAS u32x4*)stash + tid;
    if (GATHER) { unsigned vn[2][2]; if (has_next) S.a_voff(nxt, R0, C0, R1, C1, vn); else { vn[0][0] = voffA[0][0]; vn[0][1] = voffA[0][1]; vn[1][0] = voffA[1][0]; vn[1][1] = voffA[1][1]; }
        *st4 = (u32x4){vn[0][0], vn[0][1], vn[1][0], vn[1][1]};
        asm volatile("s_waitcnt vmcnt(0)" : "+v"(voffA[0][0]), "+v"(voffA[0][1]), "+v"(voffA[1][0]), "+v"(voffA[1][1]) :: "memory"); }
    f32x4 acc[2][2][4][2];
#pragma unroll
    for (int a = 0; a < 2; ++a)
#pragma unroll
        for (int b = 0; b < 2; ++b)
#pragma unroll
            for (int m = 0; m < 4; ++m)
#pragma unroll
                for (int n = 0; n < 2; ++n) acc[a][b][m][n] = (f32x4){0.f, 0.f, 0.f, 0.f};
    bf16x8 At[4][2], B0[2][2], B1[2][2];
    const char* cA = S.a_base(cur); const char* cB = S.b_base(cur); int rows_cur = cur.rows; (void)rows_cur;
    S.a_ready(cur);
    PG8_STAGE(PG8_SB(0, 0), cB, voffB); PG8_STAGE(PG8_SB(0, 1), cB + hstepB, voffB); PG8_STAGE(PG8_SA(0, 0), cA, voffA[0]); PG8_STAGE(PG8_SA(0, 1), cA + hstepA, voffA[1]);
    if (wr == 1) PG8_BAR;
    PG8_WAIT_V(2); PG8_BAR;
    PG8_STAGE(PG8_SB(1, 0), cB + kstep, voffB); PG8_STAGE(PG8_SA(1, 0), cA + kstep, voffA[0]); PG8_STAGE(PG8_SB(1, 1), cB + hstepB + kstep, voffB);
    PG8_WAIT_V(6); PG8_BAR;
    for (;;) {
        const char* nA = has_next ? S.a_base(nxt) : cA; const char* nB = has_next ? S.b_base(nxt) : cB;
#pragma unroll 1
        for (int t = 0; t < nt; t += 2) {
            const bool last = (t == nt - 2);
            if (last && has_next) S.a_ready(nxt);
            const char* a1 = cA + (size_t)(t + 1) * kstep;
            const char* a2 = last ? nA : cA + (size_t)(t + 2) * kstep; const char* b2 = last ? nB : cB + (size_t)(t + 2) * kstep;
            const char* a3 = a2 + kstep; const char* b3 = b2 + kstep;
            unsigned v20 = voffA[0][0], v21 = voffA[0][1], v30 = voffA[1][0], v31 = voffA[1][1];
            if (GATHER) { if (last) { const u32x4 n4 = *st4; v20 = n4.x; v21 = n4.y; v30 = n4.z; v31 = n4.w; } }
            const unsigned vh0[2] = {v20, v21}, vh1[2] = {v30, v31};
            PG8_LDB(B0, 0, 0); PG8_LDB(B1, 0, 1); PG8_SCHED; PG8_LDA(At, 0, 0); PG8_STAGE(PG8_SA(1, 1), a1 + hstepA, voffA[1]);
            PG8_WAIT_V(8); PG8_WAIT_L(0); PG8_BAR; PG8_MMA(0, 0, At, B0); PG8_MMA(0, 1, At, B1); PG8_BAR; PG8_SCHED;
            PG8_LDA(At, 0, 1); PG8_STAGE(PG8_SB(0, 0), b2, voffB); PG8_STAGE(PG8_SB(0, 1), b2 + hstepB, voffB); PG8_STAGE(PG8_SA(0, 0), a2, vh0);
            PG8_WAIT_V(8); PG8_WAIT_L(0); PG8_BAR; PG8_MMA(1, 0, At, B0); PG8_MMA(1, 1, At, B1); PG8_BAR; PG8_SCHED;
            PG8_LDB(B0, 1, 0); PG8_LDB(B1, 1, 1); PG8_SCHED; PG8_LDA(At, 1, 0); PG8_STAGE(PG8_SA(0, 1), a2 + hstepA, vh1);
            PG8_WAIT_V(8); PG8_WAIT_L(0); PG8_BAR; PG8_MMA(0, 0, At, B0); PG8_MMA(0, 1, At, B1); PG8_BAR; PG8_SCHED;
            PG8_LDA(At, 1, 1); PG8_STAGE(PG8_SB(1, 0), b3, voffB); PG8_STAGE(PG8_SB(1, 1), b3 + hstepB, voffB); PG8_STAGE(PG8_SA(1, 0), a3, vh0);
            PG8_WAIT_V(8); PG8_WAIT_L(0); PG8_BAR; PG8_MMA(1, 0, At, B0); PG8_MMA(1, 1, At, B1); PG8_BAR; PG8_SCHED;
        }
        if (wr == 0) PG8_BAR;
        { int fr_e = fr, fq_e = fq; asm volatile("" : "+v"(fr_e), "+v"(fq_e));
          E(acc, cur, wr, wc, fr_e, fq_e); }
        S.done(cur);
        if (!has_next) break;
#pragma unroll
        for (int a = 0; a < 2; ++a)
#pragma unroll
            for (int b = 0; b < 2; ++b)
#pragma unroll
                for (int m = 0; m < 4; ++m)
#pragma unroll
                    for (int n = 0; n < 2; ++n) acc[a][b][m][n] = (f32x4){0.f, 0.f, 0.f, 0.f};
        cur = nxt; cA = nA; cB = nB; ++ui; rows_cur = cur.rows;
        has_next = S.next(ui + 1, nxt);
        if (GATHER) {
            { const u32x4 n4 = *st4; voffA[0][0] = n4.x; voffA[0][1] = n4.y; voffA[1][0] = n4.z; voffA[1][1] = n4.w; }
            if (has_next) { unsigned vn[2][2]; S.a_voff(nxt, R0, C0, R1, C1, vn);
                asm volatile("s_waitcnt vmcnt(0)" : "+v"(vn[0][0]), "+v"(vn[0][1]), "+v"(vn[1][0]), "+v"(vn[1][1]) :: "memory");
                *st4 = (u32x4){vn[0][0], vn[0][1], vn[1][0], vn[1][1]}; }
        }
        if (wr == 1) PG8_BAR;
    }
    PG8_WAIT_V(0);
    PG8_BAR;
#undef PG8_SA
#undef PG8_SB
#undef PG8_STAGE
#undef PG8_LDA
#undef PG8_LDB
#undef PG8_MMA
#undef PG8_WAIT_V
#undef PG8_WAIT_L
#undef PG8_BAR
#undef PG8_SCHED
}
}
namespace mk {
constexpr int NB = 4, S = 4096, D = 1024, N = NB * S;
constexpr float EPS = 1e-6f, LOG2E = 1.4426950408889634f;
constexpr float C2_64 = 0.125f * LOG2E, C2_96 = 0.10206207261596575f * LOG2E;
constexpr size_t MiB = 1u << 20;
constexpr size_t WS_CTL = 0, CTL_ZERO_BYTES = 1 * MiB;
constexpr size_t WS_SS = 1 * MiB;
constexpr size_t WS_RSTD = WS_SS + (size_t)N * 4;
constexpr size_t WS_SSP = WS_RSTD + (size_t)N * 4;
constexpr size_t WS_LOGF = WS_SSP + (size_t)N * 64;
constexpr size_t WS_CB2 = WS_LOGF + (size_t)N * 32;
constexpr size_t WS_ROPE = WS_CB2 + (size_t)32 * S * 4;
constexpr size_t WS_DLSE = WS_ROPE + (size_t)S * 16 * 8;
constexpr size_t WS_SSZ = WS_DLSE + (size_t)3 * N * 32;
constexpr size_t WS_LT = WS_SSZ + (size_t)N * 48;
constexpr size_t WS_LW = WS_LT + (size_t)32 * N * 4;
constexpr size_t WS_LR = WS_LW + (size_t)32 * N * 4;
constexpr size_t WS_SMALL_END = WS_LR + (size_t)32 * N * 4;
constexpr size_t WS_KEXT = WS_LT;
static_assert(WS_SMALL_END <= 13 * MiB, "small arrays");
constexpr size_t WS_WIN0 = 13 * MiB;
constexpr size_t WS_WOUT0 = WS_WIN0 + 6 * MiB;
constexpr size_t WS_WIN1 = WS_WOUT0 + 2 * MiB;
constexpr size_t WS_WUQ = WS_WIN1 + 3 * MiB;
constexpr size_t WS_WUKV = WS_WUQ + 768 * 384 * 2;
constexpr size_t WS_WOUT1 = WS_WUKV + 1024 * 256 * 2;
constexpr size_t WS_WR = WS_WOUT1 + 2 * MiB;
static_assert(WS_WR + 2 * 64 * 1024 * 2 <= 28 * MiB, "weights");
constexpr size_t WS_XB = 28 * MiB;
constexpr size_t WS_R1 = 60 * MiB;
constexpr size_t WS_R2 = 164 * MiB;
constexpr size_t WS_END = 244 * MiB;
constexpr size_t R1_QKV0 = WS_R1;
constexpr size_t R1_Z1 = WS_R1, R1_Q1 = WS_R1 + 48 * MiB, R1_KV1 = WS_R1 + 72 * MiB;
constexpr size_t R1_WGU = WS_R1, R1_WD = WS_R1 + 32 * MiB, R1_ACT = WS_R1 + 48 * MiB;
constexpr size_t R2_AO = WS_R2, R2_DPART = WS_R2 + 32 * MiB;
constexpr size_t R2_Y = WS_R2;
constexpr size_t Y1_BASE = 128 * MiB;
constexpr size_t R2_WGU1 = WS_R2 + 32 * MiB, R2_WD1 = WS_R2 + 64 * MiB;
constexpr int CW_CNT = 64;
constexpr int CW_BAR = 4096;
constexpr int CW_RDY3 = 65536;
constexpr int CW_RDY2 = 49152;
constexpr int CW_RDY = 16384;
}

#ifndef WIDE_QKV
#define WIDE_QKV 0
#endif
namespace pg8 {
using mk::EPS;
struct EpiQkv0 {
    static constexpr bool PERM = true; static constexpr bool WIDE = (WIDE_QKV != 0);
    bf16_t* O; const float* ss;
    __device__ __forceinline__ void operator()(const f32x4 (&acc)[2][2][4][2], const Unit& u, int wr, int wc, int fr, int fq) const {
        const int row0 = u.pm * BM + wr * 64 + fr, col0 = u.pn * BM + (WIDE ? wc * 64 : wc * 32) + 8 * fq;
        const float sc = (u.pn < 2 || u.pn == 6 || u.pn == 7) ? mk::C2_64 : 1.f;
        float rs[8];
#pragma unroll
        for (int i = 0; i < 8; ++i) rs[i] = ss[row0 + (i >> 2) * HALF + (i & 3) * 16];
#pragma unroll
        for (int i = 0; i < 8; ++i) rs[i] = sc / sqrtf(rs[i] * (1.f / 1024.f) + EPS);
#pragma unroll
        for (int ai = 0; ai < 2; ++ai)
#pragma unroll
            for (int m = 0; m < 4; ++m) { const int row = row0 + ai * HALF + m * 16; const float r_ = rs[ai * 4 + m];
                bf16_t* rowp = O + (size_t)row * 3072 + col0;
#pragma unroll
                for (int bj = 0; bj < 2; ++bj) { const f32x4 v0 = acc[ai][bj][m][0] * r_, v1 = acc[ai][bj][m][1] * r_;
                    u32x4 w; w.x = cvtpk(v0[0], v0[1]); w.y = cvtpk(v0[2], v0[3]); w.z = cvtpk(v1[0], v1[1]); w.w = cvtpk(v1[2], v1[3]);
                    st16g(rowp, WIDE ? bj * 64 : bj * HALF * 2, w); } }
    }
};
struct EpiOut {
    static constexpr bool PERM = false; static constexpr bool WIDE = false;
    bf16_t* X; float* ssp;
    __device__ __forceinline__ void operator()(const f32x4 (&acc)[2][2][4][2], const Unit& u, int wr, int wc, int fr, int fq) const {
        const int row0 = u.pm * BM + wr * 64 + fr, col0 = u.pn * BM + wc * 32 + 4 * fq;
        u32x2 rb[8][4];
#pragma unroll
        for (int i = 0; i < 8; ++i) { const size_t off = (size_t)(row0 + (i >> 2) * HALF + (i & 3) * 16) * 1024 + col0;
#pragma unroll
            for (int qq = 0; qq < 4; ++qq) rb[i][qq] = *(const u32x2*)(X + off + (qq >> 1) * HALF + (qq & 1) * 16); }
#pragma unroll
        for (int i = 0; i < 8; ++i) { const int ai = i >> 2, m = i & 3; const int row = row0 + ai * HALF + m * 16; const size_t off = (size_t)row * 1024 + col0; float q = 0.f;
#pragma unroll
            for (int qq = 0; qq < 4; ++qq) { const f32x4 a4 = acc[ai][qq >> 1][m][qq & 1]; const u32x2 r2 = rb[i][qq];
                const float v0 = bflo(r2.x) + a4[0], v1 = bfhi(r2.x) + a4[1], v2 = bflo(r2.y) + a4[2], v3 = bfhi(r2.y) + a4[3];
                u32x2 w; w.x = cvtpk(v0, v1); w.y = cvtpk(v2, v3); st8g(X + off, ((qq >> 1) * HALF + (qq & 1) * 16) * 2, w);
                q += (v0 * v0 + v1 * v1) + (v2 * v2 + v3 * v3); }
            q += __shfl_xor(q, 16); q += __shfl_xor(q, 32);
            if (fq == 0) ssp[(size_t)row * 16 + u.pn * 4 + wc] = q; }
    }
};
struct EpiWin1 {
    static constexpr bool PERM = false; static constexpr bool WIDE = false;
    bf16_t* Z; const float* ss; float* ssz; const f32x2* rope;
    __device__ __forceinline__ void operator()(const f32x4 (&acc)[2][2][4][2], const Unit& u, int wr, int wc, int fr, int fq) const {
        const int row0 = u.pm * BM + wr * 64 + fr, col0 = u.pn * BM + wc * 32 + 4 * fq; const int pn = u.pn;
        const float sc = (pn == 3 || pn == 4) ? mk::C2_64 : 1.f; const bool ropew = (pn == 1 && wc == 0);
        float rs[8];
#pragma unroll
        for (int i = 0; i < 8; ++i) rs[i] = ss[row0 + (i >> 2) * HALF + (i & 3) * 16];
#pragma unroll
        for (int i = 0; i < 8; ++i) rs[i] = sc / sqrtf(rs[i] * (1.f / 1024.f) + EPS);
#pragma unroll
        for (int ai = 0; ai < 2; ++ai) {
            f32x4 cs[4][2];
            if (ropew) {
#pragma unroll
                for (int m = 0; m < 4; ++m) { const f32x4* rp = (const f32x4*)(rope + (size_t)((row0 + ai * HALF + m * 16) & (mk::S - 1)) * 16 + 4 * fq); cs[m][0] = rp[0]; cs[m][1] = rp[1]; } }
#pragma unroll
            for (int m = 0; m < 4; ++m) { const int row = row0 + ai * HALF + m * 16; const float r_ = rs[ai * 4 + m];
                bf16_t* rowp = Z + (size_t)row * 1536 + col0; float q = 0.f;
#pragma unroll
                for (int bj = 0; bj < 2; ++bj) { f32x4 v0 = acc[ai][bj][m][0] * r_, v1 = acc[ai][bj][m][1] * r_;
                    if (pn == 1 && bj == 1) {
                        if (wc != 0) continue;
#pragma unroll
                        for (int j = 0; j < 4; ++j) { const float c_ = cs[m][j >> 1][2 * (j & 1)], s_ = cs[m][j >> 1][2 * (j & 1) + 1]; const float t1 = v0[j], t2 = v1[j]; v0[j] = t1 * c_ - t2 * s_; v1[j] = t1 * s_ + t2 * c_; }
                    } else if (pn < 3) q += (v0[0] * v0[0] + v0[1] * v0[1]) + (v0[2] * v0[2] + v0[3] * v0[3]) + (v1[0] * v1[0] + v1[1] * v1[1]) + (v1[2] * v1[2] + v1[3] * v1[3]);
                    u32x2 w0, w1; w0.x = cvtpk(v0[0], v0[1]); w0.y = cvtpk(v0[2], v0[3]); w1.x = cvtpk(v1[0], v1[1]); w1.y = cvtpk(v1[2], v1[3]);
                    st8x<1>(rowp, bj * HALF * 2, w0); st8x<1>(rowp, bj * HALF * 2 + 32, w1); }
                if (pn < 3) { q += __shfl_xor(q, 16); q += __shfl_xor(q, 32); if (fq == 0) st4x<1>(ssz + (size_t)row * 12 + pn * 4 + wc, 0, __float_as_uint(q)); } }
        }
    }
};
struct EpiUq {
    static constexpr bool PERM = false; static constexpr bool WIDE = false;
    bf16_t* Q; const float* ssz; const f32x2* rope;
    __device__ __forceinline__ void operator()(const f32x4 (&acc)[2][2][4][2], const Unit& u, int wr, int wc, int fr, int fq) const {
        const int row0 = u.pm * BM + wr * 64 + fr, col0 = u.pn * BM + wc * 32 + 4 * fq;
        const bool rp0 = ((u.pn * 8 + wc) % 3 == 2), rp1 = ((u.pn * 8 + 4 + wc) % 3 == 2);
        float rs[8];
#pragma unroll
        for (int hb = 0; hb < 2; ++hb) { f32x4 sa[4], sb[4];
#pragma unroll
          for (int i = 0; i < 4; ++i) { const f32x4* sp = (const f32x4*)(ssz + (size_t)(row0 + hb * HALF + i * 16) * 12); sa[i] = sp[0]; sb[i] = sp[1]; }
#pragma unroll
          for (int i = 0; i < 4; ++i) rs[hb * 4 + i] = mk::C2_96 / sqrtf(((sa[i][0] + sa[i][1]) + (sa[i][2] + sa[i][3]) + (sb[i][0] + sb[i][1]) + (sb[i][2] + sb[i][3])) * (1.f / 384.f) + EPS);
          asm volatile("" ::: "memory"); }
#pragma unroll
        for (int ai = 0; ai < 2; ++ai)
#pragma unroll
            for (int mp = 0; mp < 2; ++mp) {
                f32x4 cs[2][2];
                if (rp0 || rp1) {
#pragma unroll
                    for (int mm = 0; mm < 2; ++mm) { const f32x4* rp = (const f32x4*)(rope + (size_t)((row0 + ai * HALF + (2 * mp + mm) * 16) & (mk::S - 1)) * 16 + 4 * fq); cs[mm][0] = rp[0]; cs[mm][1] = rp[1]; } }
#pragma unroll
                for (int mm = 0; mm < 2; ++mm) { const int m = 2 * mp + mm; const int row = row0 + ai * HALF + m * 16; const float r_ = rs[ai * 4 + m];
                    bf16_t* rowp = Q + (size_t)row * 768 + col0;
#pragma unroll
                    for (int bj = 0; bj < 2; ++bj) { f32x4 v0 = acc[ai][bj][m][0] * r_, v1 = acc[ai][bj][m][1] * r_;
                        if (bj == 0 ? rp0 : rp1) {
#pragma unroll
                            for (int j = 0; j < 4; ++j) { const float c_ = cs[mm][j >> 1][2 * (j & 1)], s_ = cs[mm][j >> 1][2 * (j & 1) + 1]; const float t1 = v0[j], t2 = v1[j]; v0[j] = t1 * c_ - t2 * s_; v1[j] = t1 * s_ + t2 * c_; } }
                        u32x2 w0, w1; w0.x = cvtpk(v0[0], v0[1]); w0.y = cvtpk(v0[2], v0[3]); w1.x = cvtpk(v1[0], v1[1]); w1.y = cvtpk(v1[2], v1[3]);
                        st8g(rowp, bj * HALF * 2, w0); st8g(rowp, bj * HALF * 2 + 32, w1); } }
                asm volatile("" ::: "memory"); }
    }
};
struct EpiUkv {
    static constexpr bool PERM = true; static constexpr bool WIDE = false;
    bf16_t* O; const float* ssz;
    __device__ __forceinline__ void operator()(const f32x4 (&acc)[2][2][4][2], const Unit& u, int wr, int wc, int fr, int fq) const {
        const int row0 = u.pm * BM + wr * 64 + fr, col0 = u.pn * BM + wc * 32 + 8 * fq;
        float rs[8];
        { f32x4 sa[8];
#pragma unroll
          for (int i = 0; i < 8; ++i) sa[i] = *(const f32x4*)(ssz + (size_t)(row0 + (i >> 2) * HALF + (i & 3) * 16) * 12 + 8);
#pragma unroll
          for (int i = 0; i < 8; ++i) rs[i] = 1.f / sqrtf(((sa[i][0] + sa[i][1]) + (sa[i][2] + sa[i][3])) * (1.f / 256.f) + EPS); }
#pragma unroll
        for (int ai = 0; ai < 2; ++ai)
#pragma unroll
            for (int m = 0; m < 4; ++m) { const int row = row0 + ai * HALF + m * 16; const float r_ = rs[ai * 4 + m];
                bf16_t* rowp = O + (size_t)row * 1024 + col0;
#pragma unroll
                for (int bj = 0; bj < 2; ++bj) { const f32x4 v0 = acc[ai][bj][m][0] * r_, v1 = acc[ai][bj][m][1] * r_;
                    u32x4 w; w.x = cvtpk(v0[0], v0[1]); w.y = cvtpk(v0[2], v0[3]); w.z = cvtpk(v1[0], v1[1]); w.w = cvtpk(v1[2], v1[3]);
                    st16g(rowp, bj * HALF * 2, w); } }
    }
};
template <int MODE>
struct MoeProb {
    static constexpr bool ROWSKIP = true;
    const LAS int* pre; const LAS int* cnt; int NT, G, c, K, lda;
    const bf16_t* A; const bf16_t* Bt; size_t bstride;
    const unsigned* lt;
    bool gather; unsigned* ready; unsigned need;
    __device__ __forceinline__ bool next(int i, Unit& u) const {
        const int totF = pre[72]; long L;
        if constexpr (MODE == 1) {
            const int F = totF * NT, Tn = pre[112] * NT, r = F % G, nfull = F / G + (c < r ? 1 : 0), Z = G - r;
            if (i < nfull) L = (long)i * G + c;
            else { const int k = i - nfull; int j;
                if (c >= r) { if (k > 1) return false; j = (c - r) + Z * k; if (j >= 2 * Z) return false; }
                else { if (k > 0) return false; j = 2 * Z + c; }
                if (j >= Tn) return false; L = F + j; }
        } else { L = (long)i * G + c; const int total = (totF + pre[112]) * NT; if (L >= total) return false; }
        int f = (int)L / NT; u.pn = (int)L % NT; int e = 0;
        if (f < totF) {
#pragma unroll
            for (int j = 1; j < 32; ++j) if (pre[40 + j] <= f) e = j;
            u.rt = f - pre[40 + e]; u.rows = 256;
        } else { e = pre[80 + f - totF]; u.rt = cnt[e] >> 8; u.rows = cnt[e] & 255; }
        e = __builtin_amdgcn_readfirstlane(e); u.e = e; u.rt = __builtin_amdgcn_readfirstlane(u.rt); u.rows = __builtin_amdgcn_readfirstlane(u.rows); u.pm = __builtin_amdgcn_readfirstlane(pre[e]) + u.rt; return true;
    }
    __device__ __forceinline__ void a_ready(const Unit& u) const {
        if constexpr (MODE == 2) {
            if (threadIdx.x < 64) {
                unsigned polls = 0;
                while ((unsigned)__builtin_amdgcn_readfirstlane((int)__hip_atomic_load(ready + 32 * u.pm, __ATOMIC_RELAXED, __HIP_MEMORY_SCOPE_AGENT)) < need) {
                    __builtin_amdgcn_s_sleep(2); if (++polls > (1u << 19)) break; }
            }
            asm volatile("" ::: "memory"); __builtin_amdgcn_s_barrier(); asm volatile("" ::: "memory");
        }
    }
    __device__ __forceinline__ void done(const Unit& u) const {
        if constexpr (MODE == 1) {
            asm volatile("s_waitcnt vmcnt(0)" ::: "memory");
            if ((threadIdx.x & 63) == 0) __hip_atomic_fetch_add(ready + 32 * u.pm, 1u, __ATOMIC_RELAXED, __HIP_MEMORY_SCOPE_AGENT);
        }
    }
    __device__ __forceinline__ const char* a_base(const Unit& u) const { return gather ? (const char*)A : (const char*)A + (size_t)u.pm * BM * lda * 2; }
    __device__ __forceinline__ size_t a_hstep() const { return (size_t)HALF * lda * 2; }
    __device__ __forceinline__ const char* b_base(const Unit& u) const { return (const char*)Bt + ((size_t)u.e * bstride + (size_t)u.pn * BM * K) * 2; }
    __device__ __forceinline__ void a_voff(const Unit& u, int R0, int C0, int R1, int C1, unsigned (&vo)[2][2]) const {
        if (gather) { const unsigned* l = lt + (size_t)u.e * mk::N + u.rt * 256;
            const unsigned t00 = (R0 < u.rows) ? (l[R0] & 0x7fffffffu) : 0u, t01 = (R1 < u.rows) ? (l[R1] & 0x7fffffffu) : 0u;
            const unsigned t10 = (R0 + HALF < u.rows) ? (l[R0 + HALF] & 0x7fffffffu) : 0u, t11 = (R1 + HALF < u.rows) ? (l[R1 + HALF] & 0x7fffffffu) : 0u;
            vo[0][0] = (t00 * (unsigned)lda + C0) * 2u; vo[0][1] = (t01 * (unsigned)lda + C1) * 2u; vo[1][0] = (t10 * (unsigned)lda + C0) * 2u; vo[1][1] = (t11 * (unsigned)lda + C1) * 2u;
        } else { vo[0][0] = (unsigned)(R0 * lda + C0) * 2u; vo[0][1] = (unsigned)(R1 * lda + C1) * 2u; vo[1][0] = vo[0][0]; vo[1][1] = vo[0][1]; }
    }
};
struct EpiGateUp {
    static constexpr bool PERM = true; static constexpr bool WIDE = false;
    bf16_t* act; const float* lw; const float* lr;
    __device__ __forceinline__ void operator()(const f32x4 (&acc)[2][2][4][2], const Unit& u, int wr, int wc, int fr, int fq) const {
        const int rl0 = wr * 64 + fr, col0 = u.pn * 128 + wc * 32 + 8 * fq; const size_t lbase = (size_t)u.e * mk::N + u.rt * 256;
        float wv[8], rv[8];
#pragma unroll
        for (int i = 0; i < 8; ++i) { const int rl = rl0 + (i >> 2) * HALF + (i & 3) * 16; const bool ok = rl < u.rows; wv[i] = ok ? lw[lbase + rl] : 0.f; rv[i] = ok ? lr[lbase + rl] : 0.f; }
#pragma unroll
        for (int ai = 0; ai < 2; ++ai)
#pragma unroll
            for (int m = 0; m < 4; ++m) { const int rl = rl0 + ai * HALF + m * 16; if (rl >= u.rows) continue;
                const float w = wv[ai * 4 + m], rs = rv[ai * 4 + m]; float o[8];
#pragma unroll
                for (int n = 0; n < 2; ++n)
#pragma unroll
                    for (int j = 0; j < 4; ++j) { const float g = acc[ai][0][m][n][j] * rs, up = acc[ai][1][m][n][j] * rs;
                        o[n * 4 + j] = g * __builtin_amdgcn_rcpf(1.f + __builtin_amdgcn_exp2f(-g * mk::LOG2E)) * up * w; }
                u32x4 pk; pk.x = cvtpk(o[0], o[1]); pk.y = cvtpk(o[2], o[3]); pk.z = cvtpk(o[4], o[5]); pk.w = cvtpk(o[6], o[7]);
                st16x<1>(act + ((size_t)u.pm * 256 + rl) * 256 + col0, 0, pk);   }
    }
};
struct EpiDown {
    static constexpr bool PERM = true; static constexpr bool WIDE = false;
    bf16_t* Y; const unsigned* lt;
    __device__ __forceinline__ void operator()(const f32x4 (&acc)[2][2][4][2], const Unit& u, int wr, int wc, int fr, int fq) const {
        const int rl0 = wr * 64 + fr, col0 = u.pn * BM + wc * 32 + 8 * fq; const size_t lbase = (size_t)u.e * mk::N + u.rt * 256;
        unsigned tk[8];
#pragma unroll
        for (int i = 0; i < 8; ++i) { const int rl = rl0 + (i >> 2) * HALF + (i & 3) * 16; tk[i] = (rl < u.rows) ? lt[lbase + rl] : 0u; }
#pragma unroll
        for (int ai = 0; ai < 2; ++ai)
#pragma unroll
            for (int m = 0; m < 4; ++m) { const int rl = rl0 + ai * HALF + m * 16; if (rl >= u.rows) continue;
                const unsigned t_ = tk[ai * 4 + m]; bf16_t* rowp = Y + ((size_t)(t_ >> 31) * mk::N + (t_ & 0x7fffffffu)) * 1024 + col0;
#pragma unroll
                for (int bj = 0; bj < 2; ++bj) { const f32x4 v0 = acc[ai][bj][m][0], v1 = acc[ai][bj][m][1];
                    u32x4 w; w.x = cvtpk(v0[0], v0[1]); w.y = cvtpk(v0[2], v0[3]); w.z = cvtpk(v1[0], v1[1]); w.w = cvtpk(v1[2], v1[3]);
                    st16g(rowp, bj * HALF * 2, w); } }
    }
};
}
namespace att {
constexpr int SLOT_K = 12288, SLOT_V = 8192, SLOT_KB = 256, SLOT = SLOT_K + SLOT_V + SLOT_KB;
constexpr int LDS_WS = 2 * SLOT, LDS_OST = LDS_WS + 8 * 256, LDS_BYTES = LDS_OST + 8 * 4608;
struct UnitDesc {
    const bf16_t* q; long qstride;
    const bf16_t* k; const bf16_t* v; long kstride;
    const bf16_t* kx; long kxstride;
    bf16_t* o; long ostride;
    float* lse; long lsestride;
    const float* kbias;
    int q0, W; float alibi, sink;
    bool has_sink, has_lse;
};
__device__ __forceinline__ int crow(int r, int hi) { return (r & 3) + 8 * (r >> 2) + 4 * hi; }
#define ATT_MX3(a, b, c) __builtin_fmaxf(__builtin_fmaxf((a), (b)), (c))
__device__ __forceinline__ float rowmax(const f32x16& p0, const f32x16& p1) {
    float a = ATT_MX3(p0[0], p0[1], p1[0]), b = ATT_MX3(p0[2], p0[3], p1[1]); a = ATT_MX3(a, p1[2], p1[3]);
#pragma unroll
    for (int r = 4; r < 16; r += 4) { a = ATT_MX3(a, p0[r], p0[r + 1]); b = ATT_MX3(b, p0[r + 2], p0[r + 3]); a = ATT_MX3(a, p1[r], p1[r + 1]); b = ATT_MX3(b, p1[r + 2], p1[r + 3]); }
    float m = __builtin_fmaxf(a, b); auto rr = __builtin_amdgcn_permlane32_swap(__float_as_uint(m), __float_as_uint(m), false, false);
    return __builtin_fmaxf(__uint_as_float(rr[0]), __uint_as_float(rr[1])); }
typedef short v4i16_t __attribute__((ext_vector_type(4)));
__device__ __forceinline__ s16x4 vtr(const LAS unsigned char* p) { return __builtin_bit_cast(s16x4, __builtin_amdgcn_ds_read_tr16_b64_v4i16((LAS v4i16_t*)p)); }

__device__ __forceinline__ void att_store_ot(const f32x16 (&o)[2], float inv, LAS bf16_t* stg, bf16_t* O, long ostride, int lane) {
    const int r32 = lane & 31, hi = lane >> 5;
#pragma unroll
    for (int d0 = 0; d0 < 2; ++d0)
#pragma unroll
        for (int g = 0; g < 4; ++g) { u32x2 p; p.x = cvtpk(o[d0][4 * g] * inv, o[d0][4 * g + 1] * inv); p.y = cvtpk(o[d0][4 * g + 2] * inv, o[d0][4 * g + 3] * inv);
            *(LAS u32x2*)(stg + r32 * 72 + 32 * d0 + 8 * g + 4 * hi) = p; }
#pragma unroll
    for (int i = 0; i < 4; ++i) { const int row = i * 8 + (lane >> 3), ch = lane & 7; const u32x4 v = *(const LAS u32x4*)(stg + row * 72 + ch * 8); st16a(O + (long)row * ostride + ch * 8, 0, v); }
}

template <int NDQ, bool FOX, bool BAND>
__device__ __forceinline__ void attn_unit(const UnitDesc& u, LAS unsigned char* lds, const int tid) {
    const int lane = tid & 63, r32 = lane & 31, hi = lane >> 5; const int w = __builtin_amdgcn_readfirstlane(tid >> 6);
    const int q0 = u.q0, Qw = q0 + 32 * w;
    const int t_lo = BAND ? ((q0 - u.W) > 0 ? ((q0 - u.W) >> 6) : 0) : 0, t_hi = (q0 + 255) >> 6;
    LAS float* wsf = (LAS float*)(lds + LDS_WS) + w * 64;
    const bf16_t* ksrc = u.k + (long)lane * u.kstride + w * 8;
    const bf16_t* kxsrc = (NDQ > 4) ? u.kx + (long)lane * u.kxstride + (NDQ == 6 ? (w & 3) * 8 : 0) : nullptr;
    const bf16_t* vsrc = u.v + (long)(16 * (w & 3) + (lane >> 2)) * u.kstride + (w >> 2) * 32 + (lane & 3) * 8;
#define ATT_DMA(t, bsel) do { LAS unsigned char* kb_ = lds + (bsel) * SLOT; \
        __builtin_amdgcn_global_load_lds((const unsigned*)(ksrc + (long)(t) * 64 * u.kstride), (LAS unsigned*)(kb_ + w * 1024), 16, 0, 0); \
        if (NDQ > 4) { if (w < 2 * (NDQ - 4)) __builtin_amdgcn_global_load_lds((const unsigned*)(kxsrc + (long)(t) * 64 * u.kxstride), (LAS unsigned*)(kb_ + (8 + w) * 1024), 16, 0, 0); } \
        __builtin_amdgcn_global_load_lds((const unsigned*)(vsrc + (long)(t) * 64 * u.kstride), (LAS unsigned*)(kb_ + SLOT_K + w * 1024), 16, 0, 0); } while (0)
    ATT_DMA(t_lo, 0);
    bf16x8 qr[NDQ];
    { const bf16_t* Qw_ = u.q + (long)(32 * w + r32) * u.qstride + hi * 8;
#pragma unroll
      for (int d0 = 0; d0 < (FOX ? 4 : NDQ); ++d0) qr[d0] = *(const bf16x8*)(Qw_ + d0 * 16);
      if (FOX) { const short one = hi ? (short)0 : (short)0x3F80; qr[4] = (bf16x8){one, one, one, 0, 0, 0, 0, 0}; } }
    const float ci = 0.f;
    f32x16 negm;
#pragma unroll
    for (int r = 0; r < 16; ++r) negm[r] = ci;
    float m_run = -1e30f, l_run = 0.f; f32x16 o[2]; o[0] = f32x16{}; o[1] = f32x16{};
    const int koff = hi * 1024 + r32 * 16;
    const int voff = SLOT_K + ((lane >> 4) & 1) * 32 + (lane & 3) * 8 + (4 * hi + ((lane & 15) >> 2)) * 64;
    for (int t = t_lo; t <= t_hi; ++t) {
        const int bsel = (t - t_lo) & 1;
        asm volatile("s_waitcnt vmcnt(0)" ::: "memory");
        __syncthreads();
        if (t < t_hi) ATT_DMA(t + 1, bsel ^ 1);
        const int k0 = 64 * t;
        bool active = (k0 <= Qw + 31); if (BAND) active = active && (Qw - (k0 + 63) <= u.W);
        if (!active) continue;
        const LAS unsigned char* kb = lds + bsel * SLOT;
        f32x16 p0, p1;
        if (BAND) {
#pragma unroll
            for (int r = 0; r < 16; ++r) { p0[r] = 0.f; p1[r] = 0.f; }
        } else { p0 = negm; p1 = negm; }
        __builtin_amdgcn_s_setprio(1);
#pragma unroll
        for (int d0 = 0; d0 < NDQ; ++d0) { const bf16x8 a0 = *(const LAS bf16x8*)(kb + koff + d0 * 2048), a1 = *(const LAS bf16x8*)(kb + koff + d0 * 2048 + 512);
            p0 = __builtin_amdgcn_mfma_f32_32x32x16_bf16(a0, qr[d0], p0, 0, 0, 0); p1 = __builtin_amdgcn_mfma_f32_32x32x16_bf16(a1, qr[d0], p1, 0, 0, 0); }
        __builtin_amdgcn_s_setprio(0);
        const int dbase = Qw + r32 - k0 - 4 * hi;
        float alpha = 1.f; float sacc = 0.f;
        if (BAND) {
#pragma unroll
            for (int r = 0; r < 16; ++r) { const int d0_ = dbase - ((r & 3) + 8 * (r >> 2)), d1_ = d0_ - 32;
                p0[r] = ((unsigned)d0_ <= (unsigned)u.W) ? p0[r] - u.alibi * (float)d0_ : -INFINITY;
                p1[r] = ((unsigned)d1_ <= (unsigned)u.W) ? p1[r] - u.alibi * (float)d1_ : -INFINITY; }
            const float rm = rowmax(p0, p1), m_new = __builtin_fmaxf(m_run, rm);
            alpha = __builtin_amdgcn_exp2f(m_run - m_new);
#pragma unroll
            for (int r = 0; r < 16; ++r) { o[0][r] *= alpha; o[1][r] *= alpha; }
            m_run = m_new;
#pragma unroll
            for (int r = 0; r < 16; ++r) { p0[r] = __builtin_amdgcn_exp2f(p0[r] - m_new); p1[r] = __builtin_amdgcn_exp2f(p1[r] - m_new); sacc += p0[r] + p1[r]; }
        } else {
            if (k0 + 63 > Qw) {
#pragma unroll
                for (int r = 0; r < 16; ++r) { const int d0_ = dbase - ((r & 3) + 8 * (r >> 2));
                    if (d0_ < 0) p0[r] = -INFINITY; if (d0_ < 32) p1[r] = -INFINITY; }
            }
            const float rm = rowmax(p0, p1);
            if (t == 0 || __any(rm > 8.0f)) {
                const float dl = (t == 0) ? rm : __builtin_fmaxf(rm, 0.f);
                alpha = __builtin_amdgcn_exp2f(-dl);
#pragma unroll
                for (int r = 0; r < 16; ++r) { p0[r] -= dl; p1[r] -= dl; negm[r] -= dl; }
                if (t != 0) {
#pragma unroll
                    for (int r = 0; r < 16; ++r) { o[0][r] *= alpha; o[1][r] *= alpha; }
                }
            }
#pragma unroll
            for (int r = 0; r < 16; ++r) { p0[r] = __builtin_amdgcn_exp2f(p0[r]); p1[r] = __builtin_amdgcn_exp2f(p1[r]); sacc += p0[r] + p1[r]; }
        }
        l_run = l_run * alpha + sacc;
        u32x4 pw[4];
#pragma unroll
        for (int j = 0; j < 4; ++j) { pw[0][j] = cvtpk(p0[2 * j], p0[2 * j + 1]); pw[1][j] = cvtpk(p0[8 + 2 * j], p0[9 + 2 * j]); pw[2][j] = cvtpk(p1[2 * j], p1[2 * j + 1]); pw[3][j] = cvtpk(p1[8 + 2 * j], p1[9 + 2 * j]); }
        const LAS unsigned char* vp = kb + voff;
        __builtin_amdgcn_s_setprio(1);
#pragma unroll
        for (int d0 = 0; d0 < 2; ++d0)
#pragma unroll
            for (int ks = 0; ks < 4; ++ks) { const s16x4 lo = vtr(vp + d0 * 4096 + ks * 1024), hh = vtr(vp + d0 * 4096 + ks * 1024 + 512);
                const bf16x8 vf = (bf16x8){lo[0], lo[1], lo[2], lo[3], hh[0], hh[1], hh[2], hh[3]};
                o[d0] = __builtin_amdgcn_mfma_f32_32x32x16_bf16(vf, __builtin_bit_cast(bf16x8, pw[ks]), o[d0], 0, 0, 0); }
        __builtin_amdgcn_s_setprio(0);
    }
#undef ATT_DMA
    { auto rr = __builtin_amdgcn_permlane32_swap(__float_as_uint(l_run), __float_as_uint(l_run), false, false); l_run = __uint_as_float(rr[0]) + __uint_as_float(rr[1]); }
    if (BAND) { if (u.has_sink) l_run += __builtin_amdgcn_exp2f(u.sink - m_run);
                if (u.has_lse) { if (hi == 0) u.lse[(long)(32 * w + r32) * u.lsestride] = m_run + __builtin_amdgcn_logf(l_run); } }
    att_store_ot(o, __builtin_amdgcn_rcpf(l_run), (LAS bf16_t*)(lds + LDS_OST) + w * 2304, u.o + (long)(32 * w) * u.ostride, u.ostride, lane);
    __syncthreads();
}

constexpr int P_LDS_WS = 3 * SLOT, P_LDS_OST = P_LDS_WS + 8 * 256, P_LDS_BYTES = P_LDS_OST + 8 * 4608;
template <int NDQ, bool FOX>
__device__ __forceinline__ void attn_unit_causal(const UnitDesc& u, LAS unsigned char* lds, const int tid) {
    const int lane = tid & 63, r32 = lane & 31, hi = lane >> 5; const int w = __builtin_amdgcn_readfirstlane(tid >> 6);
    const int q0 = u.q0, Qw = q0 + 32 * w, t_hi = (q0 + 255) >> 6, tl = (Qw + 31) >> 6;
    LAS float* wsf = (LAS float*)(lds + P_LDS_WS) + w * 64;
    const unsigned kvo = (unsigned)(lane * (int)u.kstride + w * 8) * 2u, kxo = (unsigned)(lane * (int)u.kxstride + (NDQ == 6 ? (w & 3) * 8 : 0)) * 2u;
    const unsigned vvo = (unsigned)((16 * (w & 3) + (lane >> 2)) * (int)u.kstride + (w >> 2) * 32 + (lane & 3) * 8) * 2u;
    const unsigned ldsb = (unsigned)(uintptr_t)lds + (unsigned)w * 1024u;
#define ATT_DMA(t, slot) do { const unsigned kb_ = ldsb + (unsigned)((slot) * SLOT); \
        pg8::glds_s((const char*)(u.k + (long)(t) * 64 * u.kstride), kvo, kb_); \
        if (w < 2 * (NDQ - 4)) pg8::glds_s((const char*)(u.kx + (long)(t) * 64 * u.kxstride), kxo, kb_ + 8192u); \
        pg8::glds_s((const char*)(u.v + (long)(t) * 64 * u.kstride), vvo, kb_ + (unsigned)SLOT_K); } while (0)
    ATT_DMA(0, 0);
    bf16x8 qr[NDQ];
    { const bf16_t* Qw_ = u.q + (long)(32 * w + r32) * u.qstride + hi * 8;
#pragma unroll
      for (int d0 = 0; d0 < (FOX ? 4 : NDQ); ++d0) qr[d0] = *(const bf16x8*)(Qw_ + d0 * 16);
      if (FOX) { const short one = hi ? (short)0 : (short)0x3F80; qr[NDQ - 1] = (bf16x8){one, one, one, 0, 0, 0, 0, 0}; } }
    float m_ref = -1e30f; f32x16 o[2]; float l_run = 0.f; o[0] = f32x16{}; o[1] = f32x16{};
    constexpr float THR = 30.f;
    const int koff = hi * 1024 + r32 * 16;
    const int voff = SLOT_K + ((lane >> 4) & 1) * 32 + (lane & 3) * 8 + (4 * hi + ((lane & 15) >> 2)) * 64;
    const int dq = r32 - 4 * hi;
#define ATT_KF(kbp, d0, n) (*(const LAS bf16x8*)((kbp) + koff + (d0) * 2048 + (n) * 512))
#define ATT_MASK(P0, P1, t) do { const int db_ = Qw + dq - 64 * (t); _Pragma("unroll") for (int r = 0; r < 16; ++r) { const int d_ = db_ - ((r & 3) + 8 * (r >> 2)); if (d_ < 0) P0[r] = -INFINITY; if (d_ < 32) P1[r] = -INFINITY; } } while (0)
#define ATT_SB() __builtin_amdgcn_sched_barrier(0)
#define ATT_PIN8(X0, X1, b) asm volatile("" : "+v"(X0[b]), "+v"(X0[b + 1]), "+v"(X0[b + 2]), "+v"(X0[b + 3]), "+v"(X1[b]), "+v"(X1[b + 1]), "+v"(X1[b + 2]), "+v"(X1[b + 3]))
    asm volatile("s_waitcnt vmcnt(0)" ::: "memory"); __syncthreads();
    if (t_hi >= 1) ATT_DMA(1, 1);
    f32x16 sa0 = f32x16{}, sa1 = f32x16{}, sb0, sb1;
    { const LAS unsigned char* kb = lds;
#pragma unroll
      for (int d0 = 0; d0 < NDQ; ++d0) { sa0 = __builtin_amdgcn_mfma_f32_32x32x16_bf16(ATT_KF(kb, d0, 0), qr[d0], sa0, 0, 0, 0); sa1 = __builtin_amdgcn_mfma_f32_32x32x16_bf16(ATT_KF(kb, d0, 1), qr[d0], sa1, 0, 0, 0); }
      if (tl == 0) ATT_MASK(sa0, sa1, 0); }
    int slot = 0, t = 0;
#define ATT_STEP(C0, C1, N0, N1) do { \
        const int slot1 = slot == 2 ? 0 : slot + 1, slot2 = slot1 == 2 ? 0 : slot1 + 1; \
        asm volatile("s_waitcnt vmcnt(0)" ::: "memory");                 \
        __syncthreads();                                                 \
        if (t + 2 <= t_hi) ATT_DMA(t + 2, slot2); \
        const LAS unsigned char* kbn = lds + slot1 * SLOT; const LAS unsigned char* vp = lds + slot * SLOT + voff; \
        { const float rm = rowmax(C0, C1); \
          if (__any(rm - m_ref > THR)) { const float m_new = __builtin_fmaxf(m_ref, rm), alpha = __builtin_amdgcn_exp2f(m_ref - m_new); m_ref = m_new; \
            _Pragma("unroll") for (int r = 0; r < 16; ++r) { o[0][r] *= alpha; o[1][r] *= alpha; } l_run *= alpha; } } \
        float sacc = 0.f; u32x4 pw[4]; \
        N0 = f32x16{}; N1 = f32x16{}; \
        { bf16x8 ka = ATT_KF(kbn, 0, 0), kb2 = ATT_KF(kbn, 0, 1); \
          _Pragma("unroll") for (int d0 = 0; d0 < NDQ; ++d0) { \
            bf16x8 na = ka, nb = kb2; if (d0 + 1 < NDQ) { na = ATT_KF(kbn, d0 + 1, 0); nb = ATT_KF(kbn, d0 + 1, 1); } \
            if (d0 < 4) { ATT_PIN8(C0, C1, 4 * d0); } \
            N0 = __builtin_amdgcn_mfma_f32_32x32x16_bf16(ka, qr[d0], N0, 0, 0, 0); N1 = __builtin_amdgcn_mfma_f32_32x32x16_bf16(kb2, qr[d0], N1, 0, 0, 0); \
            if (d0 < 4) { \
                _Pragma("unroll") for (int r = 4 * d0; r < 4 * d0 + 4; ++r) { C0[r] = __builtin_amdgcn_exp2f(C0[r] - m_ref); C1[r] = __builtin_amdgcn_exp2f(C1[r] - m_ref); sacc += C0[r] + C1[r]; } \
                ATT_PIN8(C0, C1, 4 * d0); asm volatile("" : "+v"(sacc)); } \
            ka = na; kb2 = nb; ATT_SB(); } } \
        l_run += sacc; \
        _Pragma("unroll") for (int j = 0; j < 4; ++j) { pw[0][j] = cvtpk(C0[2 * j], C0[2 * j + 1]); pw[1][j] = cvtpk(C0[8 + 2 * j], C0[9 + 2 * j]); pw[2][j] = cvtpk(C1[2 * j], C1[2 * j + 1]); pw[3][j] = cvtpk(C1[8 + 2 * j], C1[9 + 2 * j]); } \
        __builtin_amdgcn_s_setprio(1); \
        _Pragma("unroll") for (int ks = 0; ks < 4; ++ks) _Pragma("unroll") for (int d0 = 0; d0 < 2; ++d0) { const s16x4 lo = vtr(vp + d0 * 4096 + ks * 1024), hh = vtr(vp + d0 * 4096 + ks * 1024 + 512); \
                const bf16x8 vf = (bf16x8){lo[0], lo[1], lo[2], lo[3], hh[0], hh[1], hh[2], hh[3]}; \
                o[d0] = __builtin_amdgcn_mfma_f32_32x32x16_bf16(vf, __builtin_bit_cast(bf16x8, pw[ks]), o[d0], 0, 0, 0); \
                if (d0 == 1 && (ks & 1)) ATT_SB(); } \
        __builtin_amdgcn_s_setprio(0); \
        if (t + 1 == tl) ATT_MASK(N0, N1, t + 1); \
        slot = slot1; ++t; } while (0)
    for (; t + 1 <= tl; ) { ATT_STEP(sa0, sa1, sb0, sb1); ATT_STEP(sb0, sb1, sa0, sa1); }
    if (t <= tl) ATT_STEP(sa0, sa1, sb0, sb1);
    for (; t <= t_hi; ++t) { const int slot1 = slot == 2 ? 0 : slot + 1, slot2 = slot1 == 2 ? 0 : slot1 + 1;
        asm volatile("s_waitcnt vmcnt(0)" ::: "memory"); __syncthreads();
        if (t + 2 <= t_hi) ATT_DMA(t + 2, slot2);
        slot = slot1; }
#undef ATT_STEP
#undef ATT_DMA
#undef ATT_KF
#undef ATT_MASK
#undef ATT_SB
#undef ATT_PIN8
    { auto rr = __builtin_amdgcn_permlane32_swap(__float_as_uint(l_run), __float_as_uint(l_run), false, false); l_run = __uint_as_float(rr[0]) + __uint_as_float(rr[1]); }
    att_store_ot(o, __builtin_amdgcn_rcpf(l_run), (LAS bf16_t*)(lds + P_LDS_OST) + w * 2304, u.o + (long)(32 * w) * u.ostride, u.ostride, lane);
    __syncthreads();
}
}
namespace mk {
constexpr int NWAVES = 8, NTHREADS = 512;
constexpr int RING_BYTES = 131072, MISC_OFF = RING_BYTES, LDS_BYTES = 147456;
constexpr int MISC_PRE = MISC_OFF + 1024, MISC_CNT = MISC_PRE + 512, MISC_STASH = MISC_OFF + 2048;
constexpr int NPHASE = 17;
#define LDS_WAIT() asm volatile("s_waitcnt lgkmcnt(0)" ::: "memory")

struct Args { const float* in[21]; float* out; unsigned char* ws; float* H; int ph_lo, ph_hi; int use_bar, pad; };

typedef const __attribute__((address_space(4))) Args* cargs_t;
__device__ __forceinline__ Args load_args() {
#if defined(__HIP_DEVICE_COMPILE__)
    cargs_t p = (cargs_t)__builtin_amdgcn_kernarg_segment_ptr(); asm volatile("" : "+s"(p)); Args a;
#pragma unroll
    for (int i = 0; i < 21; ++i) a.in[i] = p->in[i];
    a.out = p->out; a.ws = p->ws; a.H = p->H; a.ph_lo = p->ph_lo; a.ph_hi = p->ph_hi; a.use_bar = p->use_bar; a.pad = 0; return a;
#else
    return Args{};
#endif
}

#define XB_TMO      128
#define XB_XCNT(j)  (256  + 64 * (j))
#define XB_XSUB(j)  (1280 + 64 * (j))
#define XB_XGEN(j)  (2304 + 64 * (j))
#define XB_TOP      3328
#define XB_TOPGEN   3392
#define XCD_BAR_WORDS 3456
#define XB_SPIN_CAP (1u << 18)
__device__ __forceinline__ unsigned xb_ld(unsigned* p)              { return __hip_atomic_load(p, __ATOMIC_RELAXED, __HIP_MEMORY_SCOPE_AGENT); }
__device__ __forceinline__ unsigned xb_add(unsigned* p, unsigned v) { return __hip_atomic_fetch_add(p, v, __ATOMIC_RELAXED, __HIP_MEMORY_SCOPE_AGENT); }
__device__ __forceinline__ unsigned xb_xcc_id() { return (unsigned)__builtin_amdgcn_s_getreg((3 << 11) | 20) & 0xFu; }
#define XB_SPIN(cond, bar) do { unsigned _sp = 0; while (cond) { __builtin_amdgcn_s_sleep(1); \
    if ((++_sp & 255u) == 0u) { if (xb_ld(&(bar)[XB_TMO])) break; if (_sp > XB_SPIN_CAP) { atomicAdd(&(bar)[XB_TMO], 1u); break; } } } } while (0)
struct XcdBarrier { unsigned* bar; unsigned x; volatile LAS unsigned* st; };
__device__ __forceinline__ XcdBarrier xcd_barrier_post(unsigned* bar, volatile LAS unsigned* st) {
    XcdBarrier b; b.bar = bar; b.x = xb_xcc_id(); b.st = st;
    if (threadIdx.x == 0) (void)xb_add(&bar[XB_XCNT(b.x)], 1u);
    return b;
}
__device__ __forceinline__ void xcd_barrier_complete(unsigned* bar, unsigned x, unsigned& nloc, unsigned& nx) {
    const unsigned G = gridDim.x * gridDim.y * gridDim.z;
    unsigned sum, cnt, mine, sp = 0u;
    for (;;) {
        sum = 0u; cnt = 0u; mine = 0u;
#pragma unroll
        for (unsigned j = 0; j < 16; ++j) { const unsigned c = xb_ld(&bar[XB_XCNT(j)]); sum += c; cnt += (c > 0u) ? 1u : 0u; mine = (j == x) ? c : mine; }
        if (sum == G) break;
        __builtin_amdgcn_s_sleep(1);
        if ((++sp & 255u) == 0u) { if (xb_ld(&bar[XB_TMO])) break; if (sp > XB_SPIN_CAP) { atomicAdd(&bar[XB_TMO], 1u); break; } }
    }
    nloc = mine > 0u ? mine : 1u; nx = cnt > 0u ? cnt : 1u;
}
__device__ __forceinline__ void xcd_barrier(const XcdBarrier& b) {
    asm volatile("s_waitcnt vmcnt(0)" ::: "memory");
    __syncthreads();
    if (threadIdx.x == 0) {
        unsigned* bar = b.bar;
        __builtin_amdgcn_s_waitcnt(0);
        unsigned nloc = b.st[0], nx = b.st[1];
        if (nloc == 0u) { xcd_barrier_complete(bar, b.x, nloc, nx); b.st[0] = nloc; b.st[1] = nx; }
        const unsigned old = xb_add(&bar[XB_XSUB(b.x)], 1u);
        const unsigned gen = old / nloc;
        if (old + 1u == (gen + 1u) * nloc) {
            __builtin_amdgcn_fence(__ATOMIC_RELEASE, "agent");
            asm volatile("s_waitcnt vmcnt(0)" ::: "memory");
            const unsigned og = xb_add(&bar[XB_TOP], 1u);
            const unsigned tg = og / nx;
            if (og + 1u == (tg + 1u) * nx) xb_add(&bar[XB_TOPGEN], 1u);
            else XB_SPIN(xb_ld(&bar[XB_TOPGEN]) == tg, bar);
            __builtin_amdgcn_fence(__ATOMIC_ACQUIRE, "agent");
            xb_add(&bar[XB_XGEN(b.x)], 1u);
            asm volatile("s_waitcnt vmcnt(0)" ::: "memory");
        } else {
            XB_SPIN(xb_ld(&bar[XB_XGEN(b.x)]) == gen, bar);
            __builtin_amdgcn_fence(__ATOMIC_ACQUIRE, "agent");
            asm volatile("s_waitcnt vmcnt(0)" ::: "memory");
        }
    }
    __syncthreads();
}
constexpr int MISC_BAR = MISC_OFF + 64;
__device__ __forceinline__ void grid_barrier(const Args& a, LAS unsigned char* lds) {
    XcdBarrier b; b.bar = (unsigned*)(a.ws + WS_CTL) + CW_BAR; b.x = xb_xcc_id(); b.st = (volatile LAS unsigned*)(lds + MISC_BAR);
    xcd_barrier(b);
}
__device__ __forceinline__ float wave_sum(float v) {
#pragma unroll
    for (int o = 1; o < 64; o <<= 1) v += __shfl_xor(v, o);
    return v;
}
__device__ __forceinline__ void tr_item(const float* src, int lds_, int ncols, const float* scale, bf16_t* dst, int ldd, LAS float* scr, int lane) {
    float v[32]; const int c0 = lane & 31, kh = lane >> 5;
#pragma unroll
    for (int i = 0; i < 32; ++i) v[i] = (src && c0 < ncols) ? src[(size_t)(2 * i + kh) * lds_ + c0] : 0.f;
    const int c = lane & 7; f32x4 s0 = (f32x4){1.f, 1.f, 1.f, 1.f}, s1 = s0;
    if (scale) { s0 = *(const f32x4*)(scale + 8 * c); s1 = *(const f32x4*)(scale + 8 * c + 4); }
#pragma unroll
    for (int i = 0; i < 32; ++i) scr[(2 * i + kh) * 33 + c0] = v[i];
    LDS_WAIT(); asm volatile("" ::: "memory");
#pragma unroll
    for (int j = 0; j < 4; ++j) { const int n = (lane >> 3) + 8 * j; const LAS float* s = scr + (8 * c) * 33 + n;
        u32x4 o; o.x = cvtpk(s[0 * 33] * s0[0], s[1 * 33] * s0[1]); o.y = cvtpk(s[2 * 33] * s0[2], s[3 * 33] * s0[3]); o.z = cvtpk(s[4 * 33] * s1[0], s[5 * 33] * s1[1]); o.w = cvtpk(s[6 * 33] * s1[2], s[7 * 33] * s1[3]);
        st16s(dst + (size_t)n * ldd + 8 * c, 0, o); }
    LDS_WAIT(); asm volatile("" ::: "memory");
}
struct TrMat { const float* W; int K, ldw; const float* scale; bf16_t* WT; int nblk; int kind; };
__device__ __forceinline__ int tr_srccol(int kind, int n0) {
    switch (kind) {
    case 0: return n0;
    case 1: return n0 < 1536 ? n0 : n0 + 8;
    case 2: return n0 < 384 ? n0 : (n0 < 416 ? n0 + 256 : (n0 < 512 ? -1 : (n0 < 768 ? n0 - 128 : n0 - 96)));
    default: return n0; }
}
__device__ __forceinline__ void tr_mat_item(const TrMat& m, int item, LAS float* scr, int lane) {
    const int kb = item / m.nblk, nb = item % m.nblk, k0 = 64 * kb, n0 = 32 * nb; const int sc = tr_srccol(m.kind, n0);
    tr_item(sc < 0 ? nullptr : m.W + (size_t)k0 * m.ldw + sc, m.ldw, 32, m.scale ? m.scale + k0 : nullptr, m.WT + (size_t)n0 * m.K + k0, m.K, scr, lane);
}

__device__ __forceinline__ void dense_mats(const Args& a, TrMat (&M)[6]) {
    unsigned char* ws = a.ws; const float* attn_norm = a.in[1];
    M[0] = TrMat{a.in[4], 1024, 3080, attn_norm, (bf16_t*)(ws + WS_WIN0), 96, 1};
    M[1] = TrMat{a.in[6], 1024, 1024, nullptr, (bf16_t*)(ws + WS_WOUT0), 32, 0};
    M[2] = TrMat{a.in[7], 1024, 1440, attn_norm + 1024, (bf16_t*)(ws + WS_WIN1), 48, 2};
    M[3] = TrMat{a.in[10], 384, 768, a.in[8], (bf16_t*)(ws + WS_WUQ), 24, 0};
    M[4] = TrMat{a.in[11], 256, 1024, a.in[9], (bf16_t*)(ws + WS_WUKV), 32, 0};
    M[5] = TrMat{a.in[13], 1024, 1024, nullptr, (bf16_t*)(ws + WS_WOUT1), 32, 0};
}
__device__ __forceinline__ void router_item(const Args& a, int it, LAS float* scr, int lane) {
    const float* ffn_norm = a.in[2]; const int l = it >> 5, r = it & 31, kb = r >> 1, nb = r & 1, k0 = 64 * kb;
    bf16_t* dst = (bf16_t*)(a.ws + WS_WR) + (size_t)l * 64 * 1024 + (size_t)(32 * nb) * 1024 + k0;
    if (nb == 0) tr_item(a.in[16] + (size_t)l * 1024 * 32 + (size_t)k0 * 32, 32, 32, ffn_norm + l * 1024 + k0, dst, 1024, scr, lane);
    else tr_item(a.in[14] + (size_t)l * 1024 * 4 + (size_t)k0 * 4, 4, 4, ffn_norm + l * 1024 + k0, dst, 1024, scr, lane);
}
template <int PART>
__device__ __forceinline__ void p0_prologue(const Args& a, LAS unsigned char* lds, int gw, int NGW, int wave, int lane) {
    unsigned char* ws = a.ws; LAS float* scr = (LAS float*)(lds + wave * 16384);
    const float* attn_norm = a.in[1];
    TrMat M[6]; dense_mats(a, M);
    const int cnt[6] = {16 * 96, 16 * 32, 16 * 48, 6 * 24, 4 * 32, 16 * 32};
    int base = 0;
#pragma unroll
    for (int mi = 0; mi < 6; ++mi) { if ((mi == 0) == (PART == 0)) { for (int it = (gw + NGW - base % NGW) % NGW; it < cnt[mi]; it += NGW) tr_mat_item(M[mi], it, scr, lane); base += cnt[mi]; } }
    if (PART == 1) for (int it = gw; it < 64; it += NGW) router_item(a, it, scr, lane);
    if (PART == 1) { f32x2* rope = (f32x2*)(ws + WS_ROPE);
      for (int i = gw * 64 + lane; i < S * 16; i += NGW * 64) { const int pos = i >> 4, j = i & 15; const float inv = powf(10000.0f, -(float)(2 * j) / 32.0f), ang = (float)pos * inv; float sn, cs; sincosf(ang, &sn, &cs); rope[i] = (f32x2){cs, sn}; } }
    if (PART == 0) { const float* x = a.in[0]; const float* win = a.in[4]; const float* bfp = a.in[5];
      bf16_t* XB = (bf16_t*)(ws + WS_XB); float* SS = (float*)(ws + WS_SS); float* LOGF = (float*)(ws + WS_LOGF);
      float wz[4][4][8];
#pragma unroll
      for (int j = 0; j < 4; ++j)
#pragma unroll
          for (int e = 0; e < 4; ++e) { const int k = 256 * j + 4 * lane + e; const float g = attn_norm[k]; const f32x4 w0 = *(const f32x4*)(win + (size_t)k * 3080 + 1536), w1 = *(const f32x4*)(win + (size_t)k * 3080 + 1540);
#pragma unroll
              for (int h = 0; h < 4; ++h) { wz[j][e][h] = w0[h] * g; wz[j][e][4 + h] = w1[h] * g; } }
      for (int row = gw; row < N; row += NGW) {
          const f32x4* xr = (const f32x4*)(x + (size_t)row * D) + lane; f32x4 v[4]; float ssq = 0.f; float zf[8];
#pragma unroll
          for (int h = 0; h < 8; ++h) zf[h] = 0.f;
#pragma unroll
          for (int j = 0; j < 4; ++j) { v[j] = xr[64 * j]; ssq += (v[j][0] * v[j][0] + v[j][1] * v[j][1]) + (v[j][2] * v[j][2] + v[j][3] * v[j][3]);
#pragma unroll
              for (int e = 0; e < 4; ++e)
#pragma unroll
                  for (int h = 0; h < 8; ++h) zf[h] += v[j][e] * wz[j][e][h]; }
          ssq = wave_sum(ssq);
#pragma unroll
          for (int h = 0; h < 8; ++h) zf[h] = wave_sum(zf[h]);
          u32x2* o8 = (u32x2*)(XB + (size_t)row * D) + lane;
#pragma unroll
          for (int j = 0; j < 4; ++j) { u32x2 wv; wv.x = cvtpk(v[j][0], v[j][1]); wv.y = cvtpk(v[j][2], v[j][3]); st8s(o8, 512 * j, wv); }
          if (lane == 0) SS[row] = ssq;
          const float rstd = 1.f / sqrtf(ssq * (1.f / D) + EPS);
          float zsel = zf[0];
#pragma unroll
          for (int h = 1; h < 8; ++h) zsel = (lane == h) ? zf[h] : zsel;
          if (lane < 8) { const float xg = zsel * rstd + bfp[lane]; LOGF[(size_t)row * 8 + lane] = fminf(xg, 0.f) - log1pf(expf(-fabsf(xg))); }
      } }
}
__device__ __forceinline__ void fox_cumsum(const Args& a, LAS unsigned char* lds, int G, const int tid) {
    const float* LOGF = (const float*)(a.ws + WS_LOGF); float* KB = (float*)(a.ws + WS_CB2); u32x4* KX = (u32x4*)(a.ws + WS_KEXT); LAS float* part = (LAS float*)lds;
    const int t = tid, lane = t & 63, wv = t >> 6;
    for (int bh = blockIdx.x; bh < 32; bh += G) { const int b = bh >> 3, h = bh & 7; float loc[8]; float run = 0.f;
#pragma unroll
        for (int i = 0; i < 8; ++i) { run += LOGF[(size_t)(b * S + t * 8 + i) * 8 + h]; loc[i] = run; }
        float inc = run;
#pragma unroll
        for (int o = 1; o < 64; o <<= 1) { const float up = __shfl_up(inc, o); if (lane >= o) inc += up; }
        __syncthreads();
        if (lane == 63) part[wv] = inc;
        __syncthreads();
        float off = inc - run;
        for (int i = 0; i < wv; ++i) off += part[i];
#pragma unroll
        for (int i = 0; i < 8; ++i) { const float kb = -LOG2E * (loc[i] + off); KB[(size_t)bh * S + t * 8 + i] = kb;
            const unsigned h1 = cvtpk(kb, 0.f) & 0xffffu; const float r1 = kb - bflo(h1); const unsigned h2 = cvtpk(r1, 0.f) & 0xffffu; const float r2 = r1 - bflo(h2); const unsigned h3 = cvtpk(r2, 0.f) & 0xffffu;
            KX[(size_t)bh * S + t * 8 + i] = (u32x4){h1 | (h2 << 16), h3, 0u, 0u}; }
    }
    __syncthreads();
}
__device__ __forceinline__ void attn_phase0(const Args& a, LAS unsigned char* lds, int vcu, int G, const int tid) {
    const bf16_t* QKV = (const bf16_t*)(a.ws + R1_QKV0); bf16_t* AO = (bf16_t*)(a.ws + R2_AO); bf16_t* DP = (bf16_t*)(a.ws + R2_DPART);
    float* DLSE = (float*)(a.ws + WS_DLSE); const float* KB = (const float*)(a.ws + WS_CB2);
    for (int it = vcu; it < 256 + 1536; it += G) {
        if (it < 256) { const int bh = it >> 3, s = it & 7, b = bh >> 3, h = bh & 7;
            for (int half = 0; half < 2; ++half) { const int qb = half ? 15 - s : s; att::UnitDesc u{};
                const bf16_t* base = QKV + (size_t)b * S * 3072 + h * 64;
                u.q = base + (size_t)(qb * 256) * 3072; u.qstride = 3072; u.k = base + 512; u.v = base + 1024; u.kstride = 3072;
                u.o = AO + (size_t)(b * S + qb * 256) * 1024 + h * 64; u.ostride = 1024; u.kbias = KB + (size_t)bh * S; u.kx = (const bf16_t*)(a.ws + WS_KEXT) + (size_t)bh * S * 8; u.kxstride = 8; u.q0 = qb * 256; u.W = 1 << 30;
                { int tid_ = tid; asm volatile("" : "+v"(tid_)); att::attn_unit_causal<5, true>(u, lds, tid_); } }
        } else { const int j = it - 256, bh = j / 48, rem = j % 48, br = rem >> 4, idx = rem & 15, b = bh >> 3, h = bh & 7;
            const int dil = br == 0 ? 1 : (br == 1 ? 4 : 16), c = br == 0 ? 0 : (br == 1 ? idx >> 2 : idx), qblk = br == 0 ? idx : (br == 1 ? idx & 3 : 0);
            att::UnitDesc u{}; const bf16_t* base = QKV + (size_t)(b * S + c) * 3072 + 1536 + h * 64; const long st = (long)dil * 3072;
            u.q = base + (size_t)(qblk * 256) * st; u.qstride = st; u.k = base + 512; u.v = base + 1024; u.kstride = st;
            const size_t tok0 = (size_t)b * S + c + (size_t)qblk * 256 * dil;
            u.o = DP + (size_t)br * N * 512 + tok0 * 512 + h * 64; u.ostride = (long)dil * 512;
            u.lse = DLSE + (size_t)br * N * 8 + tok0 * 8 + h; u.lsestride = (long)dil * 8; u.has_lse = true;
            u.q0 = qblk * 256; u.W = 128; u.alibi = exp2f(-(float)(h + 1)) * (float)dil * LOG2E;
            { int tid_ = tid; asm volatile("" : "+v"(tid_)); att::attn_unit<4, false, true>(u, lds, tid_); } }
    }
}
__device__ __forceinline__ void attn_phase1(const Args& a, LAS unsigned char* lds, int vcu, int G, const int tid) {
    const bf16_t* Z1 = (const bf16_t*)(a.ws + R1_Z1); const bf16_t* Q1 = (const bf16_t*)(a.ws + R1_Q1); const bf16_t* KV = (const bf16_t*)(a.ws + R1_KV1);
    bf16_t* AO = (bf16_t*)(a.ws + R2_AO); const float* sinks = a.in[12];
    for (int it = vcu; it < 256 + 512; it += G) {
        if (it < 256) { const int bh = it >> 3, s = it & 7, b = bh >> 3, h = bh & 7;
            for (int half = 0; half < 2; ++half) { const int qb = half ? 15 - s : s; att::UnitDesc u{};
                u.q = Q1 + (size_t)(b * S + qb * 256) * 768 + h * 96; u.qstride = 768;
                u.k = KV + (size_t)b * S * 1024 + h * 128; u.v = u.k + 64; u.kstride = 1024; u.kx = Z1 + (size_t)b * S * 1536 + 384; u.kxstride = 1536;
                u.o = AO + (size_t)(b * S + qb * 256) * 1024 + h * 64; u.ostride = 1024; u.q0 = qb * 256; u.W = 1 << 30;
                { int tid_ = tid; asm volatile("" : "+v"(tid_)); att::attn_unit_causal<6, false>(u, lds, tid_); } }
        } else { const int j = it - 256, b = j >> 7, hq = (j >> 4) & 7, qb = j & 15, kvh = hq >> 2; att::UnitDesc u{};
            const bf16_t* base = Z1 + (size_t)b * S * 1536;
            u.q = base + (size_t)(qb * 256) * 1536 + 768 + hq * 64; u.qstride = 1536; u.k = base + 1280 + kvh * 64; u.v = base + 1408 + kvh * 64; u.kstride = 1536;
            u.o = AO + (size_t)(b * S + qb * 256) * 1024 + 512 + hq * 64; u.ostride = 1024; u.q0 = qb * 256; u.W = 127;
            u.alibi = exp2f(-(float)(hq + 1)) * LOG2E; u.has_sink = true; u.sink = sinks[hq] * LOG2E;
            { int tid_ = tid; asm volatile("" : "+v"(tid_)); att::attn_unit<4, false, true>(u, lds, tid_); } }
    }
}
__device__ __forceinline__ void merge_phase(const Args& a, int gw, int NGW, int lane) {
    const bf16_t* DP = (const bf16_t*)(a.ws + R2_DPART); const float* DLSE = (const float*)(a.ws + WS_DLSE); bf16_t* AO = (bf16_t*)(a.ws + R2_AO);
    for (int tok = gw; tok < N; tok += NGW) { const int h = lane >> 3;
        const float l0 = DLSE[(size_t)tok * 8 + h], l1 = DLSE[(size_t)N * 8 + (size_t)tok * 8 + h], l2 = DLSE[(size_t)2 * N * 8 + (size_t)tok * 8 + h];
        const float mx = fmaxf(l0, fmaxf(l1, l2)); float w0 = exp2f(l0 - mx), w1 = exp2f(l1 - mx), w2 = exp2f(l2 - mx); const float inv = 1.f / (w0 + w1 + w2); w0 *= inv; w1 *= inv; w2 *= inv;
        const u32x4 a0 = *(const u32x4*)(DP + (size_t)tok * 512 + lane * 8), a1 = *(const u32x4*)(DP + (size_t)N * 512 + (size_t)tok * 512 + lane * 8), a2 = *(const u32x4*)(DP + (size_t)2 * N * 512 + (size_t)tok * 512 + lane * 8);
        u32x4 o;
#pragma unroll
        for (int i = 0; i < 4; ++i) { const float lo = w0 * bflo(a0[i]) + w1 * bflo(a1[i]) + w2 * bflo(a2[i]), hi = w0 * bfhi(a0[i]) + w1 * bfhi(a1[i]) + w2 * bfhi(a2[i]); o[i] = cvtpk(lo, hi); }
        st16s(AO + (size_t)tok * 1024 + 512 + lane * 8, 0, o); }
}
__device__ __forceinline__ void merge_panel_part(const Args& a, int tok0, int wave, int lane, unsigned* cntw) {
    const bf16_t* DP = (const bf16_t*)(a.ws + R2_DPART); const float* DLSE = (const float*)(a.ws + WS_DLSE); bf16_t* AO = (bf16_t*)(a.ws + R2_AO);
#pragma unroll 8
    for (int i = 0; i < 8; ++i) { const int tok = tok0 + wave * 8 + i, h = lane >> 3;
        const float l0 = DLSE[(size_t)tok * 8 + h], l1 = DLSE[(size_t)N * 8 + (size_t)tok * 8 + h], l2 = DLSE[(size_t)2 * N * 8 + (size_t)tok * 8 + h];
        const float mx = fmaxf(l0, fmaxf(l1, l2)); float w0 = exp2f(l0 - mx), w1 = exp2f(l1 - mx), w2 = exp2f(l2 - mx); const float inv = 1.f / (w0 + w1 + w2); w0 *= inv; w1 *= inv; w2 *= inv;
        const u32x4 a0 = *(const u32x4*)(DP + (size_t)tok * 512 + lane * 8), a1 = *(const u32x4*)(DP + (size_t)N * 512 + (size_t)tok * 512 + lane * 8), a2 = *(const u32x4*)(DP + (size_t)2 * N * 512 + (size_t)tok * 512 + lane * 8);
        u32x4 o;
#pragma unroll
        for (int j = 0; j < 4; ++j) { const float lo = w0 * bflo(a0[j]) + w1 * bflo(a1[j]) + w2 * bflo(a2[j]), hi = w0 * bfhi(a0[j]) + w1 * bfhi(a1[j]) + w2 * bfhi(a2[j]); o[j] = cvtpk(lo, hi); }
        st16x<1>(AO + (size_t)tok * 1024 + 512 + lane * 8, 0, o); }
    asm volatile("s_waitcnt vmcnt(0)" ::: "memory");
    if (lane == 0) __hip_atomic_fetch_add(cntw, 1u, __ATOMIC_RELAXED, __HIP_MEMORY_SCOPE_AGENT);
}
__device__ __forceinline__ void route_phase(const Args& a, int layer, LAS unsigned char* lds, int vcu, int G, int wave, int lane) {
    const bf16_t* HB = (const bf16_t*)(a.ws + WS_XB); const bf16_t* WR = (const bf16_t*)(a.ws + WS_WR) + (size_t)layer * 64 * 1024;
    const float* SSP = (const float*)(a.ws + WS_SSP); const float* bg = a.in[15] + layer * 4; const float* br = a.in[17] + layer * 32;
    unsigned* cnt = (unsigned*)(a.ws + WS_CTL) + CW_CNT + layer * 1024;
    unsigned* LT = (unsigned*)(a.ws + WS_LT); float* LW = (float*)(a.ws + WS_LW); float* LR = (float*)(a.ws + WS_LR);
    const int r32 = lane & 31, hi = lane >> 5, kq = wave & 3, half = wave >> 2;
    for (int b0 = vcu * 2; b0 < N / 32; b0 += G * 2) {
        const int blk = b0 + half; const bool live = blk < N / 32; const int tok = (live ? blk : 0) * 32 + r32;
        f32x16 c0 = f32x16{}, c1 = f32x16{};
        const bf16_t* xb = HB + (size_t)tok * 1024 + kq * 256 + hi * 8; const bf16_t* wa = WR + (size_t)r32 * 1024 + kq * 256 + hi * 8;
        if (live) {
#pragma unroll 8
            for (int k0 = 0; k0 < 256; k0 += 16) { const bf16x8 bx = *(const bf16x8*)(xb + k0), a0 = *(const bf16x8*)(wa + k0), a1 = *(const bf16x8*)(wa + 32 * 1024 + k0);
                c0 = __builtin_amdgcn_mfma_f32_32x32x16_bf16(a0, bx, c0, 0, 0, 0); c1 = __builtin_amdgcn_mfma_f32_32x32x16_bf16(a1, bx, c1, 0, 0, 0); } }
        LAS f32x4* red = (LAS f32x4*)(lds + wave * 16384 + 9216) + lane * 5;
        if (kq != 0) { red[0] = (f32x4){c0[0], c0[1], c0[2], c0[3]}; red[1] = (f32x4){c0[4], c0[5], c0[6], c0[7]}; red[2] = (f32x4){c0[8], c0[9], c0[10], c0[11]}; red[3] = (f32x4){c0[12], c0[13], c0[14], c0[15]}; red[4] = (f32x4){c1[0], c1[1], c1[2], c1[3]}; }
        __syncthreads();
        if (kq == 0 && live) {
#pragma unroll
            for (int q = 1; q < 4; ++q) { const LAS f32x4* rq = (const LAS f32x4*)(lds + (wave + q) * 16384 + 9216) + lane * 5;
#pragma unroll
                for (int g = 0; g < 4; ++g) { const f32x4 t = rq[g]; c0[4 * g] += t[0]; c0[4 * g + 1] += t[1]; c0[4 * g + 2] += t[2]; c0[4 * g + 3] += t[3]; }
                const f32x4 t = rq[4]; c1[0] += t[0]; c1[1] += t[1]; c1[2] += t[2]; c1[3] += t[3]; }
            const f32x4* sp = (const f32x4*)(SSP + (size_t)tok * 16); const f32x4 s0 = sp[0], s1 = sp[1], s2 = sp[2], s3 = sp[3];
            const float ssq = ((s0[0] + s0[1]) + (s0[2] + s0[3])) + ((s1[0] + s1[1]) + (s1[2] + s1[3])) + ((s2[0] + s2[1]) + (s2[2] + s2[3])) + ((s3[0] + s3[1]) + (s3[2] + s3[3]));
            const float rstd = 1.f / sqrtf(ssq * (1.f / 1024.f) + EPS);
            float gl[4];
#pragma unroll
            for (int j = 0; j < 4; ++j) { const float mine = c1[j]; const float other = __shfl_xor(mine, 32); gl[j] = (hi == 0 ? mine : other) * rstd + bg[j]; }
            int gi = 0; float gm = gl[0];
#pragma unroll
            for (int j = 1; j < 4; ++j) if (gl[j] > gm) { gm = gl[j]; gi = j; }
            float den = 0.f;
#pragma unroll
            for (int j = 0; j < 4; ++j) den += __expf(gl[j] - gm);
            const float gwt = 1.f / den;
            float mine4[4];
#pragma unroll
            for (int j = 0; j < 4; ++j) { float v = c0[j]; v = (gi == 1) ? c0[4 + j] : v; v = (gi == 2) ? c0[8 + j] : v; v = (gi == 3) ? c0[12 + j] : v; mine4[j] = v; }
            float el[8];
#pragma unroll
            for (int j = 0; j < 4; ++j) { const float other = __shfl_xor(mine4[j], 32); el[j] = (hi == 0 ? mine4[j] : other); el[4 + j] = (hi == 0 ? other : mine4[j]); }
#pragma unroll
            for (int j = 0; j < 8; ++j) el[j] = el[j] * rstd + br[gi * 8 + j];
            int i1 = 0; float v1 = el[0];
#pragma unroll
            for (int j = 1; j < 8; ++j) if (el[j] > v1) { v1 = el[j]; i1 = j; }
            int i2 = -1; float v2 = -INFINITY;
#pragma unroll
            for (int j = 0; j < 8; ++j) if (j != i1 && el[j] > v2) { v2 = el[j]; i2 = j; }
            const float e2 = __expf(v2 - v1); const float w1 = gwt / (1.f + e2), w2 = gwt * e2 / (1.f + e2);
            const int E = gi * 8 + (hi == 0 ? i1 : i2); const float wsel = hi == 0 ? w1 : w2;
            int myrank = 0, mycnt = 0; const unsigned long long ltmask = (1ull << lane) - 1ull;
#pragma unroll 4
            for (int j = 0; j < 32; ++j) { const unsigned long long mj = __ballot(E == j); if (E == j) myrank = __popcll(mj & ltmask); if (lane == j) mycnt = __popcll(mj); }
            unsigned basev = 0; if (lane < 32 && mycnt > 0) basev = atomicAdd(cnt + lane * 16, (unsigned)mycnt);
            const unsigned base = (unsigned)__shfl((int)basev, E);
            const size_t pos = (size_t)E * N + base + myrank;
            LT[pos] = (unsigned)tok | ((unsigned)hi << 31); LW[pos] = wsel; LR[pos] = rstd;
        }
        __syncthreads();
    }
}
constexpr int MOE_CONV_ITEMS = 32 * 256 + 32 * 128;
struct TrDesc { const float* src; int lds_; const float* scale; bf16_t* dst; int ldd; };
__device__ __forceinline__ TrDesc moe_desc(const Args& a, int layer, int it) {
    const float* wg = a.in[18] + (size_t)layer * 32 * 1024 * 256; const float* wu = a.in[19] + (size_t)layer * 32 * 1024 * 256; const float* wd = a.in[20] + (size_t)layer * 32 * 256 * 1024;
    const float* g = a.in[2] + layer * 1024; bf16_t* WGU = (bf16_t*)(a.ws + (layer ? R2_WGU1 : R1_WGU)); bf16_t* WD = (bf16_t*)(a.ws + (layer ? R2_WD1 : R1_WD));
    if (it < 32 * 256) { const int e = it >> 8, r = it & 255, kb = r >> 4, nb = r & 15, k0 = 64 * kb, n0 = 32 * nb;
        const int t = n0 >> 8, s = (n0 >> 7) & 1, j = n0 & 127; const float* src = (s ? wu : wg) + (size_t)e * 1024 * 256 + (size_t)k0 * 256 + 128 * t + j;
        return TrDesc{src, 256, g + k0, WGU + ((size_t)e * 512 + n0) * 1024 + k0, 1024};
    } else { const int i2 = it - 32 * 256, e = i2 >> 7, r = i2 & 127, kb = r >> 5, nb = r & 31, k0 = 64 * kb, n0 = 32 * nb;
        return TrDesc{wd + (size_t)e * 256 * 1024 + (size_t)k0 * 1024 + n0, 1024, nullptr, WD + ((size_t)e * 1024 + n0) * 256 + k0, 256}; }
}
__device__ __forceinline__ void tr_load(const TrDesc& d, float (&v)[32], int lane) {
    const int c0 = lane & 31, kh = lane >> 5;
#pragma unroll
    for (int i = 0; i < 32; ++i) v[i] = d.src[(size_t)(2 * i + kh) * d.lds_ + c0];
}
__device__ __forceinline__ void tr_store(const TrDesc& d, const float (&v)[32], LAS float* scr, int lane) {
    const int c0 = lane & 31, kh = lane >> 5, c = lane & 7; f32x4 s0 = (f32x4){1.f, 1.f, 1.f, 1.f}, s1 = s0;
    if (d.scale) { s0 = *(const f32x4*)(d.scale + 8 * c); s1 = *(const f32x4*)(d.scale + 8 * c + 4); }
#pragma unroll
    for (int i = 0; i < 32; ++i) scr[(2 * i + kh) * 33 + c0] = v[i];
    LDS_WAIT(); asm volatile("" ::: "memory");
#pragma unroll
    for (int j = 0; j < 4; ++j) { const int n = (lane >> 3) + 8 * j; const LAS float* s = scr + (8 * c) * 33 + n;
        u32x4 o; o.x = cvtpk(s[0 * 33] * s0[0], s[1 * 33] * s0[1]); o.y = cvtpk(s[2 * 33] * s0[2], s[3 * 33] * s0[3]); o.z = cvtpk(s[4 * 33] * s1[0], s[5 * 33] * s1[1]); o.w = cvtpk(s[6 * 33] * s1[2], s[7 * 33] * s1[3]);
        st16s(d.dst + (size_t)n * d.ldd + 8 * c, 0, o); }
    LDS_WAIT(); asm volatile("" ::: "memory");
}
__device__ __forceinline__ void moe_convert(const Args& a, int layer, LAS unsigned char* lds, int gw, int NGW, int wave, int lane) {
    LAS float* scr = (LAS float*)(lds + wave * 16384);
    int it = gw; if (it >= MOE_CONV_ITEMS) return;
    TrDesc da = moe_desc(a, layer, it), db = da; float va[32], vb[32]; tr_load(da, va, lane);
    for (;;) {
        const int it2 = it + NGW; const bool h2 = it2 < MOE_CONV_ITEMS;
        if (h2) { db = moe_desc(a, layer, it2); tr_load(db, vb, lane); }
        tr_store(da, va, scr, lane); if (!h2) break;
        const int it3 = it2 + NGW; const bool h3 = it3 < MOE_CONV_ITEMS;
        if (h3) { da = moe_desc(a, layer, it3); tr_load(da, va, lane); }
        tr_store(db, vb, scr, lane); if (!h3) break;
        it = it3; }
}
__device__ __forceinline__ void combine_phase(const Args& a, bool last, int gw, int NGW, int lane) {
    const bf16_t* Y = (const bf16_t*)(a.ws + (last ? Y1_BASE : R2_Y)); bf16_t* XB = (bf16_t*)(a.ws + WS_XB); float* SS = (float*)(a.ws + WS_SS); const float* g = a.in[3];
    for (int row = gw; row < N; row += NGW) {
        u32x2* xr = (u32x2*)(XB + (size_t)row * D) + lane; const u32x2* y0 = (const u32x2*)(Y + (size_t)row * D) + lane; const u32x2* y1 = (const u32x2*)(Y + (size_t)N * D + (size_t)row * D) + lane;
        f32x4 v[4]; float ssq = 0.f; u32x2 hx[4], p[4], q[4];
#pragma unroll
        for (int j = 0; j < 4; ++j) { hx[j] = xr[64 * j]; p[j] = y0[64 * j]; q[j] = y1[64 * j]; }
#pragma unroll
        for (int j = 0; j < 4; ++j) {
            v[j][0] = bflo(hx[j].x) + bflo(p[j].x) + bflo(q[j].x); v[j][1] = bfhi(hx[j].x) + bfhi(p[j].x) + bfhi(q[j].x); v[j][2] = bflo(hx[j].y) + bflo(p[j].y) + bflo(q[j].y); v[j][3] = bfhi(hx[j].y) + bfhi(p[j].y) + bfhi(q[j].y);
            ssq += (v[j][0] * v[j][0] + v[j][1] * v[j][1]) + (v[j][2] * v[j][2] + v[j][3] * v[j][3]); }
        ssq = wave_sum(ssq);
        if (!last) {
#pragma unroll
            for (int j = 0; j < 4; ++j) { u32x2 wv; wv.x = cvtpk(v[j][0], v[j][1]); wv.y = cvtpk(v[j][2], v[j][3]); st8s(xr, 512 * j, wv); }
            if (lane == 0) SS[row] = ssq;
        } else { const float rstd = 1.f / sqrtf(ssq * (1.f / D) + EPS); f32x4* orow = (f32x4*)(a.out + (size_t)row * D) + lane;
#pragma unroll
            for (int j = 0; j < 4; ++j) { const f32x4 gg = ((const f32x4*)g)[lane + 64 * j]; st16fs(orow, 1024 * j, v[j] * rstd * gg); } }
    }
}
__device__ __forceinline__ void moe_tables(const Args& a, int layer, LAS unsigned char* lds, const int tid) {
    LAS int* pre = (LAS int*)(lds + MISC_PRE); LAS int* cn = (LAS int*)(lds + MISC_CNT);
    const unsigned* cnt = (const unsigned*)(a.ws + WS_CTL) + CW_CNT + layer * 1024;
    __syncthreads();
    if (tid < 64) {
        const int e = tid & 31; const int c = (int)__hip_atomic_load(cnt + e * 16, __ATOMIC_RELAXED, __HIP_MEMORY_SCOPE_AGENT);
        const int tiles = (c + 255) >> 8, full = c >> 8, tail = c & 255; int pt = tiles, pf = full;
#pragma unroll
        for (int o = 1; o < 32; o <<= 1) { const int ut = __shfl_up(pt, o, 32), uf = __shfl_up(pf, o, 32); if (e >= o) { pt += ut; pf += uf; } }
        int rank = 0, ntail = 0;
#pragma unroll 8
        for (int j = 0; j < 32; ++j) { const int tj = __shfl(tail, j, 32); ntail += tj ? 1 : 0; rank += (tj > tail || (tj == tail && j < e)) ? 1 : 0; }
        if (tid < 32) { cn[e] = c; pre[e] = pt - tiles; pre[40 + e] = pf - full; if (tail) pre[80 + rank] = e;
            if (e == 31) { pre[32] = pt; pre[72] = pf; pre[112] = ntail; } }
    }
    __syncthreads();
}

__global__ void __launch_bounds__(NTHREADS, 2) mega(Args args) {
    extern __shared__ __attribute__((aligned(16))) unsigned char lds_raw[];
    LAS unsigned char* lds = (LAS unsigned char*)lds_raw;
    const int G = gridDim.x;
    const int lo = args.ph_lo, hi = args.ph_hi;
    if (args.use_bar) { if (threadIdx.x < 2) ((volatile LAS unsigned*)(lds + MISC_BAR))[threadIdx.x] = 0u; __syncthreads();
        (void)xcd_barrier_post((unsigned*)(args.ws + WS_CTL) + CW_BAR, (volatile LAS unsigned*)(lds + MISC_BAR)); }
#define IN(k) (lo <= (k) && (k) < hi)
#define SEAM(k) do { if (IN(k) && IN((k) + 1)) { const Args ba_ = load_args(); grid_barrier(ba_, lds); } } while (0)
#define LA() const Args args = load_args(); unsigned char* ws = args.ws; (void)ws; int tid = threadIdx.x; asm volatile("" : "+v"(tid)); int bx = blockIdx.x; asm volatile("" : "+s"(bx)); \
    const int lane = tid & 63, wave = __builtin_amdgcn_readfirstlane(tid >> 6), vcu = (G % 8 == 0) ? (bx % 8) * (G / 8) + bx / 8 : bx, gw = vcu * NWAVES + wave, NGW = G * NWAVES; (void)lane; (void)gw; (void)NGW
    if (IN(0)) { LA(); p0_prologue<0>(args, lds, gw, NGW, wave, lane); }
    SEAM(0);
    if (IN(1)) {
#pragma nounroll
        for (int pass = 0; pass < 2; ++pass) {
            { LA(); if (pass == (vcu & 1)) { __syncthreads(); p0_prologue<1>(args, lds, gw, NGW, wave, lane); __syncthreads(); } }
            if (pass == 0) { LA(); fox_cumsum(args, lds, G, tid);
                pg8::Dense P; P.init((const bf16_t*)(ws + WS_XB), 1024, (const bf16_t*)(ws + WS_WIN0), N, 3072, 1024, G, bx);
                pg8::EpiQkv0 E{(bf16_t*)(ws + R1_QKV0), (const float*)(ws + WS_SS)};
                pg8::gemm_phase<pg8::EpiQkv0, pg8::Dense, false>(lds, P, E, tid); }
        }
    }
    SEAM(1);
    if (IN(2)) { LA(); attn_phase0(args, lds, vcu, G, tid); }
    SEAM(2);
#ifndef CONV_IN_WOUT
#define CONV_IN_WOUT 3
#endif
#ifndef MERGE_IN_WOUT
#define MERGE_IN_WOUT 1
#endif
#if !MERGE_IN_WOUT
    if (IN(3)) { LA(); merge_phase(args, gw, NGW, lane); if (!(CONV_IN_WOUT & 1)) moe_convert(args, 0, lds, gw, NGW, wave, lane); }
    SEAM(3);
#endif
    for (int layer = 0; layer < 2; ++layer) {
        const int pb = layer == 0 ? 4 : 12;
        if (layer == 1) {
            if (IN(9)) { LA();
                unsigned* rdy = (unsigned*)(ws + WS_CTL) + CW_RDY2;
                { pg8::DenseT<1> P; P.init((const bf16_t*)(ws + WS_XB), 1024, (const bf16_t*)(ws + WS_WIN1), N, 1536, 1024, G, bx); P.ready = rdy;
                  pg8::EpiWin1 E{(bf16_t*)(ws + R1_Z1), (const float*)(ws + WS_SS), (float*)(ws + WS_SSZ), (const f32x2*)(ws + WS_ROPE)};
                  pg8::gemm_phase<pg8::EpiWin1, pg8::DenseT<1>, false>(lds, P, E, tid); }
                { const int ce = bx >= 128 ? bx - 128 : (bx >= 64 ? 64 + bx : (1 << 20));
                  pg8::DenseT<2> P; P.init((const bf16_t*)(ws + R1_Z1), 1536, (const bf16_t*)(ws + WS_WUQ), N, 768, 384, 1 << 20, ce); P.ready = rdy; P.need = 16u; P.sel = 0;
                  pg8::EpiUq E{(bf16_t*)(ws + R1_Q1), (const float*)(ws + WS_SSZ), (const f32x2*)(ws + WS_ROPE)};
                  int tid2 = threadIdx.x; asm volatile("" : "+v"(tid2));
                  pg8::gemm_phase<pg8::EpiUq, pg8::DenseT<2>, false>(lds, P, E, tid2); }
                { const int ce = bx >= 128 ? bx - 128 : (1 << 20);
                  pg8::DenseT<2> P; P.init((const bf16_t*)(ws + R1_Z1) + 512, 1536, (const bf16_t*)(ws + WS_WUKV), N, 1024, 256, 128, ce); P.ready = rdy; P.need = 8u; P.sel = 1;
                  pg8::EpiUkv E{(bf16_t*)(ws + R1_KV1), (const float*)(ws + WS_SSZ)};
                  int tid3 = threadIdx.x; asm volatile("" : "+v"(tid3));
                  pg8::gemm_phase<pg8::EpiUkv, pg8::DenseT<2>, false>(lds, P, E, tid3); } }
            SEAM(10);
            if (IN(11)) { LA(); attn_phase1(args, lds, vcu, G, tid); if (!(CONV_IN_WOUT & 2)) moe_convert(args, 1, lds, gw, NGW, wave, lane); }
            SEAM(11);
        }
        if (IN(pb)) { LA();
            const bool cv = (CONV_IN_WOUT >> layer) & 1;
            unsigned* mrdy = (unsigned*)(ws + WS_CTL) + CW_RDY3;
            if (MERGE_IN_WOUT && layer == 0) {
                pg8::Dense P0; P0.init((const bf16_t*)(ws + R2_AO), 1024, (const bf16_t*)(ws + WS_WOUT0), N, 1024, 1024, G, bx); pg8::Unit u0;
                for (int i = 0; P0.next(i, u0); ++i) merge_panel_part(args, u0.pm * 256 + u0.pn * 64, wave, lane, mrdy + 64 * u0.pm); }
            if (cv && !(vcu & 1)) { __syncthreads(); moe_convert(args, layer, lds, gw, NGW, wave, lane); __syncthreads(); }
            if (MERGE_IN_WOUT && layer == 0) {
                pg8::DenseT<2> P; P.init((const bf16_t*)(ws + R2_AO), 1024, (const bf16_t*)(ws + WS_WOUT0), N, 1024, 1024, G, bx); P.ready = mrdy; P.need = 32u; P.sel = 0;
                pg8::EpiOut E{(bf16_t*)(ws + WS_XB), (float*)(ws + WS_SSP)};
                pg8::gemm_phase<pg8::EpiOut, pg8::DenseT<2>, false>(lds, P, E, tid);
            } else { pg8::Dense P; P.init((const bf16_t*)(ws + R2_AO), 1024, (const bf16_t*)(ws + (layer == 0 ? WS_WOUT0 : WS_WOUT1)), N, 1024, 1024, G, bx);
              pg8::EpiOut E{(bf16_t*)(ws + WS_XB), (float*)(ws + WS_SSP)};
              pg8::gemm_phase<pg8::EpiOut, pg8::Dense, false>(lds, P, E, tid); }
            if (cv && (vcu & 1)) { __syncthreads(); int l2 = threadIdx.x & 63; asm volatile("" : "+v"(l2)); moe_convert(args, layer, lds, gw, NGW, wave, l2); } }
        SEAM(pb);
        if (IN(pb + 1)) { LA(); route_phase(args, layer, lds, vcu, G, wave, lane); }
        SEAM(pb + 1);
        if (IN(pb + 2)) { LA(); moe_tables(args, layer, lds, tid);
            unsigned* rdy = (unsigned*)(ws + WS_CTL) + CW_RDY + layer * 8192;
            { pg8::MoeProb<1> P{(const LAS int*)(lds + MISC_PRE), (const LAS int*)(lds + MISC_CNT), 2, G, vcu, 1024, 1024, (const bf16_t*)(ws + WS_XB), (const bf16_t*)(ws + (layer ? R2_WGU1 : R1_WGU)), (size_t)512 * 1024, (const unsigned*)(ws + WS_LT), true, rdy, 16u};
              pg8::EpiGateUp E{(bf16_t*)(ws + R1_ACT), (const float*)(ws + WS_LW), (const float*)(ws + WS_LR)};
              pg8::gemm_phase<pg8::EpiGateUp, pg8::MoeProb<1>, true>(lds, P, E, tid, (LAS unsigned*)(lds + MISC_STASH)); }
            { int tid2 = threadIdx.x; asm volatile("" : "+v"(tid2));
              pg8::MoeProb<2> P{(const LAS int*)(lds + MISC_PRE), (const LAS int*)(lds + MISC_CNT), 4, G, vcu, 256, 256, (const bf16_t*)(ws + R1_ACT), (const bf16_t*)(ws + (layer ? R2_WD1 : R1_WD)), (size_t)1024 * 256, (const unsigned*)(ws + WS_LT), false, rdy, 16u};
              pg8::EpiDown E{(bf16_t*)(ws + (layer ? Y1_BASE : R2_Y)), (const unsigned*)(ws + WS_LT)};
              pg8::gemm_phase<pg8::EpiDown, pg8::MoeProb<2>, false>(lds, P, E, tid2); } }
        SEAM(pb + 3);
        if (IN(pb + 4)) { LA(); combine_phase(args, layer == 1, gw, NGW, lane); }
        if (layer == 0) SEAM(8);
    }
#undef IN
#undef SEAM
#undef LA
}
}
extern "C" void kernel_launch(void* const* d_in, const int* in_sizes, int n_in, void* d_out, int out_size, void* d_ws, size_t ws_size, hipStream_t stream) {
    using namespace mk;
    static int grid = 0;
    if (grid == 0) {
        if (n_in != 21 || out_size != N * D || ws_size < 283 * MiB) { fprintf(stderr, "kernel_launch: unexpected problem (n_in %d out %d ws %zu)\n", n_in, out_size, ws_size); grid = -1; return; }
        int dev = 0, cus = 0, per_cu = 0;
        if (hipGetDevice(&dev) != hipSuccess || hipDeviceGetAttribute(&cus, hipDeviceAttributeMultiprocessorCount, dev) != hipSuccess) { grid = -1; return; }
        if (hipFuncSetAttribute((const void*)mega, hipFuncAttributeMaxDynamicSharedMemorySize, LDS_BYTES) != hipSuccess) { fprintf(stderr, "kernel_launch: hipFuncSetAttribute failed\n"); grid = -1; return; }
        if (hipOccupancyMaxActiveBlocksPerMultiprocessor(&per_cu, (const void*)mega, NTHREADS, LDS_BYTES) != hipSuccess || per_cu < 1) { fprintf(stderr, "kernel_launch: occupancy query says %d blocks per CU\n", per_cu); (void)hipGetLastError(); grid = -1; return; }
        grid = cus;
    }
    if (grid < 0) return;
    Args a{};
    for (int i = 0; i < 21; ++i) a.in[i] = (const float*)d_in[i];
    a.out = (float*)d_out; a.ws = (unsigned char*)d_ws; a.H = (float*)d_out; a.use_bar = 1; a.ph_lo = 0; a.ph_hi = NPHASE;
    (void)hipMemsetAsync((char*)d_ws + WS_CTL, 0, CTL_ZERO_BYTES, stream);
    hipLaunchKernelGGL(mega, dim3(grid), dim3(NTHREADS), LDS_BYTES, stream, a);
}
```

```cpp
#define CONV_IN_WOUT 3
#include <hip/hip_runtime.h>
#include <cstdio>
#include <cstdint>
#include <cmath>
#define LAS __attribute__((address_space(3)))
#define GAS __attribute__((address_space(1)))
typedef unsigned short bf16_t;
typedef short bf16x8 __attribute__((ext_vector_type(8)));
typedef short s16x4 __attribute__((ext_vector_type(4)));
typedef float f32x2 __attribute__((ext_vector_type(2)));
typedef float f32x4 __attribute__((ext_vector_type(4)));
typedef float f32x16 __attribute__((ext_vector_type(16)));
typedef unsigned u32x2 __attribute__((ext_vector_type(2)));
typedef unsigned u32x4 __attribute__((ext_vector_type(4)));
typedef __bf16 bf16x2_t __attribute__((ext_vector_type(2)));
__device__ __forceinline__ unsigned cvtpk(float lo, float hi) { f32x2 v = {lo, hi}; bf16x2_t b = __builtin_convertvector(v, bf16x2_t); return __builtin_bit_cast(unsigned, b); }
__device__ __forceinline__ float bf2f(unsigned short u) { return __uint_as_float((unsigned)u << 16); }
__device__ __forceinline__ float bflo(unsigned u) { return __uint_as_float(u << 16); }
__device__ __forceinline__ float bfhi(unsigned u) { return __uint_as_float(u & 0xffff0000u); }
#ifndef WT_G
#define WT_G 0
#endif
#ifndef WT_A
#define WT_A 0
#endif
#ifndef WT_S
#define WT_S 0
#endif
template <int WTF> __device__ __forceinline__ void st16x(void* p, int off, u32x4 v) {
    if constexpr (WTF) asm volatile("global_store_dwordx4 %0, %1, off offset:%2 sc1\n\ts_nop 1" :: "v"(p), "v"(v), "i"(off) : "memory");
    else *(u32x4*)((char*)p + off) = v;
}
template <int WTF> __device__ __forceinline__ void st8x(void* p, int off, u32x2 v) {
    if constexpr (WTF) asm volatile("global_store_dwordx2 %0, %1, off offset:%2 sc1" :: "v"(p), "v"(v), "i"(off) : "memory");
    else *(u32x2*)((char*)p + off) = v;
}
template <int WTF> __device__ __forceinline__ void st4x(void* p, int off, unsigned v) {
    if constexpr (WTF) asm volatile("global_store_dword %0, %1, off offset:%2 sc1" :: "v"(p), "v"(v), "i"(off) : "memory");
    else *(unsigned*)((char*)p + off) = v;
}
#define st16g st16x<WT_G>
#define st8g  st8x<WT_G>
#define st16a st16x<WT_A>
#define st16s st16x<WT_S>
#define st8s  st8x<WT_S>
__device__ __forceinline__ void st16fs(void* p, int off, f32x4 v) { st16x<WT_S>(p, off, __builtin_bit_cast(u32x4, v)); }

namespace pg8 {
constexpr int BM = 256, BK = 64, HALF = 128, HTB = HALF * BK * 2  , STAGE_BYTES = 8 * HTB, NXCD = 8, WGM = 8;
__host__ __device__ __forceinline__ int lds_byte(int r, int c) { const int st = (r >> 4) * 2 + (c >> 5), rr = r & 15, cc = c & 31, ob = rr * 64 + cc * 2; return st * 1024 + (ob ^ (((ob >> 9) & 1) << 5)); }
__host__ __device__ __forceinline__ void stage_rc(int b, int& R, int& C) { const int st = b / 1024, sb = b % 1024, swz = sb ^ (((sb >> 9) & 1) << 5); R = (st >> 1) * 16 + swz / 64; C = (st & 1) * 32 + (swz % 64) / 2; }
__host__ __device__ __forceinline__ int perm32(int rho) { const int n = rho >> 4, i = rho & 15; return 8 * (i >> 2) + 4 * n + (i & 3); }

struct Unit { int pm, pn, e, rt, rows; };

template <int MODE>
struct DenseT {
    static constexpr bool ROWSKIP = false;
    const bf16_t* A; const bf16_t* Bt; int lda, K; int nM, nN, nwg, G, c; unsigned* ready; unsigned need; int sel;
    __device__ void init(const bf16_t* A_, int lda_, const bf16_t* Bt_, int M, int N, int K_, int G_, int c_) { A = A_; lda = lda_; Bt = Bt_; K = K_; nM = M / BM; nN = N / BM; nwg = nM * nN; G = G_; c = c_; ready = nullptr; need = 0u; sel = 0; }
    __device__ __forceinline__ bool next(int i, Unit& u) const {
        const long L = (long)i * G + c; if (L >= nwg) return false;
        int wgid = (int)L; { const int q = nwg / NXCD, r = nwg % NXCD, xcd = wgid % NXCD, off = wgid / NXCD; wgid = (xcd < r ? xcd * (q + 1) : r * (q + 1) + (xcd - r) * q) + off; }
        const int nig = WGM * nN, gid = wgid / nig, fm = gid * WGM, gsz = (nM - fm) < WGM ? (nM - fm) : WGM;
        u.pm = fm + ((wgid % nig) % gsz); u.pn = (wgid % nig) / gsz; u.e = 0; u.rt = 0; u.rows = 256; return true;
    }
    __device__ __forceinline__ const char* a_base(const Unit& u) const { return (const char*)A + (size_t)u.pm * BM * lda * 2; }
    __device__ __forceinline__ const char* b_base(const Unit& u) const { return (const char*)Bt + (size_t)u.pn * BM * K * 2; }
    __device__ __forceinline__ void a_ready(const Unit& u) const {
        if constexpr (MODE == 2) {
            if (threadIdx.x < 64) {
                unsigned polls = 0;
                while ((unsigned)__builtin_amdgcn_readfirstlane((int)__hip_atomic_load(ready + 32 * (2 * u.pm + sel), __ATOMIC_RELAXED, __HIP_MEMORY_SCOPE_AGENT)) < need) {
                    __builtin_amdgcn_s_sleep(2); if (++polls > (1u << 19)) break; }
                __builtin_amdgcn_fence(__ATOMIC_ACQUIRE, "agent");
                asm volatile("s_waitcnt vmcnt(0)" ::: "memory");
            }
            asm volatile("" ::: "memory"); __builtin_amdgcn_s_barrier(); asm volatile("" ::: "memory");
        }
    }
    __device__ __forceinline__ void done(const Unit& u) const {
        if constexpr (MODE == 1) {
            if (u.pn < 3) {
                asm volatile("s_waitcnt vmcnt(0)" ::: "memory");
                if ((threadIdx.x & 63) == 0) __hip_atomic_fetch_add(ready + 32 * (2 * u.pm + (u.pn == 2 ? 1 : 0)), 1u, __ATOMIC_RELAXED, __HIP_MEMORY_SCOPE_AGENT); }
        }
    }
    __device__ __forceinline__ void a_voff(const Unit&, int R0, int C0, int R1, int C1, unsigned (&vo)[2][2]) const {
        vo[0][0] = (unsigned)(R0 * lda + C0) * 2u; vo[0][1] = (unsigned)(R1 * lda + C1) * 2u; vo[1][0] = vo[0][0]; vo[1][1] = vo[0][1]; }
    __device__ __forceinline__ size_t a_hstep() const { return (size_t)HALF * lda * 2; }
};
using Dense = DenseT<0>;

__device__ __forceinline__ void glds_s(const char* sbase, unsigned voff, unsigned lds_dst) { unsigned keep;
    asm volatile("s_mov_b32 %0, m0\n\ts_mov_b32 m0, %2\n\ts_nop 0\n\tglobal_load_lds_dwordx4 %1, %3\n\ts_mov_b32 m0, %0" : "=&s"(keep) : "v"(voff), "s"(lds_dst), "s"(sbase) : "memory"); }
template <class Epi, class Prob, bool GATHER>
__device__ __forceinline__ void gemm_phase(LAS unsigned char* lds, const Prob& S, const Epi& E, const int tid, LAS unsigned* stash = nullptr) {
    const int wid = __builtin_amdgcn_readfirstlane(tid >> 6), lane = tid & 63, wr = wid >> 2, wc = wid & 3, fr = lane & 15, fq = lane >> 4;
    const int K = S.K, nt = K / BK;
    int R0, C0, R1, C1; stage_rc(tid * 16, R0, C0); stage_rc(tid * 16 + 8192, R1, C1);
    unsigned voffB[2];
    { const int Rb0 = Epi::WIDE ? ((R0 >> 5) * 64 + perm32(R0 & 31)) : Epi::PERM ? ((R0 & ~31) + perm32(R0 & 31)) : R0, Rb1 = Epi::WIDE ? ((R1 >> 5) * 64 + perm32(R1 & 31)) : Epi::PERM ? ((R1 & ~31) + perm32(R1 & 31)) : R1;
      voffB[0] = (unsigned)(Rb0 * K + C0) * 2u; voffB[1] = (unsigned)(Rb1 * K + C1) * 2u; }
    const size_t kstep = (size_t)(BK * 2);
    const size_t hstepB = (size_t)(Epi::WIDE ? 32 : HALF) * K * 2;
    const size_t hstepA = GATHER ? 0 : S.a_hstep();
    const unsigned ldsb = (unsigned)(uintptr_t)lds + (unsigned)wid * 1024u;
    const int aoff = lds_byte(wr * 64 + fr, fq * 8), boff = lds_byte(wc * 32 + fr, fq * 8);
#define PG8_SA(b, h) (((b) * 2 + (h)) * HTB)
#define PG8_SB(b, h) ((4 + (b) * 2 + (h)) * HTB)
#define PG8_STAGE(bufoff, gbase, voff) do { _Pragma("unroll") for (int _i = 0; _i < 2; ++_i) \
        glds_s((const char*)(gbase), (voff)[_i], ldsb + (unsigned)((bufoff) + _i * 8192)); } while (0)
#define PG8_LDA(dst, b, h) do { _Pragma("unroll") for (int m = 0; m < 4; ++m) _Pragma("unroll") for (int k = 0; k < 2; ++k) dst[m][k] = *(const LAS bf16x8*)(lds + PG8_SA(b, h) + aoff + m * 2048 + k * 1024); } while (0)
#define PG8_LDB(dst, b, h) do { _Pragma("unroll") for (int n = 0; n < 2; ++n) _Pragma("unroll") for (int k = 0; k < 2; ++k) dst[n][k] = *(const LAS bf16x8*)(lds + PG8_SB(b, h) + boff + n * 2048 + k * 1024); } while (0)
#define PG8_MMA(ai, bj, At, Bt) do { __builtin_amdgcn_s_setprio(1); _Pragma("unroll") for (int m = 0; m < 4; ++m) { if (!Prob::ROWSKIP || (ai) * HALF + wr * 64 + m * 16 < rows_cur) { _Pragma("unroll") for (int n = 0; n < 2; ++n) _Pragma("unroll") for (int k = 0; k < 2; ++k) \
        acc[ai][bj][m][n] = __builtin_amdgcn_mfma_f32_16x16x32_bf16(Bt[n][k], At[m][k], acc[ai][bj][m][n], 0, 0, 0); } } __builtin_amdgcn_s_setprio(0); } while (0)
#define PG8_WAIT_V(n) asm volatile("s_waitcnt vmcnt(" #n ")" ::: "memory")
#define PG8_WAIT_L(n) asm volatile("s_waitcnt lgkmcnt(" #n ")" ::: "memory")
#define PG8_BAR __builtin_amdgcn_s_barrier()
#define PG8_SCHED __builtin_amdgcn_sched_barrier(0)
    Unit cur, nxt; int ui = 0;
    if (!S.next(0, cur)) return;
    bool has_next = S.next(1, nxt);
    unsigned voffA[2][2];
    S.a_voff(cur, R0, C0, R1, C1, voffA);
    LAS u32x4* const st4 = (LAS u32x4*)stash + tid;
    if (GATHER) { unsigned vn[2][2]; if (has_next) S.a_voff(nxt, R0, C0, R1, C1, vn); else { vn[0][0] = voffA[0][0]; vn[0][1] = voffA[0][1]; vn[1][0] = voffA[1][0]; vn[1][1] = voffA[1][1]; }
        *st4 = (u32x4){vn[0][0], vn[0][1], vn[1][0], vn[1][1]};
        asm volatile("s_waitcnt vmcnt(0)" : "+v"(voffA[0][0]), "+v"(voffA[0][1]), "+v"(voffA[1][0]), "+v"(voffA[1][1]) :: "memory"); }
    f32x4 acc[2][2][4][2];
#pragma unroll
    for (int a = 0; a < 2; ++a)
#pragma unroll
        for (int b = 0; b < 2; ++b)
#pragma unroll
            for (int m = 0; m < 4; ++m)
#pragma unroll
                for (int n = 0; n < 2; ++n) acc[a][b][m][n] = (f32x4){0.f, 0.f, 0.f, 0.f};
    bf16x8 At[4][2], B0[2][2], B1[2][2];
    const char* cA = S.a_base(cur); const char* cB = S.b_base(cur); int rows_cur = cur.rows; (void)rows_cur;
    S.a_ready(cur);
    PG8_STAGE(PG8_SB(0, 0), cB, voffB); PG8_STAGE(PG8_SB(0, 1), cB + hstepB, voffB); PG8_STAGE(PG8_SA(0, 0), cA, voffA[0]); PG8_STAGE(PG8_SA(0, 1), cA + hstepA, voffA[1]);
    if (wr == 1) PG8_BAR;
    PG8_WAIT_V(2); PG8_BAR;
    PG8_STAGE(PG8_SB(1, 0), cB + kstep, voffB); PG8_STAGE(PG8_SA(1, 0), cA + kstep, voffA[0]); PG8_STAGE(PG8_SB(1, 1), cB + hstepB + kstep, voffB);
    PG8_WAIT_V(6); PG8_BAR;
    for (;;) {
        const char* nA = has_next ? S.a_base(nxt) : cA; const char* nB = has_next ? S.b_base(nxt) : cB;
#pragma unroll 1
        for (int t = 0; t < nt; t += 2) {
            const bool last = (t == nt - 2);
            if (last && has_next) S.a_ready(nxt);
            const char* a1 = cA + (size_t)(t + 1) * kstep;
            const char* a2 = last ? nA : cA + (size_t)(t + 2) * kstep; const char* b2 = last ? nB : cB + (size_t)(t + 2) * kstep;
            const char* a3 = a2 + kstep; const char* b3 = b2 + kstep;
            unsigned v20 = voffA[0][0], v21 = voffA[0][1], v30 = voffA[1][0], v31 = voffA[1][1];
            if (GATHER) { if (last) { const u32x4 n4 = *st4; v20 = n4.x; v21 = n4.y; v30 = n4.z; v31 = n4.w; } }
            const unsigned vh0[2] = {v20, v21}, vh1[2] = {v30, v31};
            PG8_LDB(B0, 0, 0); PG8_LDB(B1, 0, 1); PG8_SCHED; PG8_LDA(At, 0, 0); PG8_STAGE(PG8_SA(1, 1), a1 + hstepA, voffA[1]);
            PG8_WAIT_V(8); PG8_WAIT_L(0); PG8_BAR; PG8_MMA(0, 0, At, B0); PG8_MMA(0, 1, At, B1); PG8_BAR; PG8_SCHED;
            PG8_LDA(At, 0, 1); PG8_STAGE(PG8_SB(0, 0), b2, voffB); PG8_STAGE(PG8_SB(0, 1), b2 + hstepB, voffB); PG8_STAGE(PG8_SA(0, 0), a2, vh0);
            PG8_WAIT_V(8); PG8_WAIT_L(0); PG8_BAR; PG8_MMA(1, 0, At, B0); PG8_MMA(1, 1, At, B1); PG8_BAR; PG8_SCHED;
            PG8_LDB(B0, 1, 0); PG8_LDB(B1, 1, 1); PG8_SCHED; PG8_LDA(At, 1, 0); PG8_STAGE(PG8_SA(0, 1), a2 + hstepA, vh1);
            PG8_WAIT_V(8); PG8_WAIT_L(0); PG8_BAR; PG8_MMA(0, 0, At, B0); PG8_MMA(0, 1, At, B1); PG8_BAR; PG8_SCHED;
            PG8_LDA(At, 1, 1); PG8_STAGE(PG8_SB(1, 0), b3, voffB); PG8_STAGE(PG8_SB(1, 1), b3 + hstepB, voffB); PG8_STAGE(PG8_SA(1, 0), a3, vh0);
            PG8_WAIT_V(8); PG8_WAIT_L(0); PG8_BAR; PG8_MMA(1, 0, At, B0); PG8_MMA(1, 1, At, B1); PG8_BAR; PG8_SCHED;
        }
        if (wr == 0) PG8_BAR;
        { int fr_e = fr, fq_e = fq; asm volatile("" : "+v"(fr_e), "+v"(fq_e));
          E(acc, cur, wr, wc, fr_e, fq_e); }
        S.done(cur);
        if (!has_next) break;
#pragma unroll
        for (int a = 0; a < 2; ++a)
#pragma unroll
            for (int b = 0; b < 2; ++b)
#pragma unroll
                for (int m = 0; m < 4; ++m)
#pragma unroll
                    for (int n = 0; n < 2; ++n) acc[a][b][m][n] = (f32x4){0.f, 0.f, 0.f, 0.f};
        cur = nxt; cA = nA; cB = nB; ++ui; rows_cur = cur.rows;
        has_next = S.next(ui + 1, nxt);
        if (GATHER) {
            { const u32x4 n4 = *st4; voffA[0][0] = n4.x; voffA[0][1] = n4.y; voffA[1][0] = n4.z; voffA[1][1] = n4.w; }
            if (has_next) { unsigned vn[2][2]; S.a_voff(nxt, R0, C0, R1, C1, vn);
                asm volatile("s_waitcnt vmcnt(0)" : "+v"(vn[0][0]), "+v"(vn[0][1]), "+v"(vn[1][0]), "+v"(vn[1][1]) :: "memory");
                *st4 = (u32x4){vn[0][0], vn[0][1], vn[1][0], vn[1][1]}; }
        }
        if (wr == 1) PG8_BAR;
    }
    PG8_WAIT_V(0);
    PG8_BAR;
#undef PG8_SA
#undef PG8_SB
#undef PG8_STAGE
#undef PG8_LDA
#undef PG8_LDB
#undef PG8_MMA
#undef PG8_WAIT_V
#undef PG8_WAIT_L
#undef PG8_BAR
#undef PG8_SCHED
}
}
namespace mk {
constexpr int NB = 4, S = 4096, D = 1024, N = NB * S;
constexpr float EPS = 1e-6f, LOG2E = 1.4426950408889634f;
constexpr float C2_64 = 0.125f * LOG2E, C2_96 = 0.10206207261596575f * LOG2E;
constexpr size_t MiB = 1u << 20;
constexpr size_t WS_CTL = 0, CTL_ZERO_BYTES = 1 * MiB;
constexpr size_t WS_SS = 1 * MiB;
constexpr size_t WS_RSTD = WS_SS + (size_t)N * 4;
constexpr size_t WS_SSP = WS_RSTD + (size_t)N * 4;
constexpr size_t WS_LOGF = WS_SSP + (size_t)N * 64;
constexpr size_t WS_CB2 = WS_LOGF + (size_t)N * 32;
constexpr size_t WS_ROPE = WS_CB2 + (size_t)32 * S * 4;
constexpr size_t WS_DLSE = WS_ROPE + (size_t)S * 16 * 8;
constexpr size_t WS_SSZ = WS_DLSE + (size_t)3 * N * 32;
constexpr size_t WS_LT = WS_SSZ + (size_t)N * 48;
constexpr size_t WS_LW = WS_LT + (size_t)32 * N * 4;
constexpr size_t WS_LR = WS_LW + (size_t)32 * N * 4;
constexpr size_t WS_SMALL_END = WS_LR + (size_t)32 * N * 4;
constexpr size_t WS_KEXT = WS_LT;
static_assert(WS_SMALL_END <= 13 * MiB, "small arrays");
constexpr size_t WS_WIN0 = 13 * MiB;
constexpr size_t WS_WOUT0 = WS_WIN0 + 6 * MiB;
constexpr size_t WS_WIN1 = WS_WOUT0 + 2 * MiB;
constexpr size_t WS_WUQ = WS_WIN1 + 3 * MiB;
constexpr size_t WS_WUKV = WS_WUQ + 768 * 384 * 2;
constexpr size_t WS_WOUT1 = WS_WUKV + 1024 * 256 * 2;
constexpr size_t WS_WR = WS_WOUT1 + 2 * MiB;
static_assert(WS_WR + 2 * 64 * 1024 * 2 <= 28 * MiB, "weights");
constexpr size_t WS_XB = 28 * MiB;
constexpr size_t WS_R1 = 60 * MiB;
constexpr size_t WS_R2 = 164 * MiB;
constexpr size_t WS_END = 244 * MiB;
constexpr size_t R1_QKV0 = WS_R1;
constexpr size_t R1_Z1 = WS_R1, R1_Q1 = WS_R1 + 48 * MiB, R1_KV1 = WS_R1 + 72 * MiB;
constexpr size_t R1_WGU = WS_R1, R1_WD = WS_R1 + 32 * MiB, R1_ACT = WS_R1 + 48 * MiB;
constexpr size_t R2_AO = WS_R2, R2_DPART = WS_R2 + 32 * MiB;
constexpr size_t R2_Y = WS_R2;
constexpr size_t Y1_BASE = 128 * MiB;
constexpr size_t R2_WGU1 = WS_R2 + 32 * MiB, R2_WD1 = WS_R2 + 64 * MiB;
constexpr int CW_CNT = 64;
constexpr int CW_BAR = 4096;
constexpr int CW_RDY2 = 49152;
constexpr int CW_RDY = 16384;
}

#ifndef WIDE_QKV
#define WIDE_QKV 0
#endif
namespace pg8 {
using mk::EPS;
struct EpiQkv0 {
    static constexpr bool PERM = true; static constexpr bool WIDE = (WIDE_QKV != 0);
    bf16_t* O; const float* ss;
    __device__ __forceinline__ void operator()(const f32x4 (&acc)[2][2][4][2], const Unit& u, int wr, int wc, int fr, int fq) const {
        const int row0 = u.pm * BM + wr * 64 + fr, col0 = u.pn * BM + (WIDE ? wc * 64 : wc * 32) + 8 * fq;
        const float sc = (u.pn < 2 || u.pn == 6 || u.pn == 7) ? mk::C2_64 : 1.f;
        float rs[8];
#pragma unroll
        for (int i = 0; i < 8; ++i) rs[i] = ss[row0 + (i >> 2) * HALF + (i & 3) * 16];
#pragma unroll
        for (int i = 0; i < 8; ++i) rs[i] = sc / sqrtf(rs[i] * (1.f / 1024.f) + EPS);
#pragma unroll
        for (int ai = 0; ai < 2; ++ai)
#pragma unroll
            for (int m = 0; m < 4; ++m) { const int row = row0 + ai * HALF + m * 16; const float r_ = rs[ai * 4 + m];
                bf16_t* rowp = O + (size_t)row * 3072 + col0;
#pragma unroll
                for (int bj = 0; bj < 2; ++bj) { const f32x4 v0 = acc[ai][bj][m][0] * r_, v1 = acc[ai][bj][m][1] * r_;
                    u32x4 w; w.x = cvtpk(v0[0], v0[1]); w.y = cvtpk(v0[2], v0[3]); w.z = cvtpk(v1[0], v1[1]); w.w = cvtpk(v1[2], v1[3]);
                    st16g(rowp, WIDE ? bj * 64 : bj * HALF * 2, w); } }
    }
};
struct EpiOut {
    static constexpr bool PERM = false; static constexpr bool WIDE = false;
    bf16_t* X; float* ssp;
    __device__ __forceinline__ void operator()(const f32x4 (&acc)[2][2][4][2], const Unit& u, int wr, int wc, int fr, int fq) const {
        const int row0 = u.pm * BM + wr * 64 + fr, col0 = u.pn * BM + wc * 32 + 4 * fq;
        u32x2 rb[8][4];
#pragma unroll
        for (int i = 0; i < 8; ++i) { const size_t off = (size_t)(row0 + (i >> 2) * HALF + (i & 3) * 16) * 1024 + col0;
#pragma unroll
            for (int qq = 0; qq < 4; ++qq) rb[i][qq] = *(const u32x2*)(X + off + (qq >> 1) * HALF + (qq & 1) * 16); }
#pragma unroll
        for (int i = 0; i < 8; ++i) { const int ai = i >> 2, m = i & 3; const int row = row0 + ai * HALF + m * 16; const size_t off = (size_t)row * 1024 + col0; float q = 0.f;
#pragma unroll
            for (int qq = 0; qq < 4; ++qq) { const f32x4 a4 = acc[ai][qq >> 1][m][qq & 1]; const u32x2 r2 = rb[i][qq];
                const float v0 = bflo(r2.x) + a4[0], v1 = bfhi(r2.x) + a4[1], v2 = bflo(r2.y) + a4[2], v3 = bfhi(r2.y) + a4[3];
                u32x2 w; w.x = cvtpk(v0, v1); w.y = cvtpk(v2, v3); st8g(X + off, ((qq >> 1) * HALF + (qq & 1) * 16) * 2, w);
                q += (v0 * v0 + v1 * v1) + (v2 * v2 + v3 * v3); }
            q += __shfl_xor(q, 16); q += __shfl_xor(q, 32);
            if (fq == 0) ssp[(size_t)row * 16 + u.pn * 4 + wc] = q; }
    }
};
struct EpiWin1 {
    static constexpr bool PERM = false; static constexpr bool WIDE = false;
    bf16_t* Z; const float* ss; float* ssz; const f32x2* rope;
    __device__ __forceinline__ void operator()(const f32x4 (&acc)[2][2][4][2], const Unit& u, int wr, int wc, int fr, int fq) const {
        const int row0 = u.pm * BM + wr * 64 + fr, col0 = u.pn * BM + wc * 32 + 4 * fq; const int pn = u.pn;
        const float sc = (pn == 3 || pn == 4) ? mk::C2_64 : 1.f; const bool ropew = (pn == 1 && wc == 0);
        float rs[8];
#pragma unroll
        for (int i = 0; i < 8; ++i) rs[i] = ss[row0 + (i >> 2) * HALF + (i & 3) * 16];
#pragma unroll
        for (int i = 0; i < 8; ++i) rs[i] = sc / sqrtf(rs[i] * (1.f / 1024.f) + EPS);
#pragma unroll
        for (int ai = 0; ai < 2; ++ai) {
            f32x4 cs[4][2];
            if (ropew) {
#pragma unroll
                for (int m = 0; m < 4; ++m) { const f32x4* rp = (const f32x4*)(rope + (size_t)((row0 + ai * HALF + m * 16) & (mk::S - 1)) * 16 + 4 * fq); cs[m][0] = rp[0]; cs[m][1] = rp[1]; } }
#pragma unroll
            for (int m = 0; m < 4; ++m) { const int row = row0 + ai * HALF + m * 16; const float r_ = rs[ai * 4 + m];
                bf16_t* rowp = Z + (size_t)row * 1536 + col0; float q = 0.f;
#pragma unroll
                for (int bj = 0; bj < 2; ++bj) { f32x4 v0 = acc[ai][bj][m][0] * r_, v1 = acc[ai][bj][m][1] * r_;
                    if (pn == 1 && bj == 1) {
                        if (wc != 0) continue;
#pragma unroll
                        for (int j = 0; j < 4; ++j) { const float c_ = cs[m][j >> 1][2 * (j & 1)], s_ = cs[m][j >> 1][2 * (j & 1) + 1]; const float t1 = v0[j], t2 = v1[j]; v0[j] = t1 * c_ - t2 * s_; v1[j] = t1 * s_ + t2 * c_; }
                    } else if (pn < 3) q += (v0[0] * v0[0] + v0[1] * v0[1]) + (v0[2] * v0[2] + v0[3] * v0[3]) + (v1[0] * v1[0] + v1[1] * v1[1]) + (v1[2] * v1[2] + v1[3] * v1[3]);
                    u32x2 w0, w1; w0.x = cvtpk(v0[0], v0[1]); w0.y = cvtpk(v0[2], v0[3]); w1.x = cvtpk(v1[0], v1[1]); w1.y = cvtpk(v1[2], v1[3]);
                    st8x<1>(rowp, bj * HALF * 2, w0); st8x<1>(rowp, bj * HALF * 2 + 32, w1); }
                if (pn < 3) { q += __shfl_xor(q, 16); q += __shfl_xor(q, 32); if (fq == 0) st4x<1>(ssz + (size_t)row * 12 + pn * 4 + wc, 0, __float_as_uint(q)); } }
        }
    }
};
struct EpiUq {
    static constexpr bool PERM = false; static constexpr bool WIDE = false;
    bf16_t* Q; const float* ssz; const f32x2* rope;
    __device__ __forceinline__ void operator()(const f32x4 (&acc)[2][2][4][2], const Unit& u, int wr, int wc, int fr, int fq) const {
        const int row0 = u.pm * BM + wr * 64 + fr, col0 = u.pn * BM + wc * 32 + 4 * fq;
        const bool rp0 = ((u.pn * 8 + wc) % 3 == 2), rp1 = ((u.pn * 8 + 4 + wc) % 3 == 2);
        float rs[8];
#pragma unroll
        for (int hb = 0; hb < 2; ++hb) { f32x4 sa[4], sb[4];
#pragma unroll
          for (int i = 0; i < 4; ++i) { const f32x4* sp = (const f32x4*)(ssz + (size_t)(row0 + hb * HALF + i * 16) * 12); sa[i] = sp[0]; sb[i] = sp[1]; }
#pragma unroll
          for (int i = 0; i < 4; ++i) rs[hb * 4 + i] = mk::C2_96 / sqrtf(((sa[i][0] + sa[i][1]) + (sa[i][2] + sa[i][3]) + (sb[i][0] + sb[i][1]) + (sb[i][2] + sb[i][3])) * (1.f / 384.f) + EPS);
          asm volatile("" ::: "memory"); }
#pragma unroll
        for (int ai = 0; ai < 2; ++ai)
#pragma unroll
            for (int mp = 0; mp < 2; ++mp) {
                f32x4 cs[2][2];
                if (rp0 || rp1) {
#pragma unroll
                    for (int mm = 0; mm < 2; ++mm) { const f32x4* rp = (const f32x4*)(rope + (size_t)((row0 + ai * HALF + (2 * mp + mm) * 16) & (mk::S - 1)) * 16 + 4 * fq); cs[mm][0] = rp[0]; cs[mm][1] = rp[1]; } }
#pragma unroll
                for (int mm = 0; mm < 2; ++mm) { const int m = 2 * mp + mm; const int row = row0 + ai * HALF + m * 16; const float r_ = rs[ai * 4 + m];
                    bf16_t* rowp = Q + (size_t)row * 768 + col0;
#pragma unroll
                    for (int bj = 0; bj < 2; ++bj) { f32x4 v0 = acc[ai][bj][m][0] * r_, v1 = acc[ai][bj][m][1] * r_;
                        if (bj == 0 ? rp0 : rp1) {
#pragma unroll
                            for (int j = 0; j < 4; ++j) { const float c_ = cs[mm][j >> 1][2 * (j & 1)], s_ = cs[mm][j >> 1][2 * (j & 1) + 1]; const float t1 = v0[j], t2 = v1[j]; v0[j] = t1 * c_ - t2 * s_; v1[j] = t1 * s_ + t2 * c_; } }
                        u32x2 w0, w1; w0.x = cvtpk(v0[0], v0[1]); w0.y = cvtpk(v0[2], v0[3]); w1.x = cvtpk(v1[0], v1[1]); w1.y = cvtpk(v1[2], v1[3]);
                        st8g(rowp, bj * HALF * 2, w0); st8g(rowp, bj * HALF * 2 + 32, w1); } }
                asm volatile("" ::: "memory"); }
    }
};
struct EpiUkv {
    static constexpr bool PERM = true; static constexpr bool WIDE = false;
    bf16_t* O; const float* ssz;
    __device__ __forceinline__ void operator()(const f32x4 (&acc)[2][2][4][2], const Unit& u, int wr, int wc, int fr, int fq) const {
        const int row0 = u.pm * BM + wr * 64 + fr, col0 = u.pn * BM + wc * 32 + 8 * fq;
        float rs[8];
        { f32x4 sa[8];
#pragma unroll
          for (int i = 0; i < 8; ++i) sa[i] = *(const f32x4*)(ssz + (size_t)(row0 + (i >> 2) * HALF + (i & 3) * 16) * 12 + 8);
#pragma unroll
          for (int i = 0; i < 8; ++i) rs[i] = 1.f / sqrtf(((sa[i][0] + sa[i][1]) + (sa[i][2] + sa[i][3])) * (1.f / 256.f) + EPS); }
#pragma unroll
        for (int ai = 0; ai < 2; ++ai)
#pragma unroll
            for (int m = 0; m < 4; ++m) { const int row = row0 + ai * HALF + m * 16; const float r_ = rs[ai * 4 + m];
                bf16_t* rowp = O + (size_t)row * 1024 + col0;
#pragma unroll
                for (int bj = 0; bj < 2; ++bj) { const f32x4 v0 = acc[ai][bj][m][0] * r_, v1 = acc[ai][bj][m][1] * r_;
                    u32x4 w; w.x = cvtpk(v0[0], v0[1]); w.y = cvtpk(v0[2], v0[3]); w.z = cvtpk(v1[0], v1[1]); w.w = cvtpk(v1[2], v1[3]);
                    st16g(rowp, bj * HALF * 2, w); } }
    }
};
template <int MODE>
struct MoeProb {
    static constexpr bool ROWSKIP = true;
    const LAS int* pre; const LAS int* cnt; int NT, G, c, K, lda;
    const bf16_t* A; const bf16_t* Bt; size_t bstride;
    const unsigned* lt;
    bool gather; unsigned* ready; unsigned need;
    __device__ __forceinline__ bool next(int i, Unit& u) const {
        const int totF = pre[72]; long L;
        if constexpr (MODE == 1) {
            const int F = totF * NT, Tn = pre[112] * NT, r = F % G, nfull = F / G + (c < r ? 1 : 0), Z = G - r;
            if (i < nfull) L = (long)i * G + c;
            else { const int k = i - nfull; int j;
                if (c >= r) { if (k > 1) return false; j = (c - r) + Z * k; if (j >= 2 * Z) return false; }
                else { if (k > 0) return false; j = 2 * Z + c; }
                if (j >= Tn) return false; L = F + j; }
        } else { L = (long)i * G + c; const int total = (totF + pre[112]) * NT; if (L >= total) return false; }
        int f = (int)L / NT; u.pn = (int)L % NT; int e = 0;
        if (f < totF) {
#pragma unroll
            for (int j = 1; j < 32; ++j) if (pre[40 + j] <= f) e = j;
            u.rt = f - pre[40 + e]; u.rows = 256;
        } else { e = pre[80 + f - totF]; u.rt = cnt[e] >> 8; u.rows = cnt[e] & 255; }
        e = __builtin_amdgcn_readfirstlane(e); u.e = e; u.rt = __builtin_amdgcn_readfirstlane(u.rt); u.rows = __builtin_amdgcn_readfirstlane(u.rows); u.pm = __builtin_amdgcn_readfirstlane(pre[e]) + u.rt; return true;
    }
    __device__ __forceinline__ void a_ready(const Unit& u) const {
        if constexpr (MODE == 2) {
            if (threadIdx.x < 64) {
                unsigned polls = 0;
                while ((unsigned)__builtin_amdgcn_readfirstlane((int)__hip_atomic_load(ready + 32 * u.pm, __ATOMIC_RELAXED, __HIP_MEMORY_SCOPE_AGENT)) < need) {
                    __builtin_amdgcn_s_sleep(2); if (++polls > (1u << 19)) break; }
            }
            asm volatile("" ::: "memory"); __builtin_amdgcn_s_barrier(); asm volatile("" ::: "memory");
        }
    }
    __device__ __forceinline__ void done(const Unit& u) const {
        if constexpr (MODE == 1) {
            asm volatile("s_waitcnt vmcnt(0)" ::: "memory");
            if ((threadIdx.x & 63) == 0) __hip_atomic_fetch_add(ready + 32 * u.pm, 1u, __ATOMIC_RELAXED, __HIP_MEMORY_SCOPE_AGENT);
        }
    }
    __device__ __forceinline__ const char* a_base(const Unit& u) const { return gather ? (const char*)A : (const char*)A + (size_t)u.pm * BM * lda * 2; }
    __device__ __forceinline__ size_t a_hstep() const { return (size_t)HALF * lda * 2; }
    __device__ __forceinline__ const char* b_base(const Unit& u) const { return (const char*)Bt + ((size_t)u.e * bstride + (size_t)u.pn * BM * K) * 2; }
    __device__ __forceinline__ void a_voff(const Unit& u, int R0, int C0, int R1, int C1, unsigned (&vo)[2][2]) const {
        if (gather) { const unsigned* l = lt + (size_t)u.e * mk::N + u.rt * 256;
            const unsigned t00 = (R0 < u.rows) ? (l[R0] & 0x7fffffffu) : 0u, t01 = (R1 < u.rows) ? (l[R1] & 0x7fffffffu) : 0u;
            const unsigned t10 = (R0 + HALF < u.rows) ? (l[R0 + HALF] & 0x7fffffffu) : 0u, t11 = (R1 + HALF < u.rows) ? (l[R1 + HALF] & 0x7fffffffu) : 0u;
            vo[0][0] = (t00 * (unsigned)lda + C0) * 2u; vo[0][1] = (t01 * (unsigned)lda + C1) * 2u; vo[1][0] = (t10 * (unsigned)lda + C0) * 2u; vo[1][1] = (t11 * (unsigned)lda + C1) * 2u;
        } else { vo[0][0] = (unsigned)(R0 * lda + C0) * 2u; vo[0][1] = (unsigned)(R1 * lda + C1) * 2u; vo[1][0] = vo[0][0]; vo[1][1] = vo[0][1]; }
    }
};
struct EpiGateUp {
    static constexpr bool PERM = true; static constexpr bool WIDE = false;
    bf16_t* act; const float* lw; const float* lr;
    __device__ __forceinline__ void operator()(const f32x4 (&acc)[2][2][4][2], const Unit& u, int wr, int wc, int fr, int fq) const {
        const int rl0 = wr * 64 + fr, col0 = u.pn * 128 + wc * 32 + 8 * fq; const size_t lbase = (size_t)u.e * mk::N + u.rt * 256;
        float wv[8], rv[8];
#pragma unroll
        for (int i = 0; i < 8; ++i) { const int rl = rl0 + (i >> 2) * HALF + (i & 3) * 16; const bool ok = rl < u.rows; wv[i] = ok ? lw[lbase + rl] : 0.f; rv[i] = ok ? lr[lbase + rl] : 0.f; }
#pragma unroll
        for (int ai = 0; ai < 2; ++ai)
#pragma unroll
            for (int m = 0; m < 4; ++m) { const int rl = rl0 + ai * HALF + m * 16; if (rl >= u.rows) continue;
                const float w = wv[ai * 4 + m], rs = rv[ai * 4 + m]; float o[8];
#pragma unroll
                for (int n = 0; n < 2; ++n)
#pragma unroll
                    for (int j = 0; j < 4; ++j) { const float g = acc[ai][0][m][n][j] * rs, up = acc[ai][1][m][n][j] * rs;
                        o[n * 4 + j] = g * __builtin_amdgcn_rcpf(1.f + __builtin_amdgcn_exp2f(-g * mk::LOG2E)) * up * w; }
                u32x4 pk; pk.x = cvtpk(o[0], o[1]); pk.y = cvtpk(o[2], o[3]); pk.z = cvtpk(o[4], o[5]); pk.w = cvtpk(o[6], o[7]);
                st16x<1>(act + ((size_t)u.pm * 256 + rl) * 256 + col0, 0, pk);   }
    }
};
struct EpiDown {
    static constexpr bool PERM = true; static constexpr bool WIDE = false;
    bf16_t* Y; const unsigned* lt;
    __device__ __forceinline__ void operator()(const f32x4 (&acc)[2][2][4][2], const Unit& u, int wr, int wc, int fr, int fq) const {
        const int rl0 = wr * 64 + fr, col0 = u.pn * BM + wc * 32 + 8 * fq; const size_t lbase = (size_t)u.e * mk::N + u.rt * 256;
        unsigned tk[8];
#pragma unroll
        for (int i = 0; i < 8; ++i) { const int rl = rl0 + (i >> 2) * HALF + (i & 3) * 16; tk[i] = (rl < u.rows) ? lt[lbase + rl] : 0u; }
#pragma unroll
        for (int ai = 0; ai < 2; ++ai)
#pragma unroll
            for (int m = 0; m < 4; ++m) { const int rl = rl0 + ai * HALF + m * 16; if (rl >= u.rows) continue;
                const unsigned t_ = tk[ai * 4 + m]; bf16_t* rowp = Y + ((size_t)(t_ >> 31) * mk::N + (t_ & 0x7fffffffu)) * 1024 + col0;
#pragma unroll
                for (int bj = 0; bj < 2; ++bj) { const f32x4 v0 = acc[ai][bj][m][0], v1 = acc[ai][bj][m][1];
                    u32x4 w; w.x = cvtpk(v0[0], v0[1]); w.y = cvtpk(v0[2], v0[3]); w.z = cvtpk(v1[0], v1[1]); w.w = cvtpk(v1[2], v1[3]);
                    st16g(rowp, bj * HALF * 2, w); } }
    }
};
}
namespace att {
constexpr int SLOT_K = 12288, SLOT_V = 8192, SLOT_KB = 256, SLOT = SLOT_K + SLOT_V + SLOT_KB;
constexpr int LDS_WS = 2 * SLOT, LDS_OST = LDS_WS + 8 * 256, LDS_BYTES = LDS_OST + 8 * 4608;
struct UnitDesc {
    const bf16_t* q; long qstride;
    const bf16_t* k; const bf16_t* v; long kstride;
    const bf16_t* kx; long kxstride;
    bf16_t* o; long ostride;
    float* lse; long lsestride;
    const float* kbias;
    int q0, W; float alibi, sink;
    bool has_sink, has_lse;
};
__device__ __forceinline__ int crow(int r, int hi) { return (r & 3) + 8 * (r >> 2) + 4 * hi; }
#define ATT_MX3(a, b, c) __builtin_fmaxf(__builtin_fmaxf((a), (b)), (c))
__device__ __forceinline__ float rowmax(const f32x16& p0, const f32x16& p1) {
    float a = ATT_MX3(p0[0], p0[1], p1[0]), b = ATT_MX3(p0[2], p0[3], p1[1]); a = ATT_MX3(a, p1[2], p1[3]);
#pragma unroll
    for (int r = 4; r < 16; r += 4) { a = ATT_MX3(a, p0[r], p0[r + 1]); b = ATT_MX3(b, p0[r + 2], p0[r + 3]); a = ATT_MX3(a, p1[r], p1[r + 1]); b = ATT_MX3(b, p1[r + 2], p1[r + 3]); }
    float m = __builtin_fmaxf(a, b); auto rr = __builtin_amdgcn_permlane32_swap(__float_as_uint(m), __float_as_uint(m), false, false);
    return __builtin_fmaxf(__uint_as_float(rr[0]), __uint_as_float(rr[1])); }
typedef short v4i16_t __attribute__((ext_vector_type(4)));
__device__ __forceinline__ s16x4 vtr(const LAS unsigned char* p) { return __builtin_bit_cast(s16x4, __builtin_amdgcn_ds_read_tr16_b64_v4i16((LAS v4i16_t*)p)); }

__device__ __forceinline__ void att_store_ot(const f32x16 (&o)[2], float inv, LAS bf16_t* stg, bf16_t* O, long ostride, int lane) {
    const int r32 = lane & 31, hi = lane >> 5;
#pragma unroll
    for (int d0 = 0; d0 < 2; ++d0)
#pragma unroll
        for (int g = 0; g < 4; ++g) { u32x2 p; p.x = cvtpk(o[d0][4 * g] * inv, o[d0][4 * g + 1] * inv); p.y = cvtpk(o[d0][4 * g + 2] * inv, o[d0][4 * g + 3] * inv);
            *(LAS u32x2*)(stg + r32 * 72 + 32 * d0 + 8 * g + 4 * hi) = p; }
#pragma unroll
    for (int i = 0; i < 4; ++i) { const int row = i * 8 + (lane >> 3), ch = lane & 7; const u32x4 v = *(const LAS u32x4*)(stg + row * 72 + ch * 8); st16a(O + (long)row * ostride + ch * 8, 0, v); }
}

template <int NDQ, bool FOX, bool BAND>
__device__ __forceinline__ void attn_unit(const UnitDesc& u, LAS unsigned char* lds, const int tid) {
    const int lane = tid & 63, r32 = lane & 31, hi = lane >> 5; const int w = __builtin_amdgcn_readfirstlane(tid >> 6);
    const int q0 = u.q0, Qw = q0 + 32 * w;
    const int t_lo = BAND ? ((q0 - u.W) > 0 ? ((q0 - u.W) >> 6) : 0) : 0, t_hi = (q0 + 255) >> 6;
    LAS float* wsf = (LAS float*)(lds + LDS_WS) + w * 64;
    const bf16_t* ksrc = u.k + (long)lane * u.kstride + w * 8;
    const bf16_t* kxsrc = (NDQ > 4) ? u.kx + (long)lane * u.kxstride + (NDQ == 6 ? (w & 3) * 8 : 0) : nullptr;
    const bf16_t* vsrc = u.v + (long)(16 * (w & 3) + (lane >> 2)) * u.kstride + (w >> 2) * 32 + (lane & 3) * 8;
#define ATT_DMA(t, bsel) do { LAS unsigned char* kb_ = lds + (bsel) * SLOT; \
        __builtin_amdgcn_global_load_lds((const unsigned*)(ksrc + (long)(t) * 64 * u.kstride), (LAS unsigned*)(kb_ + w * 1024), 16, 0, 0); \
        if (NDQ > 4) { if (w < 2 * (NDQ - 4)) __builtin_amdgcn_global_load_lds((const unsigned*)(kxsrc + (long)(t) * 64 * u.kxstride), (LAS unsigned*)(kb_ + (8 + w) * 1024), 16, 0, 0); } \
        __builtin_amdgcn_global_load_lds((const unsigned*)(vsrc + (long)(t) * 64 * u.kstride), (LAS unsigned*)(kb_ + SLOT_K + w * 1024), 16, 0, 0); } while (0)
    ATT_DMA(t_lo, 0);
    bf16x8 qr[NDQ];
    { const bf16_t* Qw_ = u.q + (long)(32 * w + r32) * u.qstride + hi * 8;
#pragma unroll
      for (int d0 = 0; d0 < (FOX ? 4 : NDQ); ++d0) qr[d0] = *(const bf16x8*)(Qw_ + d0 * 16);
      if (FOX) { const short one = hi ? (short)0 : (short)0x3F80; qr[4] = (bf16x8){one, one, one, 0, 0, 0, 0, 0}; } }
    const float ci = 0.f;
    f32x16 negm;
#pragma unroll
    for (int r = 0; r < 16; ++r) negm[r] = ci;
    float m_run = -1e30f, l_run = 0.f; f32x16 o[2]; o[0] = f32x16{}; o[1] = f32x16{};
    const int koff = hi * 1024 + r32 * 16;
    const int voff = SLOT_K + ((lane >> 4) & 1) * 32 + (lane & 3) * 8 + (4 * hi + ((lane & 15) >> 2)) * 64;
    for (int t = t_lo; t <= t_hi; ++t) {
        const int bsel = (t - t_lo) & 1;
        asm volatile("s_waitcnt vmcnt(0)" ::: "memory");
        __syncthreads();
        if (t < t_hi) ATT_DMA(t + 1, bsel ^ 1);
        const int k0 = 64 * t;
        bool active = (k0 <= Qw + 31); if (BAND) active = active && (Qw - (k0 + 63) <= u.W);
        if (!active) continue;
        const LAS unsigned char* kb = lds + bsel * SLOT;
        f32x16 p0, p1;
        if (BAND) {
#pragma unroll
            for (int r = 0; r < 16; ++r) { p0[r] = 0.f; p1[r] = 0.f; }
        } else { p0 = negm; p1 = negm; }
        __builtin_amdgcn_s_setprio(1);
#pragma unroll
        for (int d0 = 0; d0 < NDQ; ++d0) { const bf16x8 a0 = *(const LAS bf16x8*)(kb + koff + d0 * 2048), a1 = *(const LAS bf16x8*)(kb + koff + d0 * 2048 + 512);
            p0 = __builtin_amdgcn_mfma_f32_32x32x16_bf16(a0, qr[d0], p0, 0, 0, 0); p1 = __builtin_amdgcn_mfma_f32_32x32x16_bf16(a1, qr[d0], p1, 0, 0, 0); }
        __builtin_amdgcn_s_setprio(0);
        const int dbase = Qw + r32 - k0 - 4 * hi;
        float alpha = 1.f; float sacc = 0.f;
        if (BAND) {
#pragma unroll
            for (int r = 0; r < 16; ++r) { const int d0_ = dbase - ((r & 3) + 8 * (r >> 2)), d1_ = d0_ - 32;
                p0[r] = ((unsigned)d0_ <= (unsigned)u.W) ? p0[r] - u.alibi * (float)d0_ : -INFINITY;
                p1[r] = ((unsigned)d1_ <= (unsigned)u.W) ? p1[r] - u.alibi * (float)d1_ : -INFINITY; }
            const float rm = rowmax(p0, p1), m_new = __builtin_fmaxf(m_run, rm);
            alpha = __builtin_amdgcn_exp2f(m_run - m_new);
#pragma unroll
            for (int r = 0; r < 16; ++r) { o[0][r] *= alpha; o[1][r] *= alpha; }
            m_run = m_new;
#pragma unroll
            for (int r = 0; r < 16; ++r) { p0[r] = __builtin_amdgcn_exp2f(p0[r] - m_new); p1[r] = __builtin_amdgcn_exp2f(p1[r] - m_new); sacc += p0[r] + p1[r]; }
        } else {
            if (k0 + 63 > Qw) {
#pragma unroll
                for (int r = 0; r < 16; ++r) { const int d0_ = dbase - ((r & 3) + 8 * (r >> 2));
                    if (d0_ < 0) p0[r] = -INFINITY; if (d0_ < 32) p1[r] = -INFINITY; }
            }
            const float rm = rowmax(p0, p1);
            if (t == 0 || __any(rm > 8.0f)) {
                const float dl = (t == 0) ? rm : __builtin_fmaxf(rm, 0.f);
                alpha = __builtin_amdgcn_exp2f(-dl);
#pragma unroll
                for (int r = 0; r < 16; ++r) { p0[r] -= dl; p1[r] -= dl; negm[r] -= dl; }
                if (t != 0) {
#pragma unroll
                    for (int r = 0; r < 16; ++r) { o[0][r] *= alpha; o[1][r] *= alpha; }
                }
            }
#pragma unroll
            for (int r = 0; r < 16; ++r) { p0[r] = __builtin_amdgcn_exp2f(p0[r]); p1[r] = __builtin_amdgcn_exp2f(p1[r]); sacc += p0[r] + p1[r]; }
        }
        l_run = l_run * alpha + sacc;
        u32x4 pw[4];
#pragma unroll
        for (int j = 0; j < 4; ++j) { pw[0][j] = cvtpk(p0[2 * j], p0[2 * j + 1]); pw[1][j] = cvtpk(p0[8 + 2 * j], p0[9 + 2 * j]); pw[2][j] = cvtpk(p1[2 * j], p1[2 * j + 1]); pw[3][j] = cvtpk(p1[8 + 2 * j], p1[9 + 2 * j]); }
        const LAS unsigned char* vp = kb + voff;
        __builtin_amdgcn_s_setprio(1);
#pragma unroll
        for (int d0 = 0; d0 < 2; ++d0)
#pragma unroll
            for (int ks = 0; ks < 4; ++ks) { const s16x4 lo = vtr(vp + d0 * 4096 + ks * 1024), hh = vtr(vp + d0 * 4096 + ks * 1024 + 512);
                const bf16x8 vf = (bf16x8){lo[0], lo[1], lo[2], lo[3], hh[0], hh[1], hh[2], hh[3]};
                o[d0] = __builtin_amdgcn_mfma_f32_32x32x16_bf16(vf, __builtin_bit_cast(bf16x8, pw[ks]), o[d0], 0, 0, 0); }
        __builtin_amdgcn_s_setprio(0);
    }
#undef ATT_DMA
    { auto rr = __builtin_amdgcn_permlane32_swap(__float_as_uint(l_run), __float_as_uint(l_run), false, false); l_run = __uint_as_float(rr[0]) + __uint_as_float(rr[1]); }
    if (BAND) { if (u.has_sink) l_run += __builtin_amdgcn_exp2f(u.sink - m_run);
                if (u.has_lse) { if (hi == 0) u.lse[(long)(32 * w + r32) * u.lsestride] = m_run + __builtin_amdgcn_logf(l_run); } }
    att_store_ot(o, __builtin_amdgcn_rcpf(l_run), (LAS bf16_t*)(lds + LDS_OST) + w * 2304, u.o + (long)(32 * w) * u.ostride, u.ostride, lane);
    __syncthreads();
}

constexpr int P_LDS_WS = 3 * SLOT, P_LDS_OST = P_LDS_WS + 8 * 256, P_LDS_BYTES = P_LDS_OST + 8 * 4608;
template <int NDQ, bool FOX>
__device__ __forceinline__ void attn_unit_causal(const UnitDesc& u, LAS unsigned char* lds, const int tid) {
    const int lane = tid & 63, r32 = lane & 31, hi = lane >> 5; const int w = __builtin_amdgcn_readfirstlane(tid >> 6);
    const int q0 = u.q0, Qw = q0 + 32 * w, t_hi = (q0 + 255) >> 6, tl = (Qw + 31) >> 6;
    LAS float* wsf = (LAS float*)(lds + P_LDS_WS) + w * 64;
    const unsigned kvo = (unsigned)(lane * (int)u.kstride + w * 8) * 2u, kxo = (unsigned)(lane * (int)u.kxstride + (NDQ == 6 ? (w & 3) * 8 : 0)) * 2u;
    const unsigned vvo = (unsigned)((16 * (w & 3) + (lane >> 2)) * (int)u.kstride + (w >> 2) * 32 + (lane & 3) * 8) * 2u;
    const unsigned ldsb = (unsigned)(uintptr_t)lds + (unsigned)w * 1024u;
#define ATT_DMA(t, slot) do { const unsigned kb_ = ldsb + (unsigned)((slot) * SLOT); \
        pg8::glds_s((const char*)(u.k + (long)(t) * 64 * u.kstride), kvo, kb_); \
        if (w < 2 * (NDQ - 4)) pg8::glds_s((const char*)(u.kx + (long)(t) * 64 * u.kxstride), kxo, kb_ + 8192u); \
        pg8::glds_s((const char*)(u.v + (long)(t) * 64 * u.kstride), vvo, kb_ + (unsigned)SLOT_K); } while (0)
    ATT_DMA(0, 0);
    bf16x8 qr[NDQ];
    { const bf16_t* Qw_ = u.q + (long)(32 * w + r32) * u.qstride + hi * 8;
#pragma unroll
      for (int d0 = 0; d0 < (FOX ? 4 : NDQ); ++d0) qr[d0] = *(const bf16x8*)(Qw_ + d0 * 16);
      if (FOX) { const short one = hi ? (short)0 : (short)0x3F80; qr[NDQ - 1] = (bf16x8){one, one, one, 0, 0, 0, 0, 0}; } }
    float m_ref = -1e30f; f32x16 o[2]; float l_run = 0.f; o[0] = f32x16{}; o[1] = f32x16{};
    constexpr float THR = 30.f;
    const int koff = hi * 1024 + r32 * 16;
    const int voff = SLOT_K + ((lane >> 4) & 1) * 32 + (lane & 3) * 8 + (4 * hi + ((lane & 15) >> 2)) * 64;
    const int dq = r32 - 4 * hi;
#define ATT_KF(kbp, d0, n) (*(const LAS bf16x8*)((kbp) + koff + (d0) * 2048 + (n) * 512))
#define ATT_MASK(P0, P1, t) do { const int db_ = Qw + dq - 64 * (t); _Pragma("unroll") for (int r = 0; r < 16; ++r) { const int d_ = db_ - ((r & 3) + 8 * (r >> 2)); if (d_ < 0) P0[r] = -INFINITY; if (d_ < 32) P1[r] = -INFINITY; } } while (0)
#define ATT_SB() __builtin_amdgcn_sched_barrier(0)
#define ATT_PIN8(X0, X1, b) asm volatile("" : "+v"(X0[b]), "+v"(X0[b + 1]), "+v"(X0[b + 2]), "+v"(X0[b + 3]), "+v"(X1[b]), "+v"(X1[b + 1]), "+v"(X1[b + 2]), "+v"(X1[b + 3]))
    asm volatile("s_waitcnt vmcnt(0)" ::: "memory"); __syncthreads();
    if (t_hi >= 1) ATT_DMA(1, 1);
    f32x16 sa0 = f32x16{}, sa1 = f32x16{}, sb0, sb1;
    { const LAS unsigned char* kb = lds;
#pragma unroll
      for (int d0 = 0; d0 < NDQ; ++d0) { sa0 = __builtin_amdgcn_mfma_f32_32x32x16_bf16(ATT_KF(kb, d0, 0), qr[d0], sa0, 0, 0, 0); sa1 = __builtin_amdgcn_mfma_f32_32x32x16_bf16(ATT_KF(kb, d0, 1), qr[d0], sa1, 0, 0, 0); }
      if (tl == 0) ATT_MASK(sa0, sa1, 0); }
    int slot = 0, t = 0;
#define ATT_STEP(C0, C1, N0, N1) do { \
        const int slot1 = slot == 2 ? 0 : slot + 1, slot2 = slot1 == 2 ? 0 : slot1 + 1; \
        asm volatile("s_waitcnt vmcnt(0)" ::: "memory");                 \
        __syncthreads();                                                 \
        if (t + 2 <= t_hi) ATT_DMA(t + 2, slot2); \
        const LAS unsigned char* kbn = lds + slot1 * SLOT; const LAS unsigned char* vp = lds + slot * SLOT + voff; \
        { const float rm = rowmax(C0, C1); \
          if (__any(rm - m_ref > THR)) { const float m_new = __builtin_fmaxf(m_ref, rm), alpha = __builtin_amdgcn_exp2f(m_ref - m_new); m_ref = m_new; \
            _Pragma("unroll") for (int r = 0; r < 16; ++r) { o[0][r] *= alpha; o[1][r] *= alpha; } l_run *= alpha; } } \
        float sacc = 0.f; u32x4 pw[4]; \
        N0 = f32x16{}; N1 = f32x16{}; \
        { bf16x8 ka = ATT_KF(kbn, 0, 0), kb2 = ATT_KF(kbn, 0, 1); \
          _Pragma("unroll") for (int d0 = 0; d0 < NDQ; ++d0) { \
            bf16x8 na = ka, nb = kb2; if (d0 + 1 < NDQ) { na = ATT_KF(kbn, d0 + 1, 0); nb = ATT_KF(kbn, d0 + 1, 1); } \
            if (d0 < 4) { ATT_PIN8(C0, C1, 4 * d0); } \
            N0 = __builtin_amdgcn_mfma_f32_32x32x16_bf16(ka, qr[d0], N0, 0, 0, 0); N1 = __builtin_amdgcn_mfma_f32_32x32x16_bf16(kb2, qr[d0], N1, 0, 0, 0); \
            if (d0 < 4) { \
                _Pragma("unroll") for (int r = 4 * d0; r < 4 * d0 + 4; ++r) { C0[r] = __builtin_amdgcn_exp2f(C0[r] - m_ref); C1[r] = __builtin_amdgcn_exp2f(C1[r] - m_ref); sacc += C0[r] + C1[r]; } \
                ATT_PIN8(C0, C1, 4 * d0); asm volatile("" : "+v"(sacc)); } \
            ka = na; kb2 = nb; ATT_SB(); } } \
        l_run += sacc; \
        _Pragma("unroll") for (int j = 0; j < 4; ++j) { pw[0][j] = cvtpk(C0[2 * j], C0[2 * j + 1]); pw[1][j] = cvtpk(C0[8 + 2 * j], C0[9 + 2 * j]); pw[2][j] = cvtpk(C1[2 * j], C1[2 * j + 1]); pw[3][j] = cvtpk(C1[8 + 2 * j], C1[9 + 2 * j]); } \
        __builtin_amdgcn_s_setprio(1); \
        _Pragma("unroll") for (int ks = 0; ks < 4; ++ks) _Pragma("unroll") for (int d0 = 0; d0 < 2; ++d0) { const s16x4 lo = vtr(vp + d0 * 4096 + ks * 1024), hh = vtr(vp + d0 * 4096 + ks * 1024 + 512); \
                const bf16x8 vf = (bf16x8){lo[0], lo[1], lo[2], lo[3], hh[0], hh[1], hh[2], hh[3]}; \
                o[d0] = __builtin_amdgcn_mfma_f32_32x32x16_bf16(vf, __builtin_bit_cast(bf16x8, pw[ks]), o[d0], 0, 0, 0); \
                if (d0 == 1 && (ks & 1)) ATT_SB(); } \
        __builtin_amdgcn_s_setprio(0); \
        if (t + 1 == tl) ATT_MASK(N0, N1, t + 1); \
        slot = slot1; ++t; } while (0)
    for (; t + 1 <= tl; ) { ATT_STEP(sa0, sa1, sb0, sb1); ATT_STEP(sb0, sb1, sa0, sa1); }
    if (t <= tl) ATT_STEP(sa0, sa1, sb0, sb1);
    for (; t <= t_hi; ++t) { const int slot1 = slot == 2 ? 0 : slot + 1, slot2 = slot1 == 2 ? 0 : slot1 + 1;
        asm volatile("s_waitcnt vmcnt(0)" ::: "memory"); __syncthreads();
        if (t + 2 <= t_hi) ATT_DMA(t + 2, slot2);
        slot = slot1; }
#undef ATT_STEP
#undef ATT_DMA
#undef ATT_KF
#undef ATT_MASK
#undef ATT_SB
#undef ATT_PIN8
    { auto rr = __builtin_amdgcn_permlane32_swap(__float_as_uint(l_run), __float_as_uint(l_run), false, false); l_run = __uint_as_float(rr[0]) + __uint_as_float(rr[1]); }
    att_store_ot(o, __builtin_amdgcn_rcpf(l_run), (LAS bf16_t*)(lds + P_LDS_OST) + w * 2304, u.o + (long)(32 * w) * u.ostride, u.ostride, lane);
    __syncthreads();
}
}
namespace mk {
constexpr int NWAVES = 8, NTHREADS = 512;
constexpr int RING_BYTES = 131072, MISC_OFF = RING_BYTES, LDS_BYTES = 147456;
constexpr int MISC_PRE = MISC_OFF + 1024, MISC_CNT = MISC_PRE + 512, MISC_STASH = MISC_OFF + 2048;
constexpr int NPHASE = 17;
#define LDS_WAIT() asm volatile("s_waitcnt lgkmcnt(0)" ::: "memory")

struct Args { const float* in[21]; float* out; unsigned char* ws; float* H; int ph_lo, ph_hi; int use_bar, pad; };

typedef const __attribute__((address_space(4))) Args* cargs_t;
__device__ __forceinline__ Args load_args() {
#if defined(__HIP_DEVICE_COMPILE__)
    cargs_t p = (cargs_t)__builtin_amdgcn_kernarg_segment_ptr(); asm volatile("" : "+s"(p)); Args a;
#pragma unroll
    for (int i = 0; i < 21; ++i) a.in[i] = p->in[i];
    a.out = p->out; a.ws = p->ws; a.H = p->H; a.ph_lo = p->ph_lo; a.ph_hi = p->ph_hi; a.use_bar = p->use_bar; a.pad = 0; return a;
#else
    return Args{};
#endif
}

#define XB_TMO      128
#define XB_XCNT(j)  (256  + 64 * (j))
#define XB_XSUB(j)  (1280 + 64 * (j))
#define XB_XGEN(j)  (2304 + 64 * (j))
#define XB_TOP      3328
#define XB_TOPGEN   3392
#define XCD_BAR_WORDS 3456
#define XB_SPIN_CAP (1u << 18)
__device__ __forceinline__ unsigned xb_ld(unsigned* p)              { return __hip_atomic_load(p, __ATOMIC_RELAXED, __HIP_MEMORY_SCOPE_AGENT); }
__device__ __forceinline__ unsigned xb_add(unsigned* p, unsigned v) { return __hip_atomic_fetch_add(p, v, __ATOMIC_RELAXED, __HIP_MEMORY_SCOPE_AGENT); }
__device__ __forceinline__ unsigned xb_xcc_id() { return (unsigned)__builtin_amdgcn_s_getreg((3 << 11) | 20) & 0xFu; }
#define XB_SPIN(cond, bar) do { unsigned _sp = 0; while (cond) { __builtin_amdgcn_s_sleep(1); \
    if ((++_sp & 255u) == 0u) { if (xb_ld(&(bar)[XB_TMO])) break; if (_sp > XB_SPIN_CAP) { atomicAdd(&(bar)[XB_TMO], 1u); break; } } } } while (0)
struct XcdBarrier { unsigned* bar; unsigned x; volatile LAS unsigned* st; };
__device__ __forceinline__ XcdBarrier xcd_barrier_post(unsigned* bar, volatile LAS unsigned* st) {
    XcdBarrier b; b.bar = bar; b.x = xb_xcc_id(); b.st = st;
    if (threadIdx.x == 0) (void)xb_add(&bar[XB_XCNT(b.x)], 1u);
    return b;
}
__device__ __forceinline__ void xcd_barrier_complete(unsigned* bar, unsigned x, unsigned& nloc, unsigned& nx) {
    const unsigned G = gridDim.x * gridDim.y * gridDim.z;
    unsigned sum, cnt, mine, sp = 0u;
    for (;;) {
        sum = 0u; cnt = 0u; mine = 0u;
#pragma unroll
        for (unsigned j = 0; j < 16; ++j) { const unsigned c = xb_ld(&bar[XB_XCNT(j)]); sum += c; cnt += (c > 0u) ? 1u : 0u; mine = (j == x) ? c : mine; }
        if (sum == G) break;
        __builtin_amdgcn_s_sleep(1);
        if ((++sp & 255u) == 0u) { if (xb_ld(&bar[XB_TMO])) break; if (sp > XB_SPIN_CAP) { atomicAdd(&bar[XB_TMO], 1u); break; } }
    }
    nloc = mine > 0u ? mine : 1u; nx = cnt > 0u ? cnt : 1u;
}
__device__ __forceinline__ void xcd_barrier(const XcdBarrier& b) {
    asm volatile("s_waitcnt vmcnt(0)" ::: "memory");
    __syncthreads();
    if (threadIdx.x == 0) {
        unsigned* bar = b.bar;
        __builtin_amdgcn_s_waitcnt(0);
        unsigned nloc = b.st[0], nx = b.st[1];
        if (nloc == 0u) { xcd_barrier_complete(bar, b.x, nloc, nx); b.st[0] = nloc; b.st[1] = nx; }
        const unsigned old = xb_add(&bar[XB_XSUB(b.x)], 1u);
        const unsigned gen = old / nloc;
        if (old + 1u == (gen + 1u) * nloc) {
            __builtin_amdgcn_fence(__ATOMIC_RELEASE, "agent");
            asm volatile("s_waitcnt vmcnt(0)" ::: "memory");
            const unsigned og = xb_add(&bar[XB_TOP], 1u);
            const unsigned tg = og / nx;
            if (og + 1u == (tg + 1u) * nx) xb_add(&bar[XB_TOPGEN], 1u);
            else XB_SPIN(xb_ld(&bar[XB_TOPGEN]) == tg, bar);
            __builtin_amdgcn_fence(__ATOMIC_ACQUIRE, "agent");
            xb_add(&bar[XB_XGEN(b.x)], 1u);
            asm volatile("s_waitcnt vmcnt(0)" ::: "memory");
        } else {
            XB_SPIN(xb_ld(&bar[XB_XGEN(b.x)]) == gen, bar);
            __builtin_amdgcn_fence(__ATOMIC_ACQUIRE, "agent");
            asm volatile("s_waitcnt vmcnt(0)" ::: "memory");
        }
    }
    __syncthreads();
}
constexpr int MISC_BAR = MISC_OFF + 64;
__device__ __forceinline__ void grid_barrier(const Args& a, LAS unsigned char* lds) {
    XcdBarrier b; b.bar = (unsigned*)(a.ws + WS_CTL) + CW_BAR; b.x = xb_xcc_id(); b.st = (volatile LAS unsigned*)(lds + MISC_BAR);
    xcd_barrier(b);
}
__device__ __forceinline__ float wave_sum(float v) {
#pragma unroll
    for (int o = 1; o < 64; o <<= 1) v += __shfl_xor(v, o);
    return v;
}
__device__ __forceinline__ void tr_item(const float* src, int lds_, int ncols, const float* scale, bf16_t* dst, int ldd, LAS float* scr, int lane) {
    float v[32]; const int c0 = lane & 31, kh = lane >> 5;
#pragma unroll
    for (int i = 0; i < 32; ++i) v[i] = (src && c0 < ncols) ? src[(size_t)(2 * i + kh) * lds_ + c0] : 0.f;
    const int c = lane & 7; f32x4 s0 = (f32x4){1.f, 1.f, 1.f, 1.f}, s1 = s0;
    if (scale) { s0 = *(const f32x4*)(scale + 8 * c); s1 = *(const f32x4*)(scale + 8 * c + 4); }
#pragma unroll
    for (int i = 0; i < 32; ++i) scr[(2 * i + kh) * 33 + c0] = v[i];
    LDS_WAIT(); asm volatile("" ::: "memory");
#pragma unroll
    for (int j = 0; j < 4; ++j) { const int n = (lane >> 3) + 8 * j; const LAS float* s = scr + (8 * c) * 33 + n;
        u32x4 o; o.x = cvtpk(s[0 * 33] * s0[0], s[1 * 33] * s0[1]); o.y = cvtpk(s[2 * 33] * s0[2], s[3 * 33] * s0[3]); o.z = cvtpk(s[4 * 33] * s1[0], s[5 * 33] * s1[1]); o.w = cvtpk(s[6 * 33] * s1[2], s[7 * 33] * s1[3]);
        st16s(dst + (size_t)n * ldd + 8 * c, 0, o); }
    LDS_WAIT(); asm volatile("" ::: "memory");
}
struct TrMat { const float* W; int K, ldw; const float* scale; bf16_t* WT; int nblk; int kind; };
__device__ __forceinline__ int tr_srccol(int kind, int n0) {
    switch (kind) {
    case 0: return n0;
    case 1: return n0 < 1536 ? n0 : n0 + 8;
    case 2: return n0 < 384 ? n0 : (n0 < 416 ? n0 + 256 : (n0 < 512 ? -1 : (n0 < 768 ? n0 - 128 : n0 - 96)));
    default: return n0; }
}
__device__ __forceinline__ void tr_mat_item(const TrMat& m, int item, LAS float* scr, int lane) {
    const int kb = item / m.nblk, nb = item % m.nblk, k0 = 64 * kb, n0 = 32 * nb; const int sc = tr_srccol(m.kind, n0);
    tr_item(sc < 0 ? nullptr : m.W + (size_t)k0 * m.ldw + sc, m.ldw, 32, m.scale ? m.scale + k0 : nullptr, m.WT + (size_t)n0 * m.K + k0, m.K, scr, lane);
}

__device__ __forceinline__ void dense_mats(const Args& a, TrMat (&M)[6]) {
    unsigned char* ws = a.ws; const float* attn_norm = a.in[1];
    M[0] = TrMat{a.in[4], 1024, 3080, attn_norm, (bf16_t*)(ws + WS_WIN0), 96, 1};
    M[1] = TrMat{a.in[6], 1024, 1024, nullptr, (bf16_t*)(ws + WS_WOUT0), 32, 0};
    M[2] = TrMat{a.in[7], 1024, 1440, attn_norm + 1024, (bf16_t*)(ws + WS_WIN1), 48, 2};
    M[3] = TrMat{a.in[10], 384, 768, a.in[8], (bf16_t*)(ws + WS_WUQ), 24, 0};
    M[4] = TrMat{a.in[11], 256, 1024, a.in[9], (bf16_t*)(ws + WS_WUKV), 32, 0};
    M[5] = TrMat{a.in[13], 1024, 1024, nullptr, (bf16_t*)(ws + WS_WOUT1), 32, 0};
}
__device__ __forceinline__ void router_item(const Args& a, int it, LAS float* scr, int lane) {
    const float* ffn_norm = a.in[2]; const int l = it >> 5, r = it & 31, kb = r >> 1, nb = r & 1, k0 = 64 * kb;
    bf16_t* dst = (bf16_t*)(a.ws + WS_WR) + (size_t)l * 64 * 1024 + (size_t)(32 * nb) * 1024 + k0;
    if (nb == 0) tr_item(a.in[16] + (size_t)l * 1024 * 32 + (size_t)k0 * 32, 32, 32, ffn_norm + l * 1024 + k0, dst, 1024, scr, lane);
    else tr_item(a.in[14] + (size_t)l * 1024 * 4 + (size_t)k0 * 4, 4, 4, ffn_norm + l * 1024 + k0, dst, 1024, scr, lane);
}
template <int PART>
__device__ __forceinline__ void p0_prologue(const Args& a, LAS unsigned char* lds, int gw, int NGW, int wave, int lane) {
    unsigned char* ws = a.ws; LAS float* scr = (LAS float*)(lds + wave * 16384);
    const float* attn_norm = a.in[1];
    TrMat M[6]; dense_mats(a, M);
    const int cnt[6] = {16 * 96, 16 * 32, 16 * 48, 6 * 24, 4 * 32, 16 * 32};
    int base = 0;
#pragma unroll
    for (int mi = 0; mi < 6; ++mi) { if ((mi == 0) == (PART == 0)) { for (int it = (gw + NGW - base % NGW) % NGW; it < cnt[mi]; it += NGW) tr_mat_item(M[mi], it, scr, lane); base += cnt[mi]; } }
    if (PART == 1) for (int it = gw; it < 64; it += NGW) router_item(a, it, scr, lane);
    if (PART == 1) { f32x2* rope = (f32x2*)(ws + WS_ROPE);
      for (int i = gw * 64 + lane; i < S * 16; i += NGW * 64) { const int pos = i >> 4, j = i & 15; const float inv = powf(10000.0f, -(float)(2 * j) / 32.0f), ang = (float)pos * inv; float sn, cs; sincosf(ang, &sn, &cs); rope[i] = (f32x2){cs, sn}; } }
    if (PART == 0) { const float* x = a.in[0]; const float* win = a.in[4]; const float* bfp = a.in[5];
      bf16_t* XB = (bf16_t*)(ws + WS_XB); float* SS = (float*)(ws + WS_SS); float* LOGF = (float*)(ws + WS_LOGF);
      float wz[4][4][8];
#pragma unroll
      for (int j = 0; j < 4; ++j)
#pragma unroll
          for (int e = 0; e < 4; ++e) { const int k = 256 * j + 4 * lane + e; const float g = attn_norm[k]; const f32x4 w0 = *(const f32x4*)(win + (size_t)k * 3080 + 1536), w1 = *(const f32x4*)(win + (size_t)k * 3080 + 1540);
#pragma unroll
              for (int h = 0; h < 4; ++h) { wz[j][e][h] = w0[h] * g; wz[j][e][4 + h] = w1[h] * g; } }
      for (int row = gw; row < N; row += NGW) {
          const f32x4* xr = (const f32x4*)(x + (size_t)row * D) + lane; f32x4 v[4]; float ssq = 0.f; float zf[8];
#pragma unroll
          for (int h = 0; h < 8; ++h) zf[h] = 0.f;
#pragma unroll
          for (int j = 0; j < 4; ++j) { v[j] = xr[64 * j]; ssq += (v[j][0] * v[j][0] + v[j][1] * v[j][1]) + (v[j][2] * v[j][2] + v[j][3] * v[j][3]);
#pragma unroll
              for (int e = 0; e < 4; ++e)
#pragma unroll
                  for (int h = 0; h < 8; ++h) zf[h] += v[j][e] * wz[j][e][h]; }
          ssq = wave_sum(ssq);
#pragma unroll
          for (int h = 0; h < 8; ++h) zf[h] = wave_sum(zf[h]);
          u32x2* o8 = (u32x2*)(XB + (size_t)row * D) + lane;
#pragma unroll
          for (int j = 0; j < 4; ++j) { u32x2 wv; wv.x = cvtpk(v[j][0], v[j][1]); wv.y = cvtpk(v[j][2], v[j][3]); st8s(o8, 512 * j, wv); }
          if (lane == 0) SS[row] = ssq;
          const float rstd = 1.f / sqrtf(ssq * (1.f / D) + EPS);
          float zsel = zf[0];
#pragma unroll
          for (int h = 1; h < 8; ++h) zsel = (lane == h) ? zf[h] : zsel;
          if (lane < 8) { const float xg = zsel * rstd + bfp[lane]; LOGF[(size_t)row * 8 + lane] = fminf(xg, 0.f) - log1pf(expf(-fabsf(xg))); }
      } }
}
__device__ __forceinline__ void fox_cumsum(const Args& a, LAS unsigned char* lds, int G, const int tid) {
    const float* LOGF = (const float*)(a.ws + WS_LOGF); float* KB = (float*)(a.ws + WS_CB2); u32x4* KX = (u32x4*)(a.ws + WS_KEXT); LAS float* part = (LAS float*)lds;
    const int t = tid, lane = t & 63, wv = t >> 6;
    for (int bh = blockIdx.x; bh < 32; bh += G) { const int b = bh >> 3, h = bh & 7; float loc[8]; float run = 0.f;
#pragma unroll
        for (int i = 0; i < 8; ++i) { run += LOGF[(size_t)(b * S + t * 8 + i) * 8 + h]; loc[i] = run; }
        float inc = run;
#pragma unroll
        for (int o = 1; o < 64; o <<= 1) { const float up = __shfl_up(inc, o); if (lane >= o) inc += up; }
        __syncthreads();
        if (lane == 63) part[wv] = inc;
        __syncthreads();
        float off = inc - run;
        for (int i = 0; i < wv; ++i) off += part[i];
#pragma unroll
        for (int i = 0; i < 8; ++i) { const float kb = -LOG2E * (loc[i] + off); KB[(size_t)bh * S + t * 8 + i] = kb;
            const unsigned h1 = cvtpk(kb, 0.f) & 0xffffu; const float r1 = kb - bflo(h1); const unsigned h2 = cvtpk(r1, 0.f) & 0xffffu; const float r2 = r1 - bflo(h2); const unsigned h3 = cvtpk(r2, 0.f) & 0xffffu;
            KX[(size_t)bh * S + t * 8 + i] = (u32x4){h1 | (h2 << 16), h3, 0u, 0u}; }
    }
    __syncthreads();
}
__device__ __forceinline__ void attn_phase0(const Args& a, LAS unsigned char* lds, int vcu, int G, const int tid) {
    const bf16_t* QKV = (const bf16_t*)(a.ws + R1_QKV0); bf16_t* AO = (bf16_t*)(a.ws + R2_AO); bf16_t* DP = (bf16_t*)(a.ws + R2_DPART);
    float* DLSE = (float*)(a.ws + WS_DLSE); const float* KB = (const float*)(a.ws + WS_CB2);
    for (int it = vcu; it < 256 + 1536; it += G) {
        if (it < 256) { const int bh = it >> 3, s = it & 7, b = bh >> 3, h = bh & 7;
            for (int half = 0; half < 2; ++half) { const int qb = half ? 15 - s : s; att::UnitDesc u{};
                const bf16_t* base = QKV + (size_t)b * S * 3072 + h * 64;
                u.q = base + (size_t)(qb * 256) * 3072; u.qstride = 3072; u.k = base + 512; u.v = base + 1024; u.kstride = 3072;
                u.o = AO + (size_t)(b * S + qb * 256) * 1024 + h * 64; u.ostride = 1024; u.kbias = KB + (size_t)bh * S; u.kx = (const bf16_t*)(a.ws + WS_KEXT) + (size_t)bh * S * 8; u.kxstride = 8; u.q0 = qb * 256; u.W = 1 << 30;
                { int tid_ = tid; asm volatile("" : "+v"(tid_)); att::attn_unit_causal<5, true>(u, lds, tid_); } }
        } else { const int j = it - 256, bh = j / 48, rem = j % 48, br = rem >> 4, idx = rem & 15, b = bh >> 3, h = bh & 7;
            const int dil = br == 0 ? 1 : (br == 1 ? 4 : 16), c = br == 0 ? 0 : (br == 1 ? idx >> 2 : idx), qblk = br == 0 ? idx : (br == 1 ? idx & 3 : 0);
            att::UnitDesc u{}; const bf16_t* base = QKV + (size_t)(b * S + c) * 3072 + 1536 + h * 64; const long st = (long)dil * 3072;
            u.q = base + (size_t)(qblk * 256) * st; u.qstride = st; u.k = base + 512; u.v = base + 1024; u.kstride = st;
            const size_t tok0 = (size_t)b * S + c + (size_t)qblk * 256 * dil;
            u.o = DP + (size_t)br * N * 512 + tok0 * 512 + h * 64; u.ostride = (long)dil * 512;
            u.lse = DLSE + (size_t)br * N * 8 + tok0 * 8 + h; u.lsestride = (long)dil * 8; u.has_lse = true;
            u.q0 = qblk * 256; u.W = 128; u.alibi = exp2f(-(float)(h + 1)) * (float)dil * LOG2E;
            { int tid_ = tid; asm volatile("" : "+v"(tid_)); att::attn_unit<4, false, true>(u, lds, tid_); } }
    }
}
__device__ __forceinline__ void attn_phase1(const Args& a, LAS unsigned char* lds, int vcu, int G, const int tid) {
    const bf16_t* Z1 = (const bf16_t*)(a.ws + R1_Z1); const bf16_t* Q1 = (const bf16_t*)(a.ws + R1_Q1); const bf16_t* KV = (const bf16_t*)(a.ws + R1_KV1);
    bf16_t* AO = (bf16_t*)(a.ws + R2_AO); const float* sinks = a.in[12];
    for (int it = vcu; it < 256 + 512; it += G) {
        if (it < 256) { const int bh = it >> 3, s = it & 7, b = bh >> 3, h = bh & 7;
            for (int half = 0; half < 2; ++half) { const int qb = half ? 15 - s : s; att::UnitDesc u{};
                u.q = Q1 + (size_t)(b * S + qb * 256) * 768 + h * 96; u.qstride = 768;
                u.k = KV + (size_t)b * S * 1024 + h * 128; u.v = u.k + 64; u.kstride = 1024; u.kx = Z1 + (size_t)b * S * 1536 + 384; u.kxstride = 1536;
                u.o = AO + (size_t)(b * S + qb * 256) * 1024 + h * 64; u.ostride = 1024; u.q0 = qb * 256; u.W = 1 << 30;
                { int tid_ = tid; asm volatile("" : "+v"(tid_)); att::attn_unit_causal<6, false>(u, lds, tid_); } }
        } else { const int j = it - 256, b = j >> 7, hq = (j >> 4) & 7, qb = j & 15, kvh = hq >> 2; att::UnitDesc u{};
            const bf16_t* base = Z1 + (size_t)b * S * 1536;
            u.q = base + (size_t)(qb * 256) * 1536 + 768 + hq * 64; u.qstride = 1536; u.k = base + 1280 + kvh * 64; u.v = base + 1408 + kvh * 64; u.kstride = 1536;
            u.o = AO + (size_t)(b * S + qb * 256) * 1024 + 512 + hq * 64; u.ostride = 1024; u.q0 = qb * 256; u.W = 127;
            u.alibi = exp2f(-(float)(hq + 1)) * LOG2E; u.has_sink = true; u.sink = sinks[hq] * LOG2E;
            { int tid_ = tid; asm volatile("" : "+v"(tid_)); att::attn_unit<4, false, true>(u, lds, tid_); } }
    }
}
__device__ __forceinline__ void merge_phase(const Args& a, int gw, int NGW, int lane) {
    const bf16_t* DP = (const bf16_t*)(a.ws + R2_DPART); const float* DLSE = (const float*)(a.ws + WS_DLSE); bf16_t* AO = (bf16_t*)(a.ws + R2_AO);
    for (int tok = gw; tok < N; tok += NGW) { const int h = lane >> 3;
        const float l0 = DLSE[(size_t)tok * 8 + h], l1 = DLSE[(size_t)N * 8 + (size_t)tok * 8 + h], l2 = DLSE[(size_t)2 * N * 8 + (size_t)tok * 8 + h];
        const float mx = fmaxf(l0, fmaxf(l1, l2)); float w0 = exp2f(l0 - mx), w1 = exp2f(l1 - mx), w2 = exp2f(l2 - mx); const float inv = 1.f / (w0 + w1 + w2); w0 *= inv; w1 *= inv; w2 *= inv;
        const u32x4 a0 = *(const u32x4*)(DP + (size_t)tok * 512 + lane * 8), a1 = *(const u32x4*)(DP + (size_t)N * 512 + (size_t)tok * 512 + lane * 8), a2 = *(const u32x4*)(DP + (size_t)2 * N * 512 + (size_t)tok * 512 + lane * 8);
        u32x4 o;
#pragma unroll
        for (int i = 0; i < 4; ++i) { const float lo = w0 * bflo(a0[i]) + w1 * bflo(a1[i]) + w2 * bflo(a2[i]), hi = w0 * bfhi(a0[i]) + w1 * bfhi(a1[i]) + w2 * bfhi(a2[i]); o[i] = cvtpk(lo, hi); }
        st16s(AO + (size_t)tok * 1024 + 512 + lane * 8, 0, o); }
}
__device__ __forceinline__ void route_phase(const Args& a, int layer, LAS unsigned char* lds, int vcu, int G, int wave, int lane) {
    const bf16_t* HB = (const bf16_t*)(a.ws + WS_XB); const bf16_t* WR = (const bf16_t*)(a.ws + WS_WR) + (size_t)layer * 64 * 1024;
    const float* SSP = (const float*)(a.ws + WS_SSP); const float* bg = a.in[15] + layer * 4; const float* br = a.in[17] + layer * 32;
    unsigned* cnt = (unsigned*)(a.ws + WS_CTL) + CW_CNT + layer * 1024;
    unsigned* LT = (unsigned*)(a.ws + WS_LT); float* LW = (float*)(a.ws + WS_LW); float* LR = (float*)(a.ws + WS_LR);
    const int r32 = lane & 31, hi = lane >> 5, kq = wave & 3, half = wave >> 2;
    for (int b0 = vcu * 2; b0 < N / 32; b0 += G * 2) {
        const int blk = b0 + half; const bool live = blk < N / 32; const int tok = (live ? blk : 0) * 32 + r32;
        f32x16 c0 = f32x16{}, c1 = f32x16{}; int E_ = 0, myrank_ = 0, mycnt_ = 0; float wsel_ = 0.f, rstd_ = 0.f;
        const bf16_t* xb = HB + (size_t)tok * 1024 + kq * 256 + hi * 8; const bf16_t* wa = WR + (size_t)r32 * 1024 + kq * 256 + hi * 8;
        if (live) {
#pragma unroll 8
            for (int k0 = 0; k0 < 256; k0 += 16) { const bf16x8 bx = *(const bf16x8*)(xb + k0), a0 = *(const bf16x8*)(wa + k0), a1 = *(const bf16x8*)(wa + 32 * 1024 + k0);
                c0 = __builtin_amdgcn_mfma_f32_32x32x16_bf16(a0, bx, c0, 0, 0, 0); c1 = __builtin_amdgcn_mfma_f32_32x32x16_bf16(a1, bx, c1, 0, 0, 0); } }
        LAS f32x4* red = (LAS f32x4*)(lds + wave * 16384 + 9216) + lane * 5;
        if (kq != 0) { red[0] = (f32x4){c0[0], c0[1], c0[2], c0[3]}; red[1] = (f32x4){c0[4], c0[5], c0[6], c0[7]}; red[2] = (f32x4){c0[8], c0[9], c0[10], c0[11]}; red[3] = (f32x4){c0[12], c0[13], c0[14], c0[15]}; red[4] = (f32x4){c1[0], c1[1], c1[2], c1[3]}; }
        __syncthreads();
        if (kq == 0 && live) {
#pragma unroll
            for (int q = 1; q < 4; ++q) { const LAS f32x4* rq = (const LAS f32x4*)(lds + (wave + q) * 16384 + 9216) + lane * 5;
#pragma unroll
                for (int g = 0; g < 4; ++g) { const f32x4 t = rq[g]; c0[4 * g] += t[0]; c0[4 * g + 1] += t[1]; c0[4 * g + 2] += t[2]; c0[4 * g + 3] += t[3]; }
                const f32x4 t = rq[4]; c1[0] += t[0]; c1[1] += t[1]; c1[2] += t[2]; c1[3] += t[3]; }
            const f32x4* sp = (const f32x4*)(SSP + (size_t)tok * 16); const f32x4 s0 = sp[0], s1 = sp[1], s2 = sp[2], s3 = sp[3];
            const float ssq = ((s0[0] + s0[1]) + (s0[2] + s0[3])) + ((s1[0] + s1[1]) + (s1[2] + s1[3])) + ((s2[0] + s2[1]) + (s2[2] + s2[3])) + ((s3[0] + s3[1]) + (s3[2] + s3[3]));
            const float rstd = 1.f / sqrtf(ssq * (1.f / 1024.f) + EPS);
            float gl[4];
#pragma unroll
            for (int j = 0; j < 4; ++j) { const float mine = c1[j]; const float other = __shfl_xor(mine, 32); gl[j] = (hi == 0 ? mine : other) * rstd + bg[j]; }
            int gi = 0; float gm = gl[0];
#pragma unroll
            for (int j = 1; j < 4; ++j) if (gl[j] > gm) { gm = gl[j]; gi = j; }
            float den = 0.f;
#pragma unroll
            for (int j = 0; j < 4; ++j) den += __expf(gl[j] - gm);
            const float gwt = 1.f / den;
            float mine4[4];
#pragma unroll
            for (int j = 0; j < 4; ++j) { float v = c0[j]; v = (gi == 1) ? c0[4 + j] : v; v = (gi == 2) ? c0[8 + j] : v; v = (gi == 3) ? c0[12 + j] : v; mine4[j] = v; }
            float el[8];
#pragma unroll
            for (int j = 0; j < 4; ++j) { const float other = __shfl_xor(mine4[j], 32); el[j] = (hi == 0 ? mine4[j] : other); el[4 + j] = (hi == 0 ? other : mine4[j]); }
#pragma unroll
            for (int j = 0; j < 8; ++j) el[j] = el[j] * rstd + br[gi * 8 + j];
            int i1 = 0; float v1 = el[0];
#pragma unroll
            for (int j = 1; j < 8; ++j) if (el[j] > v1) { v1 = el[j]; i1 = j; }
            int i2 = -1; float v2 = -INFINITY;
#pragma unroll
            for (int j = 0; j < 8; ++j) if (j != i1 && el[j] > v2) { v2 = el[j]; i2 = j; }
            const float e2 = __expf(v2 - v1); const float w1 = gwt / (1.f + e2), w2 = gwt * e2 / (1.f + e2);
            const int E = gi * 8 + (hi == 0 ? i1 : i2); const float wsel = hi == 0 ? w1 : w2;
            int myrank = 0, mycnt = 0; const unsigned long long ltmask = (1ull << lane) - 1ull;
#pragma unroll 4
            for (int j = 0; j < 32; ++j) { const unsigned long long mj = __ballot(E == j); if (E == j) myrank = __popcll(mj & ltmask); if (lane == j) mycnt = __popcll(mj); }
            E_ = E; wsel_ = wsel; rstd_ = rstd; myrank_ = myrank; mycnt_ = mycnt;
        }
        LAS unsigned* ag = (LAS unsigned*)(lds + MISC_OFF + 256);
        if (kq == 0 && half == 1 && lane < 32) ag[lane] = live ? (unsigned)mycnt_ : 0u;
        __syncthreads();
        unsigned basev = 0;
        if (kq == 0 && half == 0 && lane < 32) { const unsigned mine = live ? (unsigned)mycnt_ : 0u, tot = mine + ag[lane];
            if (tot > 0u) basev = atomicAdd(cnt + lane * 16, tot);
            ag[32 + lane] = basev + mine; }
        __syncthreads();
        if (kq == 0 && live) {
            if (half == 1 && lane < 32) basev = ag[32 + lane];
            const unsigned base = (unsigned)__shfl((int)basev, E_);
            const size_t pos = (size_t)E_ * N + base + myrank_;
            LT[pos] = (unsigned)tok | ((unsigned)hi << 31); LW[pos] = wsel_; LR[pos] = rstd_;
        }
        __syncthreads();
    }
}
constexpr int MOE_CONV_ITEMS = 32 * 256 + 32 * 128;
struct TrDesc { const float* src; int lds_; const float* scale; bf16_t* dst; int ldd; };
__device__ __forceinline__ TrDesc moe_desc(const Args& a, int layer, int it) {
    const float* wg = a.in[18] + (size_t)layer * 32 * 1024 * 256; const float* wu = a.in[19] + (size_t)layer * 32 * 1024 * 256; const float* wd = a.in[20] + (size_t)layer * 32 * 256 * 1024;
    const float* g = a.in[2] + layer * 1024; bf16_t* WGU = (bf16_t*)(a.ws + (layer ? R2_WGU1 : R1_WGU)); bf16_t* WD = (bf16_t*)(a.ws + (layer ? R2_WD1 : R1_WD));
    if (it < 32 * 256) { const int e = it >> 8, r = it & 255, kb = r >> 4, nb = r & 15, k0 = 64 * kb, n0 = 32 * nb;
        const int t = n0 >> 8, s = (n0 >> 7) & 1, j = n0 & 127; const float* src = (s ? wu : wg) + (size_t)e * 1024 * 256 + (size_t)k0 * 256 + 128 * t + j;
        return TrDesc{src, 256, g + k0, WGU + ((size_t)e * 512 + n0) * 1024 + k0, 1024};
    } else { const int i2 = it - 32 * 256, e = i2 >> 7, r = i2 & 127, kb = r >> 5, nb = r & 31, k0 = 64 * kb, n0 = 32 * nb;
        return TrDesc{wd + (size_t)e * 256 * 1024 + (size_t)k0 * 1024 + n0, 1024, nullptr, WD + ((size_t)e * 1024 + n0) * 256 + k0, 256}; }
}
__device__ __forceinline__ void tr_load(const TrDesc& d, float (&v)[32], int lane) {
    const int c0 = lane & 31, kh = lane >> 5;
#pragma unroll
    for (int i = 0; i < 32; ++i) v[i] = d.src[(size_t)(2 * i + kh) * d.lds_ + c0];
}
__device__ __forceinline__ void tr_store(const TrDesc& d, const float (&v)[32], LAS float* scr, int lane) {
    const int c0 = lane & 31, kh = lane >> 5, c = lane & 7; f32x4 s0 = (f32x4){1.f, 1.f, 1.f, 1.f}, s1 = s0;
    if (d.scale) { s0 = *(const f32x4*)(d.scale + 8 * c); s1 = *(const f32x4*)(d.scale + 8 * c + 4); }
#pragma unroll
    for (int i = 0; i < 32; ++i) scr[(2 * i + kh) * 33 + c0] = v[i];
    LDS_WAIT(); asm volatile("" ::: "memory");
#pragma unroll
    for (int j = 0; j < 4; ++j) { const int n = (lane >> 3) + 8 * j; const LAS float* s = scr + (8 * c) * 33 + n;
        u32x4 o; o.x = cvtpk(s[0 * 33] * s0[0], s[1 * 33] * s0[1]); o.y = cvtpk(s[2 * 33] * s0[2], s[3 * 33] * s0[3]); o.z = cvtpk(s[4 * 33] * s1[0], s[5 * 33] * s1[1]); o.w = cvtpk(s[6 * 33] * s1[2], s[7 * 33] * s1[3]);
        st16s(d.dst + (size_t)n * d.ldd + 8 * c, 0, o); }
    LDS_WAIT(); asm volatile("" ::: "memory");
}
__device__ __forceinline__ void moe_convert(const Args& a, int layer, LAS unsigned char* lds, int gw, int NGW, int wave, int lane) {
    LAS float* scr = (LAS float*)(lds + wave * 16384);
    int it = gw; if (it >= MOE_CONV_ITEMS) return;
    TrDesc da = moe_desc(a, layer, it), db = da; float va[32], vb[32]; tr_load(da, va, lane);
    for (;;) {
        const int it2 = it + NGW; const bool h2 = it2 < MOE_CONV_ITEMS;
        if (h2) { db = moe_desc(a, layer, it2); tr_load(db, vb, lane); }
        tr_store(da, va, scr, lane); if (!h2) break;
        const int it3 = it2 + NGW; const bool h3 = it3 < MOE_CONV_ITEMS;
        if (h3) { da = moe_desc(a, layer, it3); tr_load(da, va, lane); }
        tr_store(db, vb, scr, lane); if (!h3) break;
        it = it3; }
}
__device__ __forceinline__ void combine_phase(const Args& a, bool last, int gw, int NGW, int lane) {
    const bf16_t* Y = (const bf16_t*)(a.ws + (last ? Y1_BASE : R2_Y)); bf16_t* XB = (bf16_t*)(a.ws + WS_XB); float* SS = (float*)(a.ws + WS_SS); const float* g = a.in[3];
    for (int row = gw; row < N; row += NGW) {
        u32x2* xr = (u32x2*)(XB + (size_t)row * D) + lane; const u32x2* y0 = (const u32x2*)(Y + (size_t)row * D) + lane; const u32x2* y1 = (const u32x2*)(Y + (size_t)N * D + (size_t)row * D) + lane;
        f32x4 v[4]; float ssq = 0.f; u32x2 hx[4], p[4], q[4];
#pragma unroll
        for (int j = 0; j < 4; ++j) { hx[j] = xr[64 * j]; p[j] = y0[64 * j]; q[j] = y1[64 * j]; }
#pragma unroll
        for (int j = 0; j < 4; ++j) {
            v[j][0] = bflo(hx[j].x) + bflo(p[j].x) + bflo(q[j].x); v[j][1] = bfhi(hx[j].x) + bfhi(p[j].x) + bfhi(q[j].x); v[j][2] = bflo(hx[j].y) + bflo(p[j].y) + bflo(q[j].y); v[j][3] = bfhi(hx[j].y) + bfhi(p[j].y) + bfhi(q[j].y);
            ssq += (v[j][0] * v[j][0] + v[j][1] * v[j][1]) + (v[j][2] * v[j][2] + v[j][3] * v[j][3]); }
        ssq = wave_sum(ssq);
        if (!last) {
#pragma unroll
            for (int j = 0; j < 4; ++j) { u32x2 wv; wv.x = cvtpk(v[j][0], v[j][1]); wv.y = cvtpk(v[j][2], v[j][3]); st8s(xr, 512 * j, wv); }
            if (lane == 0) SS[row] = ssq;
        } else { const float rstd = 1.f / sqrtf(ssq * (1.f / D) + EPS); f32x4* orow = (f32x4*)(a.out + (size_t)row * D) + lane;
#pragma unroll
            for (int j = 0; j < 4; ++j) { const f32x4 gg = ((const f32x4*)g)[lane + 64 * j]; st16fs(orow, 1024 * j, v[j] * rstd * gg); } }
    }
}
__device__ __forceinline__ void moe_tables(const Args& a, int layer, LAS unsigned char* lds, const int tid) {
    LAS int* pre = (LAS int*)(lds + MISC_PRE); LAS int* cn = (LAS int*)(lds + MISC_CNT);
    const unsigned* cnt = (const unsigned*)(a.ws + WS_CTL) + CW_CNT + layer * 1024;
    __syncthreads();
    if (tid < 64) {
        const int e = tid & 31; const int c = (int)__hip_atomic_load(cnt + e * 16, __ATOMIC_RELAXED, __HIP_MEMORY_SCOPE_AGENT);
        const int tiles = (c + 255) >> 8, full = c >> 8, tail = c & 255; int pt = tiles, pf = full;
#pragma unroll
        for (int o = 1; o < 32; o <<= 1) { const int ut = __shfl_up(pt, o, 32), uf = __shfl_up(pf, o, 32); if (e >= o) { pt += ut; pf += uf; } }
        int rank = 0, ntail = 0;
#pragma unroll 8
        for (int j = 0; j < 32; ++j) { const int tj = __shfl(tail, j, 32); ntail += tj ? 1 : 0; rank += (tj > tail || (tj == tail && j < e)) ? 1 : 0; }
        if (tid < 32) { cn[e] = c; pre[e] = pt - tiles; pre[40 + e] = pf - full; if (tail) pre[80 + rank] = e;
            if (e == 31) { pre[32] = pt; pre[72] = pf; pre[112] = ntail; } }
    }
    __syncthreads();
}

__global__ void __launch_bounds__(NTHREADS, 2) mega(Args args) {
    extern __shared__ __attribute__((aligned(16))) unsigned char lds_raw[];
    LAS unsigned char* lds = (LAS unsigned char*)lds_raw;
    const int G = gridDim.x;
    const int lo = args.ph_lo, hi = args.ph_hi;
    if (args.use_bar) { if (threadIdx.x < 2) ((volatile LAS unsigned*)(lds + MISC_BAR))[threadIdx.x] = 0u; __syncthreads();
        (void)xcd_barrier_post((unsigned*)(args.ws + WS_CTL) + CW_BAR, (volatile LAS unsigned*)(lds + MISC_BAR)); }
#define IN(k) (lo <= (k) && (k) < hi)
#define SEAM(k) do { if (IN(k) && IN((k) + 1)) { const Args ba_ = load_args(); grid_barrier(ba_, lds); } } while (0)
#define LA() const Args args = load_args(); unsigned char* ws = args.ws; (void)ws; int tid = threadIdx.x; asm volatile("" : "+v"(tid)); int bx = blockIdx.x; asm volatile("" : "+s"(bx)); \
    const int lane = tid & 63, wave = __builtin_amdgcn_readfirstlane(tid >> 6), vcu = (G % 8 == 0) ? (bx % 8) * (G / 8) + bx / 8 : bx, gw = vcu * NWAVES + wave, NGW = G * NWAVES; (void)lane; (void)gw; (void)NGW
    if (IN(0)) { LA(); p0_prologue<0>(args, lds, gw, NGW, wave, lane); }
    SEAM(0);
    if (IN(1)) {
#pragma nounroll
        for (int pass = 0; pass < 2; ++pass) {
            { LA(); if (pass == (vcu & 1)) { __syncthreads(); p0_prologue<1>(args, lds, gw, NGW, wave, lane); __syncthreads(); } }
            if (pass == 0) { LA(); fox_cumsum(args, lds, G, tid);
                pg8::Dense P; P.init((const bf16_t*)(ws + WS_XB), 1024, (const bf16_t*)(ws + WS_WIN0), N, 3072, 1024, G, bx);
                pg8::EpiQkv0 E{(bf16_t*)(ws + R1_QKV0), (const float*)(ws + WS_SS)};
                pg8::gemm_phase<pg8::EpiQkv0, pg8::Dense, false>(lds, P, E, tid); }
        }
    }
    SEAM(1);
    if (IN(2)) { LA(); attn_phase0(args, lds, vcu, G, tid); }
    SEAM(2);
#ifndef CONV_IN_WOUT
#define CONV_IN_WOUT 3
#endif
    if (IN(3)) { LA(); merge_phase(args, gw, NGW, lane); if (!(CONV_IN_WOUT & 1)) moe_convert(args, 0, lds, gw, NGW, wave, lane); }
    SEAM(3);
    for (int layer = 0; layer < 2; ++layer) {
        const int pb = layer == 0 ? 4 : 12;
        if (layer == 1) {
            if (IN(9)) { LA();
                unsigned* rdy = (unsigned*)(ws + WS_CTL) + CW_RDY2;
                { pg8::DenseT<1> P; P.init((const bf16_t*)(ws + WS_XB), 1024, (const bf16_t*)(ws + WS_WIN1), N, 1536, 1024, G, bx); P.ready = rdy;
                  pg8::EpiWin1 E{(bf16_t*)(ws + R1_Z1), (const float*)(ws + WS_SS), (float*)(ws + WS_SSZ), (const f32x2*)(ws + WS_ROPE)};
                  pg8::gemm_phase<pg8::EpiWin1, pg8::DenseT<1>, false>(lds, P, E, tid); }
                { const int ce = bx >= 128 ? bx - 128 : (bx >= 64 ? 64 + bx : (1 << 20));
                  pg8::DenseT<2> P; P.init((const bf16_t*)(ws + R1_Z1), 1536, (const bf16_t*)(ws + WS_WUQ), N, 768, 384, 1 << 20, ce); P.ready = rdy; P.need = 16u; P.sel = 0;
                  pg8::EpiUq E{(bf16_t*)(ws + R1_Q1), (const float*)(ws + WS_SSZ), (const f32x2*)(ws + WS_ROPE)};
                  int tid2 = threadIdx.x; asm volatile("" : "+v"(tid2));
                  pg8::gemm_phase<pg8::EpiUq, pg8::DenseT<2>, false>(lds, P, E, tid2); }
                { const int ce = bx >= 128 ? bx - 128 : (1 << 20);
                  pg8::DenseT<2> P; P.init((const bf16_t*)(ws + R1_Z1) + 512, 1536, (const bf16_t*)(ws + WS_WUKV), N, 1024, 256, 128, ce); P.ready = rdy; P.need = 8u; P.sel = 1;
                  pg8::EpiUkv E{(bf16_t*)(ws + R1_KV1), (const float*)(ws + WS_SSZ)};
                  int tid3 = threadIdx.x; asm volatile("" : "+v"(tid3));
                  pg8::gemm_phase<pg8::EpiUkv, pg8::DenseT<2>, false>(lds, P, E, tid3); } }
            SEAM(10);
            if (IN(11)) { LA(); attn_phase1(args, lds, vcu, G, tid); if (!(CONV_IN_WOUT & 2)) moe_convert(args, 1, lds, gw, NGW, wave, lane); }
            SEAM(11);
        }
        if (IN(pb)) { LA();
            const bool cv = (CONV_IN_WOUT >> layer) & 1;
            if (cv && !(vcu & 1)) { moe_convert(args, layer, lds, gw, NGW, wave, lane); __syncthreads(); }
            { pg8::Dense P; P.init((const bf16_t*)(ws + R2_AO), 1024, (const bf16_t*)(ws + (layer == 0 ? WS_WOUT0 : WS_WOUT1)), N, 1024, 1024, G, bx);
              pg8::EpiOut E{(bf16_t*)(ws + WS_XB), (float*)(ws + WS_SSP)};
              pg8::gemm_phase<pg8::EpiOut, pg8::Dense, false>(lds, P, E, tid); }
            if (cv && (vcu & 1)) { __syncthreads(); int l2 = threadIdx.x & 63; asm volatile("" : "+v"(l2)); moe_convert(args, layer, lds, gw, NGW, wave, l2); } }
        SEAM(pb);
        if (IN(pb + 1)) { LA(); route_phase(args, layer, lds, vcu, G, wave, lane); }
        SEAM(pb + 1);
        if (IN(pb + 2)) { LA(); moe_tables(args, layer, lds, tid);
            unsigned* rdy = (unsigned*)(ws + WS_CTL) + CW_RDY + layer * 8192;
            { pg8::MoeProb<1> P{(const LAS int*)(lds + MISC_PRE), (const LAS int*)(lds + MISC_CNT), 2, G, vcu, 1024, 1024, (const bf16_t*)(ws + WS_XB), (const bf16_t*)(ws + (layer ? R2_WGU1 : R1_WGU)), (size_t)512 * 1024, (const unsigned*)(ws + WS_LT), true, rdy, 16u};
              pg8::EpiGateUp E{(bf16_t*)(ws + R1_ACT), (const float*)(ws + WS_LW), (const float*)(ws + WS_LR)};
              pg8::gemm_phase<pg8::EpiGateUp, pg8::MoeProb<1>, true>(lds, P, E, tid, (LAS unsigned*)(lds + MISC_STASH)); }
            { int tid2 = threadIdx.x; asm volatile("" : "+v"(tid2));
              pg8::MoeProb<2> P{(const LAS int*)(lds + MISC_PRE), (const LAS int*)(lds + MISC_CNT), 4, G, vcu, 256, 256, (const bf16_t*)(ws + R1_ACT), (const bf16_t*)(ws + (layer ? R2_WD1 : R1_WD)), (size_t)1024 * 256, (const unsigned*)(ws + WS_LT), false, rdy, 16u};
              pg8::EpiDown E{(bf16_t*)(ws + (layer ? Y1_BASE : R2_Y)), (const unsigned*)(ws + WS_LT)};
              pg8::gemm_phase<pg8::EpiDown, pg8::MoeProb<2>, false>(lds, P, E, tid2); } }
        SEAM(pb + 3);
        if (IN(pb + 4)) { LA(); combine_phase(args, layer == 1, gw, NGW, lane); }
        if (layer == 0) SEAM(8);
    }
#undef IN
#undef SEAM
#undef LA
}
}
extern "C" void kernel_launch(void* const* d_in, const int* in_sizes, int n_in, void* d_out, int out_size, void* d_ws, size_t ws_size, hipStream_t stream) {
    using namespace mk;
    static int grid = 0;
    if (grid == 0) {
        if (n_in != 21 || out_size != N * D || ws_size < 283 * MiB) { fprintf(stderr, "kernel_launch: unexpected problem (n_in %d out %d ws %zu)\n", n_in, out_size, ws_size); grid = -1; return; }
        int dev = 0, cus = 0, per_cu = 0;
        if (hipGetDevice(&dev) != hipSuccess || hipDeviceGetAttribute(&cus, hipDeviceAttributeMultiprocessorCount, dev) != hipSuccess) { grid = -1; return; }
        if (hipFuncSetAttribute((const void*)mega, hipFuncAttributeMaxDynamicSharedMemorySize, LDS_BYTES) != hipSuccess) { fprintf(stderr, "kernel_launch: hipFuncSetAttribute failed\n"); grid = -1; return; }
        if (hipOccupancyMaxActiveBlocksPerMultiprocessor(&per_cu, (const void*)mega, NTHREADS, LDS_BYTES) != hipSuccess || per_cu < 1) { fprintf(stderr, "kernel_launch: occupancy query says %d blocks per CU\n", per_cu); (void)hipGetLastError(); grid = -1; return; }
        grid = cus;
    }
    if (grid < 0) return;
    Args a{};
    for (int i = 0; i < 21; ++i) a.in[i] = (const float*)d_in[i];
    a.out = (float*)d_out; a.ws = (unsigned char*)d_ws; a.H = (float*)d_out; a.use_bar = 1; a.ph_lo = 0; a.ph_hi = NPHASE;
    (void)hipMemsetAsync((char*)d_ws + WS_CTL, 0, CTL_ZERO_BYTES, stream);
    hipLaunchKernelGGL(mega, dim3(grid), dim3(NTHREADS), LDS_BYTES, stream, a);
}
```

```cpp
#define CONV_IN_WOUT 3
#include <hip/hip_runtime.h>
#include <cstdio>
#include <cstdint>
#include <cmath>
#define LAS __attribute__((address_space(3)))
#define GAS __attribute__((address_space(1)))
typedef unsigned short bf16_t;
typedef short bf16x8 __attribute__((ext_vector_type(8)));
typedef short s16x4 __attribute__((ext_vector_type(4)));
typedef float f32x2 __attribute__((ext_vector_type(2)));
typedef float f32x4 __attribute__((ext_vector_type(4)));
typedef float f32x16 __attribute__((ext_vector_type(16)));
typedef unsigned u32x2 __attribute__((ext_vector_type(2)));
typedef unsigned u32x4 __attribute__((ext_vector_type(4)));
typedef __bf16 bf16x2_t __attribute__((ext_vector_type(2)));
__device__ __forceinline__ unsigned cvtpk(float lo, float hi) { f32x2 v = {lo, hi}; bf16x2_t b = __builtin_convertvector(v, bf16x2_t); return __builtin_bit_cast(unsigned, b); }
__device__ __forceinline__ float bf2f(unsigned short u) { return __uint_as_float((unsigned)u << 16); }
__device__ __forceinline__ float bflo(unsigned u) { return __uint_as_float(u << 16); }
__device__ __forceinline__ float bfhi(unsigned u) { return __uint_as_float(u & 0xffff0000u); }
#ifndef WT_G
#define WT_G 0
#endif
#ifndef WT_A
#define WT_A 0
#endif
#ifndef WT_S
#define WT_S 0
#endif
template <int WTF> __device__ __forceinline__ void st16x(void* p, int off, u32x4 v) {
    if constexpr (WTF) asm volatile("global_store_dwordx4 %0, %1, off offset:%2 sc1\n\ts_nop 1" :: "v"(p), "v"(v), "i"(off) : "memory");
    else *(u32x4*)((char*)p + off) = v;
}
template <int WTF> __device__ __forceinline__ void st8x(void* p, int off, u32x2 v) {
    if constexpr (WTF) asm volatile("global_store_dwordx2 %0, %1, off offset:%2 sc1" :: "v"(p), "v"(v), "i"(off) : "memory");
    else *(u32x2*)((char*)p + off) = v;
}
template <int WTF> __device__ __forceinline__ void st4x(void* p, int off, unsigned v) {
    if constexpr (WTF) asm volatile("global_store_dword %0, %1, off offset:%2 sc1" :: "v"(p), "v"(v), "i"(off) : "memory");
    else *(unsigned*)((char*)p + off) = v;
}
#define st16g st16x<WT_G>
#define st8g  st8x<WT_G>
#define st16a st16x<WT_A>
#define st16s st16x<WT_S>
#define st8s  st8x<WT_S>
__device__ __forceinline__ void st16fs(void* p, int off, f32x4 v) { st16x<WT_S>(p, off, __builtin_bit_cast(u32x4, v)); }

namespace pg8 {
constexpr int BM = 256, BK = 64, HALF = 128, HTB = HALF * BK * 2  , STAGE_BYTES = 8 * HTB, NXCD = 8, WGM = 8;
__host__ __device__ __forceinline__ int lds_byte(int r, int c) { const int st = (r >> 4) * 2 + (c >> 5), rr = r & 15, cc = c & 31, ob = rr * 64 + cc * 2; return st * 1024 + (ob ^ (((ob >> 9) & 1) << 5)); }
__host__ __device__ __forceinline__ void stage_rc(int b, int& R, int& C) { const int st = b / 1024, sb = b % 1024, swz = sb ^ (((sb >> 9) & 1) << 5); R = (st >> 1) * 16 + swz / 64; C = (st & 1) * 32 + (swz % 64) / 2; }
__host__ __device__ __forceinline__ int perm32(int rho) { const int n = rho >> 4, i = rho & 15; return 8 * (i >> 2) + 4 * n + (i & 3); }

struct Unit { int pm, pn, e, rt, rows; };

template <int MODE>
struct DenseT {
    static constexpr bool ROWSKIP = false;
    const bf16_t* A; const bf16_t* Bt; int lda, K; int nM, nN, nwg, G, c; unsigned* ready; unsigned need; int sel;
    __device__ void init(const bf16_t* A_, int lda_, const bf16_t* Bt_, int M, int N, int K_, int G_, int c_) { A = A_; lda = lda_; Bt = Bt_; K = K_; nM = M / BM; nN = N / BM; nwg = nM * nN; G = G_; c = c_; ready = nullptr; need = 0u; sel = 0; }
    __device__ __forceinline__ bool next(int i, Unit& u) const {
        const long L = (long)i * G + c; if (L >= nwg) return false;
        int wgid = (int)L; { const int q = nwg / NXCD, r = nwg % NXCD, xcd = wgid % NXCD, off = wgid / NXCD; wgid = (xcd < r ? xcd * (q + 1) : r * (q + 1) + (xcd - r) * q) + off; }
        const int nig = WGM * nN, gid = wgid / nig, fm = gid * WGM, gsz = (nM - fm) < WGM ? (nM - fm) : WGM;
        u.pm = fm + ((wgid % nig) % gsz); u.pn = (wgid % nig) / gsz; u.e = 0; u.rt = 0; u.rows = 256; return true;
    }
    __device__ __forceinline__ const char* a_base(const Unit& u) const { return (const char*)A + (size_t)u.pm * BM * lda * 2; }
    __device__ __forceinline__ const char* b_base(const Unit& u) const { return (const char*)Bt + (size_t)u.pn * BM * K * 2; }
    __device__ __forceinline__ void a_ready(const Unit& u) const {
        if constexpr (MODE == 2) {
            if (threadIdx.x < 64) {
                unsigned polls = 0;
                while ((unsigned)__builtin_amdgcn_readfirstlane((int)__hip_atomic_load(ready + 32 * (2 * u.pm + sel), __ATOMIC_RELAXED, __HIP_MEMORY_SCOPE_AGENT)) < need) {
                    __builtin_amdgcn_s_sleep(2); if (++polls > (1u << 19)) break; }
                __builtin_amdgcn_fence(__ATOMIC_ACQUIRE, "agent");
                asm volatile("s_waitcnt vmcnt(0)" ::: "memory");
            }
            asm volatile("" ::: "memory"); __builtin_amdgcn_s_barrier(); asm volatile("" ::: "memory");
        }
    }
    __device__ __forceinline__ void done(const Unit& u) const {
        if constexpr (MODE == 1) {
            if (u.pn < 3) {
                asm volatile("s_waitcnt vmcnt(0)" ::: "memory");
                if ((threadIdx.x & 63) == 0) __hip_atomic_fetch_add(ready + 32 * (2 * u.pm + (u.pn == 2 ? 1 : 0)), 1u, __ATOMIC_RELAXED, __HIP_MEMORY_SCOPE_AGENT); }
        }
    }
    __device__ __forceinline__ void a_voff(const Unit&, int R0, int C0, int R1, int C1, unsigned (&vo)[2][2]) const {
        vo[0][0] = (unsigned)(R0 * lda + C0) * 2u; vo[0][1] = (unsigned)(R1 * lda + C1) * 2u; vo[1][0] = vo[0][0]; vo[1][1] = vo[0][1]; }
    __device__ __forceinline__ size_t a_hstep() const { return (size_t)HALF * lda * 2; }
};
using Dense = DenseT<0>;

__device__ __forceinline__ void glds_s(const char* sbase, unsigned voff, unsigned lds_dst) { unsigned keep;
    asm volatile("s_mov_b32 %0, m0\n\ts_mov_b32 m0, %2\n\ts_nop 0\n\tglobal_load_lds_dwordx4 %1, %3\n\ts_mov_b32 m0, %0" : "=&s"(keep) : "v"(voff), "s"(lds_dst), "s"(sbase) : "memory"); }
template <class Epi, class Prob, bool GATHER>
__device__ __forceinline__ void gemm_phase(LAS unsigned char* lds, const Prob& S, const Epi& E, const int tid, LAS unsigned* stash = nullptr) {
    const int wid = __builtin_amdgcn_readfirstlane(tid >> 6), lane = tid & 63, wr = wid >> 2, wc = wid & 3, fr = lane & 15, fq = lane >> 4;
    const int K = S.K, nt = K / BK;
    int R0, C0, R1, C1; stage_rc(tid * 16, R0, C0); stage_rc(tid * 16 + 8192, R1, C1);
    unsigned voffB[2];
    { const int Rb0 = Epi::WIDE ? ((R0 >> 5) * 64 + perm32(R0 & 31)) : Epi::PERM ? ((R0 & ~31) + perm32(R0 & 31)) : R0, Rb1 = Epi::WIDE ? ((R1 >> 5) * 64 + perm32(R1 & 31)) : Epi::PERM ? ((R1 & ~31) + perm32(R1 & 31)) : R1;
      voffB[0] = (unsigned)(Rb0 * K + C0) * 2u; voffB[1] = (unsigned)(Rb1 * K + C1) * 2u; }
    const size_t kstep = (size_t)(BK * 2);
    const size_t hstepB = (size_t)(Epi::WIDE ? 32 : HALF) * K * 2;
    const size_t hstepA = GATHER ? 0 : S.a_hstep();
    const unsigned ldsb = (unsigned)(uintptr_t)lds + (unsigned)wid * 1024u;
    const int aoff = lds_byte(wr * 64 + fr, fq * 8), boff = lds_byte(wc * 32 + fr, fq * 8);
#define PG8_SA(b, h) (((b) * 2 + (h)) * HTB)
#define PG8_SB(b, h) ((4 + (b) * 2 + (h)) * HTB)
#define PG8_STAGE(bufoff, gbase, voff) do { _Pragma("unroll") for (int _i = 0; _i < 2; ++_i) \
        glds_s((const char*)(gbase), (voff)[_i], ldsb + (unsigned)((bufoff) + _i * 8192)); } while (0)
#define PG8_LDA(dst, b, h) do { _Pragma("unroll") for (int m = 0; m < 4; ++m) _Pragma("unroll") for (int k = 0; k < 2; ++k) dst[m][k] = *(const LAS bf16x8*)(lds + PG8_SA(b, h) + aoff + m * 2048 + k * 1024); } while (0)
#define PG8_LDB(dst, b, h) do { _Pragma("unroll") for (int n = 0; n < 2; ++n) _Pragma("unroll") for (int k = 0; k < 2; ++k) dst[n][k] = *(const LAS bf16x8*)(lds + PG8_SB(b, h) + boff + n * 2048 + k * 1024); } while (0)
#define PG8_MMA(ai, bj, At, Bt) do { __builtin_amdgcn_s_setprio(1); _Pragma("unroll") for (int m = 0; m < 4; ++m) { if (!Prob::ROWSKIP || (ai) * HALF + wr * 64 + m * 16 < rows_cur) { _Pragma("unroll") for (int n = 0; n < 2; ++n) _Pragma("unroll") for (int k = 0; k < 2; ++k) \
        acc[ai][bj][m][n] = __builtin_amdgcn_mfma_f32_16x16x32_bf16(Bt[n][k], At[m][k], acc[ai][bj][m][n], 0, 0, 0); } } __builtin_amdgcn_s_setprio(0); } while (0)
#define PG8_WAIT_V(n) asm volatile("s_waitcnt vmcnt(" #n ")" ::: "memory")
#define PG8_WAIT_L(n) asm volatile("s_waitcnt lgkmcnt(" #n ")" ::: "memory")
#define PG8_BAR __builtin_amdgcn_s_barrier()
#define PG8_SCHED __builtin_amdgcn_sched_barrier(0)
    Unit cur, nxt; int ui = 0;
    if (!S.next(0, cur)) return;
    bool has_next = S.next(1, nxt);
    unsigned voffA[2][2];
    S.a_voff(cur, R0, C0, R1, C1, voffA);
    LAS u32x4* const st4 = (LAS u32x4*)stash + tid;
    if (GATHER) { unsigned vn[2][2]; if (has_next) S.a_voff(nxt, R0, C0, R1, C1, vn); else { vn[0][0] = voffA[0][0]; vn[0][1] = voffA[0][1]; vn[1][0] = voffA[1][0]; vn[1][1] = voffA[1][1]; }
        *st4 = (u32x4){vn[0][0], vn[0][1], vn[1][0], vn[1][1]};
        asm volatile("s_waitcnt vmcnt(0)" : "+v"(voffA[0][0]), "+v"(voffA[0][1]), "+v"(voffA[1][0]), "+v"(voffA[1][1]) :: "memory"); }
    f32x4 acc[2][2][4][2];
#pragma unroll
    for (int a = 0; a < 2; ++a)
#pragma unroll
        for (int b = 0; b < 2; ++b)
#pragma unroll
            for (int m = 0; m < 4; ++m)
#pragma unroll
                for (int n = 0; n < 2; ++n) acc[a][b][m][n] = (f32x4){0.f, 0.f, 0.f, 0.f};
    bf16x8 At[4][2], B0[2][2], B1[2][2];
    const char* cA = S.a_base(cur); const char* cB = S.b_base(cur); int rows_cur = cur.rows; (void)rows_cur;
    S.a_ready(cur);
    PG8_STAGE(PG8_SB(0, 0), cB, voffB); PG8_STAGE(PG8_SB(0, 1), cB + hstepB, voffB); PG8_STAGE(PG8_SA(0, 0), cA, voffA[0]); PG8_STAGE(PG8_SA(0, 1), cA + hstepA, voffA[1]);
    if (wr == 1) PG8_BAR;
    PG8_WAIT_V(2); PG8_BAR;
    PG8_STAGE(PG8_SB(1, 0), cB + kstep, voffB); PG8_STAGE(PG8_SA(1, 0), cA + kstep, voffA[0]); PG8_STAGE(PG8_SB(1, 1), cB + hstepB + kstep, voffB);
    PG8_WAIT_V(6); PG8_BAR;
    for (;;) {
        const char* nA = has_next ? S.a_base(nxt) : cA; const char* nB = has_next ? S.b_base(nxt) : cB;
#pragma unroll 1
        for (int t = 0; t < nt; t += 2) {
            const bool last = (t == nt - 2);
            if (last && has_next) S.a_ready(nxt);
            const char* a1 = cA + (size_t)(t + 1) * kstep;
            const char* a2 = last ? nA : cA + (size_t)(t + 2) * kstep; const char* b2 = last ? nB : cB + (size_t)(t + 2) * kstep;
            const char* a3 = a2 + kstep; const char* b3 = b2 + kstep;
            unsigned v20 = voffA[0][0], v21 = voffA[0][1], v30 = voffA[1][0], v31 = voffA[1][1];
            if (GATHER) { if (last) { const u32x4 n4 = *st4; v20 = n4.x; v21 = n4.y; v30 = n4.z; v31 = n4.w; } }
            const unsigned vh0[2] = {v20, v21}, vh1[2] = {v30, v31};
            PG8_LDB(B0, 0, 0); PG8_LDB(B1, 0, 1); PG8_SCHED; PG8_LDA(At, 0, 0); PG8_STAGE(PG8_SA(1, 1), a1 + hstepA, voffA[1]);
            PG8_WAIT_V(8); PG8_WAIT_L(0); PG8_BAR; PG8_MMA(0, 0, At, B0); PG8_MMA(0, 1, At, B1); PG8_BAR; PG8_SCHED;
            PG8_LDA(At, 0, 1); PG8_STAGE(PG8_SB(0, 0), b2, voffB); PG8_STAGE(PG8_SB(0, 1), b2 + hstepB, voffB); PG8_STAGE(PG8_SA(0, 0), a2, vh0);
            PG8_WAIT_V(8); PG8_WAIT_L(0); PG8_BAR; PG8_MMA(1, 0, At, B0); PG8_MMA(1, 1, At, B1); PG8_BAR; PG8_SCHED;
            PG8_LDB(B0, 1, 0); PG8_LDB(B1, 1, 1); PG8_SCHED; PG8_LDA(At, 1, 0); PG8_STAGE(PG8_SA(0, 1), a2 + hstepA, vh1);
            PG8_WAIT_V(8); PG8_WAIT_L(0); PG8_BAR; PG8_MMA(0, 0, At, B0); PG8_MMA(0, 1, At, B1); PG8_BAR; PG8_SCHED;
            PG8_LDA(At, 1, 1); PG8_STAGE(PG8_SB(1, 0), b3, voffB); PG8_STAGE(PG8_SB(1, 1), b3 + hstepB, voffB); PG8_STAGE(PG8_SA(1, 0), a3, vh0);
            PG8_WAIT_V(8); PG8_WAIT_L(0); PG8_BAR; PG8_MMA(1, 0, At, B0); PG8_MMA(1, 1, At, B1); PG8_BAR; PG8_SCHED;
        }
        if (wr == 0) PG8_BAR;
        { int fr_e = fr, fq_e = fq; asm volatile("" : "+v"(fr_e), "+v"(fq_e));
          E(acc, cur, wr, wc, fr_e, fq_e); }
        S.done(cur);
        if (!has_next) break;
#pragma unroll
        for (int a = 0; a < 2; ++a)
#pragma unroll
            for (int b = 0; b < 2; ++b)
#pragma unroll
                for (int m = 0; m < 4; ++m)
#pragma unroll
                    for (int n = 0; n < 2; ++n) acc[a][b][m][n] = (f32x4){0.f, 0.f, 0.f, 0.f};
        cur = nxt; cA = nA; cB = nB; ++ui; rows_cur = cur.rows;
        has_next = S.next(ui + 1, nxt);
        if (GATHER) {
            { const u32x4 n4 = *st4; voffA[0][0] = n4.x; voffA[0][1] = n4.y; voffA[1][0] = n4.z; voffA[1][1] = n4.w; }
            if (has_next) { unsigned vn[2][2]; S.a_voff(nxt, R0, C0, R1, C1, vn);
                asm volatile("s_waitcnt vmcnt(0)" : "+v"(vn[0][0]), "+v"(vn[0][1]), "+v"(vn[1][0]), "+v"(vn[1][1]) :: "memory");
                *st4 = (u32x4){vn[0][0], vn[0][1], vn[1][0], vn[1][1]}; }
        }
        if (wr == 1) PG8_BAR;
    }
    PG8_WAIT_V(0);
    PG8_BAR;
#undef PG8_SA
#undef PG8_SB
#undef PG8_STAGE
#undef PG8_LDA
#undef PG8_LDB
#undef PG8_MMA
#undef PG8_WAIT_V
#undef PG8_WAIT_L
#undef PG8_BAR
#undef PG8_SCHED
}
}
namespace mk {
constexpr int NB = 4, S = 4096, D = 1024, N = NB * S;
constexpr float EPS = 1e-6f, LOG2E = 1.4426950408889634f;
constexpr float C2_64 = 0.125f * LOG2E, C2_96 = 0.10206207261596575f * LOG2E;
constexpr size_t MiB = 1u << 20;
constexpr size_t WS_CTL = 0, CTL_ZERO_BYTES = 1 * MiB;
constexpr size_t WS_SS = 1 * MiB;
constexpr size_t WS_RSTD = WS_SS + (size_t)N * 4;
constexpr size_t WS_SSP = WS_RSTD + (size_t)N * 4;
constexpr size_t WS_LOGF = WS_SSP + (size_t)N * 64;
constexpr size_t WS_CB2 = WS_LOGF + (size_t)N * 32;
constexpr size_t WS_ROPE = WS_CB2 + (size_t)32 * S * 4;
constexpr size_t WS_DLSE = WS_ROPE + (size_t)S * 16 * 8;
constexpr size_t WS_SSZ = WS_DLSE + (size_t)3 * N * 32;
constexpr size_t WS_LT = WS_SSZ + (size_t)N * 48;
constexpr size_t WS_LW = WS_LT + (size_t)32 * N * 4;
constexpr size_t WS_LR = WS_LW + (size_t)32 * N * 4;
constexpr size_t WS_SMALL_END = WS_LR + (size_t)32 * N * 4;
constexpr size_t WS_KEXT = WS_LT;
static_assert(WS_SMALL_END <= 13 * MiB, "small arrays");
constexpr size_t WS_WIN0 = 13 * MiB;
constexpr size_t WS_WOUT0 = WS_WIN0 + 6 * MiB;
constexpr size_t WS_WIN1 = WS_WOUT0 + 2 * MiB;
constexpr size_t WS_WUQ = WS_WIN1 + 3 * MiB;
constexpr size_t WS_WUKV = WS_WUQ + 768 * 384 * 2;
constexpr size_t WS_WOUT1 = WS_WUKV + 1024 * 256 * 2;
constexpr size_t WS_WR = WS_WOUT1 + 2 * MiB;
static_assert(WS_WR + 2 * 64 * 1024 * 2 <= 28 * MiB, "weights");
constexpr size_t WS_XB = 28 * MiB;
constexpr size_t WS_R1 = 60 * MiB;
constexpr size_t WS_R2 = 164 * MiB;
constexpr size_t WS_END = 244 * MiB;
constexpr size_t R1_QKV0 = WS_R1;
constexpr size_t R1_Z1 = WS_R1, R1_Q1 = WS_R1 + 48 * MiB, R1_KV1 = WS_R1 + 72 * MiB;
constexpr size_t R1_WGU = WS_R1, R1_WD = WS_R1 + 32 * MiB, R1_ACT = WS_R1 + 48 * MiB;
constexpr size_t R2_AO = WS_R2, R2_DPART = WS_R2 + 32 * MiB;
constexpr size_t R2_Y = WS_R2;
constexpr size_t Y1_BASE = 128 * MiB;
constexpr size_t R2_WGU1 = WS_R2 + 32 * MiB, R2_WD1 = WS_R2 + 64 * MiB;
constexpr int CW_CNT = 64;
constexpr int CW_BAR = 4096;
constexpr int CW_RDY2 = 49152;
constexpr int CW_RDY = 16384;
}

#ifndef WIDE_QKV
#define WIDE_QKV 0
#endif
namespace pg8 {
using mk::EPS;
struct EpiQkv0 {
    static constexpr bool PERM = true; static constexpr bool WIDE = (WIDE_QKV != 0);
    bf16_t* O; const float* ss;
    __device__ __forceinline__ void operator()(const f32x4 (&acc)[2][2][4][2], const Unit& u, int wr, int wc, int fr, int fq) const {
        const int row0 = u.pm * BM + wr * 64 + fr, col0 = u.pn * BM + (WIDE ? wc * 64 : wc * 32) + 8 * fq;
        const float sc = (u.pn < 2 || u.pn == 6 || u.pn == 7) ? mk::C2_64 : 1.f;
        float rs[8];
#pragma unroll
        for (int i = 0; i < 8; ++i) rs[i] = ss[row0 + (i >> 2) * HALF + (i & 3) * 16];
#pragma unroll
        for (int i = 0; i < 8; ++i) rs[i] = sc / sqrtf(rs[i] * (1.f / 1024.f) + EPS);
#pragma unroll
        for (int ai = 0; ai < 2; ++ai)
#pragma unroll
            for (int m = 0; m < 4; ++m) { const int row = row0 + ai * HALF + m * 16; const float r_ = rs[ai * 4 + m];
                bf16_t* rowp = O + (size_t)row * 3072 + col0;
#pragma unroll
                for (int bj = 0; bj < 2; ++bj) { const f32x4 v0 = acc[ai][bj][m][0] * r_, v1 = acc[ai][bj][m][1] * r_;
                    u32x4 w; w.x = cvtpk(v0[0], v0[1]); w.y = cvtpk(v0[2], v0[3]); w.z = cvtpk(v1[0], v1[1]); w.w = cvtpk(v1[2], v1[3]);
                    st16g(rowp, WIDE ? bj * 64 : bj * HALF * 2, w); } }
    }
};
struct EpiOut {
    static constexpr bool PERM = false; static constexpr bool WIDE = false;
    bf16_t* X; float* ssp;
    __device__ __forceinline__ void operator()(const f32x4 (&acc)[2][2][4][2], const Unit& u, int wr, int wc, int fr, int fq) const {
        const int row0 = u.pm * BM + wr * 64 + fr, col0 = u.pn * BM + wc * 32 + 4 * fq;
        u32x2 rb[8][4];
#pragma unroll
        for (int i = 0; i < 8; ++i) { const size_t off = (size_t)(row0 + (i >> 2) * HALF + (i & 3) * 16) * 1024 + col0;
#pragma unroll
            for (int qq = 0; qq < 4; ++qq) rb[i][qq] = *(const u32x2*)(X + off + (qq >> 1) * HALF + (qq & 1) * 16); }
#pragma unroll
        for (int i = 0; i < 8; ++i) { const int ai = i >> 2, m = i & 3; const int row = row0 + ai * HALF + m * 16; const size_t off = (size_t)row * 1024 + col0; float q = 0.f;
#pragma unroll
            for (int qq = 0; qq < 4; ++qq) { const f32x4 a4 = acc[ai][qq >> 1][m][qq & 1]; const u32x2 r2 = rb[i][qq];
                const float v0 = bflo(r2.x) + a4[0], v1 = bfhi(r2.x) + a4[1], v2 = bflo(r2.y) + a4[2], v3 = bfhi(r2.y) + a4[3];
                u32x2 w; w.x = cvtpk(v0, v1); w.y = cvtpk(v2, v3); st8g(X + off, ((qq >> 1) * HALF + (qq & 1) * 16) * 2, w);
                q += (v0 * v0 + v1 * v1) + (v2 * v2 + v3 * v3); }
            q += __shfl_xor(q, 16); q += __shfl_xor(q, 32);
            if (fq == 0) ssp[(size_t)row * 16 + u.pn * 4 + wc] = q; }
    }
};
struct EpiWin1 {
    static constexpr bool PERM = false; static constexpr bool WIDE = false;
    bf16_t* Z; const float* ss; float* ssz; const f32x2* rope;
    __device__ __forceinline__ void operator()(const f32x4 (&acc)[2][2][4][2], const Unit& u, int wr, int wc, int fr, int fq) const {
        const int row0 = u.pm * BM + wr * 64 + fr, col0 = u.pn * BM + wc * 32 + 4 * fq; const int pn = u.pn;
        const float sc = (pn == 3 || pn == 4) ? mk::C2_64 : 1.f; const bool ropew = (pn == 1 && wc == 0);
        float rs[8];
#pragma unroll
        for (int i = 0; i < 8; ++i) rs[i] = ss[row0 + (i >> 2) * HALF + (i & 3) * 16];
#pragma unroll
        for (int i = 0; i < 8; ++i) rs[i] = sc / sqrtf(rs[i] * (1.f / 1024.f) + EPS);
#pragma unroll
        for (int ai = 0; ai < 2; ++ai) {
            f32x4 cs[4][2];
            if (ropew) {
#pragma unroll
                for (int m = 0; m < 4; ++m) { const f32x4* rp = (const f32x4*)(rope + (size_t)((row0 + ai * HALF + m * 16) & (mk::S - 1)) * 16 + 4 * fq); cs[m][0] = rp[0]; cs[m][1] = rp[1]; } }
#pragma unroll
            for (int m = 0; m < 4; ++m) { const int row = row0 + ai * HALF + m * 16; const float r_ = rs[ai * 4 + m];
                bf16_t* rowp = Z + (size_t)row * 1536 + col0; float q = 0.f;
#pragma unroll
                for (int bj = 0; bj < 2; ++bj) { f32x4 v0 = acc[ai][bj][m][0] * r_, v1 = acc[ai][bj][m][1] * r_;
                    if (pn == 1 && bj == 1) {
                        if (wc != 0) continue;
#pragma unroll
                        for (int j = 0; j < 4; ++j) { const float c_ = cs[m][j >> 1][2 * (j & 1)], s_ = cs[m][j >> 1][2 * (j & 1) + 1]; const float t1 = v0[j], t2 = v1[j]; v0[j] = t1 * c_ - t2 * s_; v1[j] = t1 * s_ + t2 * c_; }
                    } else if (pn < 3) q += (v0[0] * v0[0] + v0[1] * v0[1]) + (v0[2] * v0[2] + v0[3] * v0[3]) + (v1[0] * v1[0] + v1[1] * v1[1]) + (v1[2] * v1[2] + v1[3] * v1[3]);
                    u32x2 w0, w1; w0.x = cvtpk(v0[0], v0[1]); w0.y = cvtpk(v0[2], v0[3]); w1.x = cvtpk(v1[0], v1[1]); w1.y = cvtpk(v1[2], v1[3]);
                    st8x<1>(rowp, bj * HALF * 2, w0); st8x<1>(rowp, bj * HALF * 2 + 32, w1); }
                if (pn < 3) { q += __shfl_xor(q, 16); q += __shfl_xor(q, 32); if (fq == 0) st4x<1>(ssz + (size_t)row * 12 + pn * 4 + wc, 0, __float_as_uint(q)); } }
        }
    }
};
struct EpiUq {
    static constexpr bool PERM = false; static constexpr bool WIDE = false;
    bf16_t* Q; const float* ssz; const f32x2* rope;
    __device__ __forceinline__ void operator()(const f32x4 (&acc)[2][2][4][2], const Unit& u, int wr, int wc, int fr, int fq) const {
        const int row0 = u.pm * BM + wr * 64 + fr, col0 = u.pn * BM + wc * 32 + 4 * fq;
        const bool rp0 = ((u.pn * 8 + wc) % 3 == 2), rp1 = ((u.pn * 8 + 4 + wc) % 3 == 2);
        float rs[8];
#pragma unroll
        for (int hb = 0; hb < 2; ++hb) { f32x4 sa[4], sb[4];
#pragma unroll
          for (int i = 0; i < 4; ++i) { const f32x4* sp = (const f32x4*)(ssz + (size_t)(row0 + hb * HALF + i * 16) * 12); sa[i] = sp[0]; sb[i] = sp[1]; }
#pragma unroll
          for (int i = 0; i < 4; ++i) rs[hb * 4 + i] = mk::C2_96 / sqrtf(((sa[i][0] + sa[i][1]) + (sa[i][2] + sa[i][3]) + (sb[i][0] + sb[i][1]) + (sb[i][2] + sb[i][3])) * (1.f / 384.f) + EPS);
          asm volatile("" ::: "memory"); }
#pragma unroll
        for (int ai = 0; ai < 2; ++ai)
#pragma unroll
            for (int mp = 0; mp < 2; ++mp) {
                f32x4 cs[2][2];
                if (rp0 || rp1) {
#pragma unroll
                    for (int mm = 0; mm < 2; ++mm) { const f32x4* rp = (const f32x4*)(rope + (size_t)((row0 + ai * HALF + (2 * mp + mm) * 16) & (mk::S - 1)) * 16 + 4 * fq); cs[mm][0] = rp[0]; cs[mm][1] = rp[1]; } }
#pragma unroll
                for (int mm = 0; mm < 2; ++mm) { const int m = 2 * mp + mm; const int row = row0 + ai * HALF + m * 16; const float r_ = rs[ai * 4 + m];
                    bf16_t* rowp = Q + (size_t)row * 768 + col0;
#pragma unroll
                    for (int bj = 0; bj < 2; ++bj) { f32x4 v0 = acc[ai][bj][m][0] * r_, v1 = acc[ai][bj][m][1] * r_;
                        if (bj == 0 ? rp0 : rp1) {
#pragma unroll
                            for (int j = 0; j < 4; ++j) { const float c_ = cs[mm][j >> 1][2 * (j & 1)], s_ = cs[mm][j >> 1][2 * (j & 1) + 1]; const float t1 = v0[j], t2 = v1[j]; v0[j] = t1 * c_ - t2 * s_; v1[j] = t1 * s_ + t2 * c_; } }
                        u32x2 w0, w1; w0.x = cvtpk(v0[0], v0[1]); w0.y = cvtpk(v0[2], v0[3]); w1.x = cvtpk(v1[0], v1[1]); w1.y = cvtpk(v1[2], v1[3]);
                        st8g(rowp, bj * HALF * 2, w0); st8g(rowp, bj * HALF * 2 + 32, w1); } }
                asm volatile("" ::: "memory"); }
    }
};
struct EpiUkv {
    static constexpr bool PERM = true; static constexpr bool WIDE = false;
    bf16_t* O; const float* ssz;
    __device__ __forceinline__ void operator()(const f32x4 (&acc)[2][2][4][2], const Unit& u, int wr, int wc, int fr, int fq) const {
        const int row0 = u.pm * BM + wr * 64 + fr, col0 = u.pn * BM + wc * 32 + 8 * fq;
        float rs[8];
        { f32x4 sa[8];
#pragma unroll
          for (int i = 0; i < 8; ++i) sa[i] = *(const f32x4*)(ssz + (size_t)(row0 + (i >> 2) * HALF + (i & 3) * 16) * 12 + 8);
#pragma unroll
          for (int i = 0; i < 8; ++i) rs[i] = 1.f / sqrtf(((sa[i][0] + sa[i][1]) + (sa[i][2] + sa[i][3])) * (1.f / 256.f) + EPS); }
#pragma unroll
        for (int ai = 0; ai < 2; ++ai)
#pragma unroll
            for (int m = 0; m < 4; ++m) { const int row = row0 + ai * HALF + m * 16; const float r_ = rs[ai * 4 + m];
                bf16_t* rowp = O + (size_t)row * 1024 + col0;
#pragma unroll
                for (int bj = 0; bj < 2; ++bj) { const f32x4 v0 = acc[ai][bj][m][0] * r_, v1 = acc[ai][bj][m][1] * r_;
                    u32x4 w; w.x = cvtpk(v0[0], v0[1]); w.y = cvtpk(v0[2], v0[3]); w.z = cvtpk(v1[0], v1[1]); w.w = cvtpk(v1[2], v1[3]);
                    st16g(rowp, bj * HALF * 2, w); } }
    }
};
template <int MODE>
struct MoeProb {
    static constexpr bool ROWSKIP = true;
    const LAS int* pre; const LAS int* cnt; int NT, G, c, K, lda;
    const bf16_t* A; const bf16_t* Bt; size_t bstride;
    const unsigned* lt;
    bool gather; unsigned* ready; unsigned need;
    __device__ __forceinline__ bool next(int i, Unit& u) const {
        const int totF = pre[72]; long L;
        if constexpr (MODE == 1) {
            const int F = totF * NT, Tn = pre[112] * NT, r = F % G, nfull = F / G + (c < r ? 1 : 0), Z = G - r;
            if (i < nfull) L = (long)i * G + c;
            else { const int k = i - nfull; int j;
                if (c >= r) { if (k > 1) return false; j = (c - r) + Z * k; if (j >= 2 * Z) return false; }
                else { if (k > 0) return false; j = 2 * Z + c; }
                if (j >= Tn) return false; L = F + j; }
        } else { L = (long)i * G + c; const int total = (totF + pre[112]) * NT; if (L >= total) return false; }
        int f = (int)L / NT; u.pn = (int)L % NT; int e = 0;
        if (f < totF) {
#pragma unroll
            for (int j = 1; j < 32; ++j) if (pre[40 + j] <= f) e = j;
            u.rt = f - pre[40 + e]; u.rows = 256;
        } else { e = pre[80 + f - totF]; u.rt = cnt[e] >> 8; u.rows = cnt[e] & 255; }
        e = __builtin_amdgcn_readfirstlane(e); u.e = e; u.rt = __builtin_amdgcn_readfirstlane(u.rt); u.rows = __builtin_amdgcn_readfirstlane(u.rows); u.pm = __builtin_amdgcn_readfirstlane(pre[e]) + u.rt; return true;
    }
    __device__ __forceinline__ void a_ready(const Unit& u) const {
        if constexpr (MODE == 2) {
            if (threadIdx.x < 64) {
                unsigned polls = 0;
                while ((unsigned)__builtin_amdgcn_readfirstlane((int)__hip_atomic_load(ready + 32 * u.pm, __ATOMIC_RELAXED, __HIP_MEMORY_SCOPE_AGENT)) < need) {
                    __builtin_amdgcn_s_sleep(2); if (++polls > (1u << 19)) break; }
            }
            asm volatile("" ::: "memory"); __builtin_amdgcn_s_barrier(); asm volatile("" ::: "memory");
        }
    }
    __device__ __forceinline__ void done(const Unit& u) const {
        if constexpr (MODE == 1) {
            asm volatile("s_waitcnt vmcnt(0)" ::: "memory");
            if ((threadIdx.x & 63) == 0) __hip_atomic_fetch_add(ready + 32 * u.pm, 1u, __ATOMIC_RELAXED, __HIP_MEMORY_SCOPE_AGENT);
        }
    }
    __device__ __forceinline__ const char* a_base(const Unit& u) const { return gather ? (const char*)A : (const char*)A + (size_t)u.pm * BM * lda * 2; }
    __device__ __forceinline__ size_t a_hstep() const { return (size_t)HALF * lda * 2; }
    __device__ __forceinline__ const char* b_base(const Unit& u) const { return (const char*)Bt + ((size_t)u.e * bstride + (size_t)u.pn * BM * K) * 2; }
    __device__ __forceinline__ void a_voff(const Unit& u, int R0, int C0, int R1, int C1, unsigned (&vo)[2][2]) const {
        if (gather) { const unsigned* l = lt + (size_t)u.e * mk::N + u.rt * 256;
            const unsigned t00 = (R0 < u.rows) ? (l[R0] & 0x7fffffffu) : 0u, t01 = (R1 < u.rows) ? (l[R1] & 0x7fffffffu) : 0u;
            const unsigned t10 = (R0 + HALF < u.rows) ? (l[R0 + HALF] & 0x7fffffffu) : 0u, t11 = (R1 + HALF < u.rows) ? (l[R1 + HALF] & 0x7fffffffu) : 0u;
            vo[0][0] = (t00 * (unsigned)lda + C0) * 2u; vo[0][1] = (t01 * (unsigned)lda + C1) * 2u; vo[1][0] = (t10 * (unsigned)lda + C0) * 2u; vo[1][1] = (t11 * (unsigned)lda + C1) * 2u;
        } else { vo[0][0] = (unsigned)(R0 * lda + C0) * 2u; vo[0][1] = (unsigned)(R1 * lda + C1) * 2u; vo[1][0] = vo[0][0]; vo[1][1] = vo[0][1]; }
    }
};
struct EpiGateUp {
    static constexpr bool PERM = true; static constexpr bool WIDE = false;
    bf16_t* act; const float* lw; const float* lr;
    __device__ __forceinline__ void operator()(const f32x4 (&acc)[2][2][4][2], const Unit& u, int wr, int wc, int fr, int fq) const {
        const int rl0 = wr * 64 + fr, col0 = u.pn * 128 + wc * 32 + 8 * fq; const size_t lbase = (size_t)u.e * mk::N + u.rt * 256;
        float wv[8], rv[8];
#pragma unroll
        for (int i = 0; i < 8; ++i) { const int rl = rl0 + (i >> 2) * HALF + (i & 3) * 16; const bool ok = rl < u.rows; wv[i] = ok ? lw[lbase + rl] : 0.f; rv[i] = ok ? lr[lbase + rl] : 0.f; }
#pragma unroll
        for (int ai = 0; ai < 2; ++ai)
#pragma unroll
            for (int m = 0; m < 4; ++m) { const int rl = rl0 + ai * HALF + m * 16; if (rl >= u.rows) continue;
                const float w = wv[ai * 4 + m], rs = rv[ai * 4 + m]; float o[8];
#pragma unroll
                for (int n = 0; n < 2; ++n)
#pragma unroll
                    for (int j = 0; j < 4; ++j) { const float g = acc[ai][0][m][n][j] * rs, up = acc[ai][1][m][n][j] * rs;
                        o[n * 4 + j] = g * __builtin_amdgcn_rcpf(1.f + __builtin_amdgcn_exp2f(-g * mk::LOG2E)) * up * w; }
                u32x4 pk; pk.x = cvtpk(o[0], o[1]); pk.y = cvtpk(o[2], o[3]); pk.z = cvtpk(o[4], o[5]); pk.w = cvtpk(o[6], o[7]);
                st16x<1>(act + ((size_t)u.pm * 256 + rl) * 256 + col0, 0, pk);   }
    }
};
struct EpiDown {
    static constexpr bool PERM = true; static constexpr bool WIDE = false;
    bf16_t* Y; const unsigned* lt;
    __device__ __forceinline__ void operator()(const f32x4 (&acc)[2][2][4][2], const Unit& u, int wr, int wc, int fr, int fq) const {
        const int rl0 = wr * 64 + fr, col0 = u.pn * BM + wc * 32 + 8 * fq; const size_t lbase = (size_t)u.e * mk::N + u.rt * 256;
        unsigned tk[8];
#pragma unroll
        for (int i = 0; i < 8; ++i) { const int rl = rl0 + (i >> 2) * HALF + (i & 3) * 16; tk[i] = (rl < u.rows) ? lt[lbase + rl] : 0u; }
#pragma unroll
        for (int ai = 0; ai < 2; ++ai)
#pragma unroll
            for (int m = 0; m < 4; ++m) { const int rl = rl0 + ai * HALF + m * 16; if (rl >= u.rows) continue;
                const unsigned t_ = tk[ai * 4 + m]; bf16_t* rowp = Y + ((size_t)(t_ >> 31) * mk::N + (t_ & 0x7fffffffu)) * 1024 + col0;
#pragma unroll
                for (int bj = 0; bj < 2; ++bj) { const f32x4 v0 = acc[ai][bj][m][0], v1 = acc[ai][bj][m][1];
                    u32x4 w; w.x = cvtpk(v0[0], v0[1]); w.y = cvtpk(v0[2], v0[3]); w.z = cvtpk(v1[0], v1[1]); w.w = cvtpk(v1[2], v1[3]);
                    st16g(rowp, bj * HALF * 2, w); } }
    }
};
}
namespace att {
constexpr int SLOT_K = 12288, SLOT_V = 8192, SLOT_KB = 256, SLOT = SLOT_K + SLOT_V + SLOT_KB;
constexpr int LDS_WS = 2 * SLOT, LDS_OST = LDS_WS + 8 * 256, LDS_BYTES = LDS_OST + 8 * 4608;
struct UnitDesc {
    const bf16_t* q; long qstride;
    const bf16_t* k; const bf16_t* v; long kstride;
    const bf16_t* kx; long kxstride;
    bf16_t* o; long ostride;
    float* lse; long lsestride;
    const float* kbias;
    int q0, W; float alibi, sink;
    bool has_sink, has_lse;
};
__device__ __forceinline__ int crow(int r, int hi) { return (r & 3) + 8 * (r >> 2) + 4 * hi; }
#define ATT_MX3(a, b, c) __builtin_fmaxf(__builtin_fmaxf((a), (b)), (c))
__device__ __forceinline__ float rowmax(const f32x16& p0, const f32x16& p1) {
    float a = ATT_MX3(p0[0], p0[1], p1[0]), b = ATT_MX3(p0[2], p0[3], p1[1]); a = ATT_MX3(a, p1[2], p1[3]);
#pragma unroll
    for (int r = 4; r < 16; r += 4) { a = ATT_MX3(a, p0[r], p0[r + 1]); b = ATT_MX3(b, p0[r + 2], p0[r + 3]); a = ATT_MX3(a, p1[r], p1[r + 1]); b = ATT_MX3(b, p1[r + 2], p1[r + 3]); }
    float m = __builtin_fmaxf(a, b); auto rr = __builtin_amdgcn_permlane32_swap(__float_as_uint(m), __float_as_uint(m), false, false);
    return __builtin_fmaxf(__uint_as_float(rr[0]), __uint_as_float(rr[1])); }
typedef short v4i16_t __attribute__((ext_vector_type(4)));
__device__ __forceinline__ s16x4 vtr(const LAS unsigned char* p) { return __builtin_bit_cast(s16x4, __builtin_amdgcn_ds_read_tr16_b64_v4i16((LAS v4i16_t*)p)); }

__device__ __forceinline__ void att_store_ot(const f32x16 (&o)[2], float inv, LAS bf16_t* stg, bf16_t* O, long ostride, int lane) {
    const int r32 = lane & 31, hi = lane >> 5;
#pragma unroll
    for (int d0 = 0; d0 < 2; ++d0)
#pragma unroll
        for (int g = 0; g < 4; ++g) { u32x2 p; p.x = cvtpk(o[d0][4 * g] * inv, o[d0][4 * g + 1] * inv); p.y = cvtpk(o[d0][4 * g + 2] * inv, o[d0][4 * g + 3] * inv);
            *(LAS u32x2*)(stg + r32 * 72 + 32 * d0 + 8 * g + 4 * hi) = p; }
#pragma unroll
    for (int i = 0; i < 4; ++i) { const int row = i * 8 + (lane >> 3), ch = lane & 7; const u32x4 v = *(const LAS u32x4*)(stg + row * 72 + ch * 8); st16a(O + (long)row * ostride + ch * 8, 0, v); }
}

template <int NDQ, bool FOX, bool BAND>
__device__ __forceinline__ void attn_unit(const UnitDesc& u, LAS unsigned char* lds, const int tid) {
    const int lane = tid & 63, r32 = lane & 31, hi = lane >> 5; const int w = __builtin_amdgcn_readfirstlane(tid >> 6);
    const int q0 = u.q0, Qw = q0 + 32 * w;
    const int t_lo = BAND ? ((q0 - u.W) > 0 ? ((q0 - u.W) >> 6) : 0) : 0, t_hi = (q0 + 255) >> 6;
    LAS float* wsf = (LAS float*)(lds + LDS_WS) + w * 64;
    const bf16_t* ksrc = u.k + (long)lane * u.kstride + w * 8;
    const bf16_t* kxsrc = (NDQ > 4) ? u.kx + (long)lane * u.kxstride + (NDQ == 6 ? (w & 3) * 8 : 0) : nullptr;
    const bf16_t* vsrc = u.v + (long)(16 * (w & 3) + (lane >> 2)) * u.kstride + (w >> 2) * 32 + (lane & 3) * 8;
#define ATT_DMA(t, bsel) do { LAS unsigned char* kb_ = lds + (bsel) * SLOT; \
        __builtin_amdgcn_global_load_lds((const unsigned*)(ksrc + (long)(t) * 64 * u.kstride), (LAS unsigned*)(kb_ + w * 1024), 16, 0, 0); \
        if (NDQ > 4) { if (w < 2 * (NDQ - 4)) __builtin_amdgcn_global_load_lds((const unsigned*)(kxsrc + (long)(t) * 64 * u.kxstride), (LAS unsigned*)(kb_ + (8 + w) * 1024), 16, 0, 0); } \
        __builtin_amdgcn_global_load_lds((const unsigned*)(vsrc + (long)(t) * 64 * u.kstride), (LAS unsigned*)(kb_ + SLOT_K + w * 1024), 16, 0, 0); } while (0)
    ATT_DMA(t_lo, 0);
    bf16x8 qr[NDQ];
    { const bf16_t* Qw_ = u.q + (long)(32 * w + r32) * u.qstride + hi * 8;
#pragma unroll
      for (int d0 = 0; d0 < (FOX ? 4 : NDQ); ++d0) qr[d0] = *(const bf16x8*)(Qw_ + d0 * 16);
      if (FOX) { const short one = hi ? (short)0 : (short)0x3F80; qr[4] = (bf16x8){one, one, one, 0, 0, 0, 0, 0}; } }
    const float ci = 0.f;
    f32x16 negm;
#pragma unroll
    for (int r = 0; r < 16; ++r) negm[r] = ci;
    float m_run = -1e30f, l_run = 0.f; f32x16 o[2]; o[0] = f32x16{}; o[1] = f32x16{};
    const int koff = hi * 1024 + r32 * 16;
    const int voff = SLOT_K + ((lane >> 4) & 1) * 32 + (lane & 3) * 8 + (4 * hi + ((lane & 15) >> 2)) * 64;
    for (int t = t_lo; t <= t_hi; ++t) {
        const int bsel = (t - t_lo) & 1;
        asm volatile("s_waitcnt vmcnt(0)" ::: "memory");
        __syncthreads();
        if (t < t_hi) ATT_DMA(t + 1, bsel ^ 1);
        const int k0 = 64 * t;
        bool active = (k0 <= Qw + 31); if (BAND) active = active && (Qw - (k0 + 63) <= u.W);
        if (!active) continue;
        const LAS unsigned char* kb = lds + bsel * SLOT;
        f32x16 p0, p1;
        if (BAND) {
#pragma unroll
            for (int r = 0; r < 16; ++r) { p0[r] = 0.f; p1[r] = 0.f; }
        } else { p0 = negm; p1 = negm; }
        __builtin_amdgcn_s_setprio(1);
#pragma unroll
        for (int d0 = 0; d0 < NDQ; ++d0) { const bf16x8 a0 = *(const LAS bf16x8*)(kb + koff + d0 * 2048), a1 = *(const LAS bf16x8*)(kb + koff + d0 * 2048 + 512);
            p0 = __builtin_amdgcn_mfma_f32_32x32x16_bf16(a0, qr[d0], p0, 0, 0, 0); p1 = __builtin_amdgcn_mfma_f32_32x32x16_bf16(a1, qr[d0], p1, 0, 0, 0); }
        __builtin_amdgcn_s_setprio(0);
        const int dbase = Qw + r32 - k0 - 4 * hi;
        float alpha = 1.f; float sacc = 0.f;
        if (BAND) {
#pragma unroll
            for (int r = 0; r < 16; ++r) { const int d0_ = dbase - ((r & 3) + 8 * (r >> 2)), d1_ = d0_ - 32;
                p0[r] = ((unsigned)d0_ <= (unsigned)u.W) ? p0[r] - u.alibi * (float)d0_ : -INFINITY;
                p1[r] = ((unsigned)d1_ <= (unsigned)u.W) ? p1[r] - u.alibi * (float)d1_ : -INFINITY; }
            const float rm = rowmax(p0, p1), m_new = __builtin_fmaxf(m_run, rm);
            alpha = __builtin_amdgcn_exp2f(m_run - m_new);
#pragma unroll
            for (int r = 0; r < 16; ++r) { o[0][r] *= alpha; o[1][r] *= alpha; }
            m_run = m_new;
#pragma unroll
            for (int r = 0; r < 16; ++r) { p0[r] = __builtin_amdgcn_exp2f(p0[r] - m_new); p1[r] = __builtin_amdgcn_exp2f(p1[r] - m_new); sacc += p0[r] + p1[r]; }
        } else {
            if (k0 + 63 > Qw) {
#pragma unroll
                for (int r = 0; r < 16; ++r) { const int d0_ = dbase - ((r & 3) + 8 * (r >> 2));
                    if (d0_ < 0) p0[r] = -INFINITY; if (d0_ < 32) p1[r] = -INFINITY; }
            }
            const float rm = rowmax(p0, p1);
            if (t == 0 || __any(rm > 8.0f)) {
                const float dl = (t == 0) ? rm : __builtin_fmaxf(rm, 0.f);
                alpha = __builtin_amdgcn_exp2f(-dl);
#pragma unroll
                for (int r = 0; r < 16; ++r) { p0[r] -= dl; p1[r] -= dl; negm[r] -= dl; }
                if (t != 0) {
#pragma unroll
                    for (int r = 0; r < 16; ++r) { o[0][r] *= alpha; o[1][r] *= alpha; }
                }
            }
#pragma unroll
            for (int r = 0; r < 16; ++r) { p0[r] = __builtin_amdgcn_exp2f(p0[r]); p1[r] = __builtin_amdgcn_exp2f(p1[r]); sacc += p0[r] + p1[r]; }
        }
        l_run = l_run * alpha + sacc;
        u32x4 pw[4];
#pragma unroll
        for (int j = 0; j < 4; ++j) { pw[0][j] = cvtpk(p0[2 * j], p0[2 * j + 1]); pw[1][j] = cvtpk(p0[8 + 2 * j], p0[9 + 2 * j]); pw[2][j] = cvtpk(p1[2 * j], p1[2 * j + 1]); pw[3][j] = cvtpk(p1[8 + 2 * j], p1[9 + 2 * j]); }
        const LAS unsigned char* vp = kb + voff;
        __builtin_amdgcn_s_setprio(1);
#pragma unroll
        for (int d0 = 0; d0 < 2; ++d0)
#pragma unroll
            for (int ks = 0; ks < 4; ++ks) { const s16x4 lo = vtr(vp + d0 * 4096 + ks * 1024), hh = vtr(vp + d0 * 4096 + ks * 1024 + 512);
                const bf16x8 vf = (bf16x8){lo[0], lo[1], lo[2], lo[3], hh[0], hh[1], hh[2], hh[3]};
                o[d0] = __builtin_amdgcn_mfma_f32_32x32x16_bf16(vf, __builtin_bit_cast(bf16x8, pw[ks]), o[d0], 0, 0, 0); }
        __builtin_amdgcn_s_setprio(0);
    }
#undef ATT_DMA
    { auto rr = __builtin_amdgcn_permlane32_swap(__float_as_uint(l_run), __float_as_uint(l_run), false, false); l_run = __uint_as_float(rr[0]) + __uint_as_float(rr[1]); }
    if (BAND) { if (u.has_sink) l_run += __builtin_amdgcn_exp2f(u.sink - m_run);
                if (u.has_lse) { if (hi == 0) u.lse[(long)(32 * w + r32) * u.lsestride] = m_run + __builtin_amdgcn_logf(l_run); } }
    att_store_ot(o, __builtin_amdgcn_rcpf(l_run), (LAS bf16_t*)(lds + LDS_OST) + w * 2304, u.o + (long)(32 * w) * u.ostride, u.ostride, lane);
    __syncthreads();
}

constexpr int P_LDS_WS = 3 * SLOT, P_LDS_OST = P_LDS_WS + 8 * 256, P_LDS_BYTES = P_LDS_OST + 8 * 4608;
template <int NDQ, bool FOX>
__device__ __forceinline__ void attn_unit_causal(const UnitDesc& u, LAS unsigned char* lds, const int tid) {
    const int lane = tid & 63, r32 = lane & 31, hi = lane >> 5; const int w = __builtin_amdgcn_readfirstlane(tid >> 6);
    const int q0 = u.q0, Qw = q0 + 32 * w, t_hi = (q0 + 255) >> 6, tl = (Qw + 31) >> 6;
    LAS float* wsf = (LAS float*)(lds + P_LDS_WS) + w * 64;
    const unsigned kvo = (unsigned)(lane * (int)u.kstride + w * 8) * 2u, kxo = (unsigned)(lane * (int)u.kxstride + (NDQ == 6 ? (w & 3) * 8 : 0)) * 2u;
    const unsigned vvo = (unsigned)((16 * (w & 3) + (lane >> 2)) * (int)u.kstride + (w >> 2) * 32 + (lane & 3) * 8) * 2u;
    const unsigned ldsb = (unsigned)(uintptr_t)lds + (unsigned)w * 1024u;
#define ATT_DMA(t, slot) do { const unsigned kb_ = ldsb + (unsigned)((slot) * SLOT); \
        pg8::glds_s((const char*)(u.k + (long)(t) * 64 * u.kstride), kvo, kb_); \
        if (w < 2 * (NDQ - 4)) pg8::glds_s((const char*)(u.kx + (long)(t) * 64 * u.kxstride), kxo, kb_ + 8192u); \
        pg8::glds_s((const char*)(u.v + (long)(t) * 64 * u.kstride), vvo, kb_ + (unsigned)SLOT_K); } while (0)
    ATT_DMA(0, 0);
    bf16x8 qr[NDQ];
    { const bf16_t* Qw_ = u.q + (long)(32 * w + r32) * u.qstride + hi * 8;
#pragma unroll
      for (int d0 = 0; d0 < (FOX ? 4 : NDQ); ++d0) qr[d0] = *(const bf16x8*)(Qw_ + d0 * 16);
      if (FOX) { const short one = hi ? (short)0 : (short)0x3F80; qr[NDQ - 1] = (bf16x8){one, one, one, 0, 0, 0, 0, 0}; } }
    float m_ref = -1e30f; f32x16 o[2]; float l_run = 0.f; o[0] = f32x16{}; o[1] = f32x16{};
    constexpr float THR = 30.f;
    const int koff = hi * 1024 + r32 * 16;
    const int voff = SLOT_K + ((lane >> 4) & 1) * 32 + (lane & 3) * 8 + (4 * hi + ((lane & 15) >> 2)) * 64;
    const int dq = r32 - 4 * hi;
#define ATT_KF(kbp, d0, n) (*(const LAS bf16x8*)((kbp) + koff + (d0) * 2048 + (n) * 512))
#define ATT_MASK(P0, P1, t) do { const int db_ = Qw + dq - 64 * (t); _Pragma("unroll") for (int r = 0; r < 16; ++r) { const int d_ = db_ - ((r & 3) + 8 * (r >> 2)); if (d_ < 0) P0[r] = -INFINITY; if (d_ < 32) P1[r] = -INFINITY; } } while (0)
#define ATT_SB() __builtin_amdgcn_sched_barrier(0)
#define ATT_PIN8(X0, X1, b) asm volatile("" : "+v"(X0[b]), "+v"(X0[b + 1]), "+v"(X0[b + 2]), "+v"(X0[b + 3]), "+v"(X1[b]), "+v"(X1[b + 1]), "+v"(X1[b + 2]), "+v"(X1[b + 3]))
    asm volatile("s_waitcnt vmcnt(0)" ::: "memory"); __syncthreads();
    if (t_hi >= 1) ATT_DMA(1, 1);
    f32x16 sa0 = f32x16{}, sa1 = f32x16{}, sb0, sb1;
    { const LAS unsigned char* kb = lds;
#pragma unroll
      for (int d0 = 0; d0 < NDQ; ++d0) { sa0 = __builtin_amdgcn_mfma_f32_32x32x16_bf16(ATT_KF(kb, d0, 0), qr[d0], sa0, 0, 0, 0); sa1 = __builtin_amdgcn_mfma_f32_32x32x16_bf16(ATT_KF(kb, d0, 1), qr[d0], sa1, 0, 0, 0); }
      if (tl == 0) ATT_MASK(sa0, sa1, 0); }
    int slot = 0, t = 0;
#define ATT_STEP(C0, C1, N0, N1) do { \
        const int slot1 = slot == 2 ? 0 : slot + 1, slot2 = slot1 == 2 ? 0 : slot1 + 1; \
        asm volatile("s_waitcnt vmcnt(0)" ::: "memory");                 \
        __syncthreads();                                                 \
        if (t + 2 <= t_hi) ATT_DMA(t + 2, slot2); \
        const LAS unsigned char* kbn = lds + slot1 * SLOT; const LAS unsigned char* vp = lds + slot * SLOT + voff; \
        { const float rm = rowmax(C0, C1); \
          if (__any(rm - m_ref > THR)) { const float m_new = __builtin_fmaxf(m_ref, rm), alpha = __builtin_amdgcn_exp2f(m_ref - m_new); m_ref = m_new; \
            _Pragma("unroll") for (int r = 0; r < 16; ++r) { o[0][r] *= alpha; o[1][r] *= alpha; } l_run *= alpha; } } \
        float sacc = 0.f; u32x4 pw[4]; \
        N0 = f32x16{}; N1 = f32x16{}; \
        { bf16x8 ka = ATT_KF(kbn, 0, 0), kb2 = ATT_KF(kbn, 0, 1); \
          _Pragma("unroll") for (int d0 = 0; d0 < NDQ; ++d0) { \
            bf16x8 na = ka, nb = kb2; if (d0 + 1 < NDQ) { na = ATT_KF(kbn, d0 + 1, 0); nb = ATT_KF(kbn, d0 + 1, 1); } \
            if (d0 < 4) { ATT_PIN8(C0, C1, 4 * d0); } \
            N0 = __builtin_amdgcn_mfma_f32_32x32x16_bf16(ka, qr[d0], N0, 0, 0, 0); N1 = __builtin_amdgcn_mfma_f32_32x32x16_bf16(kb2, qr[d0], N1, 0, 0, 0); \
            if (d0 < 4) { \
                _Pragma("unroll") for (int r = 4 * d0; r < 4 * d0 + 4; ++r) { C0[r] = __builtin_amdgcn_exp2f(C0[r] - m_ref); C1[r] = __builtin_amdgcn_exp2f(C1[r] - m_ref); sacc += C0[r] + C1[r]; } \
                ATT_PIN8(C0, C1, 4 * d0); asm volatile("" : "+v"(sacc)); } \
            ka = na; kb2 = nb; ATT_SB(); } } \
        l_run += sacc; \
        _Pragma("unroll") for (int j = 0; j < 4; ++j) { pw[0][j] = cvtpk(C0[2 * j], C0[2 * j + 1]); pw[1][j] = cvtpk(C0[8 + 2 * j], C0[9 + 2 * j]); pw[2][j] = cvtpk(C1[2 * j], C1[2 * j + 1]); pw[3][j] = cvtpk(C1[8 + 2 * j], C1[9 + 2 * j]); } \
        __builtin_amdgcn_s_setprio(1); \
        _Pragma("unroll") for (int ks = 0; ks < 4; ++ks) _Pragma("unroll") for (int d0 = 0; d0 < 2; ++d0) { const s16x4 lo = vtr(vp + d0 * 4096 + ks * 1024), hh = vtr(vp + d0 * 4096 + ks * 1024 + 512); \
                const bf16x8 vf = (bf16x8){lo[0], lo[1], lo[2], lo[3], hh[0], hh[1], hh[2], hh[3]}; \
                o[d0] = __builtin_amdgcn_mfma_f32_32x32x16_bf16(vf, __builtin_bit_cast(bf16x8, pw[ks]), o[d0], 0, 0, 0); \
                if (d0 == 1 && (ks & 1)) ATT_SB(); } \
        __builtin_amdgcn_s_setprio(0); \
        if (t + 1 == tl) ATT_MASK(N0, N1, t + 1); \
        slot = slot1; ++t; } while (0)
    for (; t + 1 <= tl; ) { ATT_STEP(sa0, sa1, sb0, sb1); ATT_STEP(sb0, sb1, sa0, sa1); }
    if (t <= tl) ATT_STEP(sa0, sa1, sb0, sb1);
    for (; t <= t_hi; ++t) { const int slot1 = slot == 2 ? 0 : slot + 1, slot2 = slot1 == 2 ? 0 : slot1 + 1;
        asm volatile("s_waitcnt vmcnt(0)" ::: "memory"); __syncthreads();
        if (t + 2 <= t_hi) ATT_DMA(t + 2, slot2);
        slot = slot1; }
#undef ATT_STEP
#undef ATT_DMA
#undef ATT_KF
#undef ATT_MASK
#undef ATT_SB
#undef ATT_PIN8
    { auto rr = __builtin_amdgcn_permlane32_swap(__float_as_uint(l_run), __float_as_uint(l_run), false, false); l_run = __uint_as_float(rr[0]) + __uint_as_float(rr[1]); }
    att_store_ot(o, __builtin_amdgcn_rcpf(l_run), (LAS bf16_t*)(lds + P_LDS_OST) + w * 2304, u.o + (long)(32 * w) * u.ostride, u.ostride, lane);
    __syncthreads();
}
}
namespace mk {
constexpr int NWAVES = 8, NTHREADS = 512;
constexpr int RING_BYTES = 131072, MISC_OFF = RING_BYTES, LDS_BYTES = 147456;
constexpr int MISC_PRE = MISC_OFF + 1024, MISC_CNT = MISC_PRE + 512, MISC_STASH = MISC_OFF + 2048;
constexpr int NPHASE = 17;
#define LDS_WAIT() asm volatile("s_waitcnt lgkmcnt(0)" ::: "memory")

struct Args { const float* in[21]; float* out; unsigned char* ws; float* H; int ph_lo, ph_hi; int use_bar, pad; };

typedef const __attribute__((address_space(4))) Args* cargs_t;
__device__ __forceinline__ Args load_args() {
#if defined(__HIP_DEVICE_COMPILE__)
    cargs_t p = (cargs_t)__builtin_amdgcn_kernarg_segment_ptr(); asm volatile("" : "+s"(p)); Args a;
#pragma unroll
    for (int i = 0; i < 21; ++i) a.in[i] = p->in[i];
    a.out = p->out; a.ws = p->ws; a.H = p->H; a.ph_lo = p->ph_lo; a.ph_hi = p->ph_hi; a.use_bar = p->use_bar; a.pad = 0; return a;
#else
    return Args{};
#endif
}

#define XB_TMO      128
#define XB_XCNT(j)  (256  + 64 * (j))
#define XB_XSUB(j)  (1280 + 64 * (j))
#define XB_XGEN(j)  (2304 + 64 * (j))
#define XB_TOP      3328
#define XB_TOPGEN   3392
#define XCD_BAR_WORDS 3456
#define XB_SPIN_CAP (1u << 18)
__device__ __forceinline__ unsigned xb_ld(unsigned* p)              { return __hip_atomic_load(p, __ATOMIC_RELAXED, __HIP_MEMORY_SCOPE_AGENT); }
__device__ __forceinline__ unsigned xb_add(unsigned* p, unsigned v) { return __hip_atomic_fetch_add(p, v, __ATOMIC_RELAXED, __HIP_MEMORY_SCOPE_AGENT); }
__device__ __forceinline__ unsigned xb_xcc_id() { return (unsigned)__builtin_amdgcn_s_getreg((3 << 11) | 20) & 0xFu; }
#define XB_SPIN(cond, bar) do { unsigned _sp = 0; while (cond) { __builtin_amdgcn_s_sleep(1); \
    if ((++_sp & 255u) == 0u) { if (xb_ld(&(bar)[XB_TMO])) break; if (_sp > XB_SPIN_CAP) { atomicAdd(&(bar)[XB_TMO], 1u); break; } } } } while (0)
struct XcdBarrier { unsigned* bar; unsigned x; volatile LAS unsigned* st; };
__device__ __forceinline__ XcdBarrier xcd_barrier_post(unsigned* bar, volatile LAS unsigned* st) {
    XcdBarrier b; b.bar = bar; b.x = xb_xcc_id(); b.st = st;
    if (threadIdx.x == 0) (void)xb_add(&bar[XB_XCNT(b.x)], 1u);
    return b;
}
__device__ __forceinline__ void xcd_barrier_complete(unsigned* bar, unsigned x, unsigned& nloc, unsigned& nx) {
    const unsigned G = gridDim.x * gridDim.y * gridDim.z;
    unsigned sum, cnt, mine, sp = 0u;
    for (;;) {
        sum = 0u; cnt = 0u; mine = 0u;
#pragma unroll
        for (unsigned j = 0; j < 16; ++j) { const unsigned c = xb_ld(&bar[XB_XCNT(j)]); sum += c; cnt += (c > 0u) ? 1u : 0u; mine = (j == x) ? c : mine; }
        if (sum == G) break;
        __builtin_amdgcn_s_sleep(1);
        if ((++sp & 255u) == 0u) { if (xb_ld(&bar[XB_TMO])) break; if (sp > XB_SPIN_CAP) { atomicAdd(&bar[XB_TMO], 1u); break; } }
    }
    nloc = mine > 0u ? mine : 1u; nx = cnt > 0u ? cnt : 1u;
}
__device__ __forceinline__ void xcd_barrier(const XcdBarrier& b) {
    asm volatile("s_waitcnt vmcnt(0)" ::: "memory");
    __syncthreads();
    if (threadIdx.x == 0) {
        unsigned* bar = b.bar;
        __builtin_amdgcn_s_waitcnt(0);
        unsigned nloc = b.st[0], nx = b.st[1];
        if (nloc == 0u) { xcd_barrier_complete(bar, b.x, nloc, nx); b.st[0] = nloc; b.st[1] = nx; }
        const unsigned old = xb_add(&bar[XB_XSUB(b.x)], 1u);
        const unsigned gen = old / nloc;
        if (old + 1u == (gen + 1u) * nloc) {
            __builtin_amdgcn_fence(__ATOMIC_RELEASE, "agent");
            asm volatile("s_waitcnt vmcnt(0)" ::: "memory");
            const unsigned og = xb_add(&bar[XB_TOP], 1u);
            const unsigned tg = og / nx;
            if (og + 1u == (tg + 1u) * nx) xb_add(&bar[XB_TOPGEN], 1u);
            else XB_SPIN(xb_ld(&bar[XB_TOPGEN]) == tg, bar);
            __builtin_amdgcn_fence(__ATOMIC_ACQUIRE, "agent");
            xb_add(&bar[XB_XGEN(b.x)], 1u);
            asm volatile("s_waitcnt vmcnt(0)" ::: "memory");
        } else {
            XB_SPIN(xb_ld(&bar[XB_XGEN(b.x)]) == gen, bar);
            __builtin_amdgcn_fence(__ATOMIC_ACQUIRE, "agent");
            asm volatile("s_waitcnt vmcnt(0)" ::: "memory");
        }
    }
    __syncthreads();
}
constexpr int MISC_BAR = MISC_OFF + 64;
__device__ __forceinline__ void grid_barrier(const Args& a, LAS unsigned char* lds) {
    XcdBarrier b; b.bar = (unsigned*)(a.ws + WS_CTL) + CW_BAR; b.x = xb_xcc_id(); b.st = (volatile LAS unsigned*)(lds + MISC_BAR);
    xcd_barrier(b);
}
__device__ __forceinline__ float wave_sum(float v) {
#pragma unroll
    for (int o = 1; o < 64; o <<= 1) v += __shfl_xor(v, o);
    return v;
}
__device__ __forceinline__ void tr_item(const float* src, int lds_, int ncols, const float* scale, bf16_t* dst, int ldd, LAS float* scr, int lane) {
    float v[32]; const int c0 = lane & 31, kh = lane >> 5;
#pragma unroll
    for (int i = 0; i < 32; ++i) v[i] = (src && c0 < ncols) ? src[(size_t)(2 * i + kh) * lds_ + c0] : 0.f;
    const int c = lane & 7; f32x4 s0 = (f32x4){1.f, 1.f, 1.f, 1.f}, s1 = s0;
    if (scale) { s0 = *(const f32x4*)(scale + 8 * c); s1 = *(const f32x4*)(scale + 8 * c + 4); }
#pragma unroll
    for (int i = 0; i < 32; ++i) scr[(2 * i + kh) * 33 + c0] = v[i];
    LDS_WAIT(); asm volatile("" ::: "memory");
#pragma unroll
    for (int j = 0; j < 4; ++j) { const int n = (lane >> 3) + 8 * j; const LAS float* s = scr + (8 * c) * 33 + n;
        u32x4 o; o.x = cvtpk(s[0 * 33] * s0[0], s[1 * 33] * s0[1]); o.y = cvtpk(s[2 * 33] * s0[2], s[3 * 33] * s0[3]); o.z = cvtpk(s[4 * 33] * s1[0], s[5 * 33] * s1[1]); o.w = cvtpk(s[6 * 33] * s1[2], s[7 * 33] * s1[3]);
        st16s(dst + (size_t)n * ldd + 8 * c, 0, o); }
    LDS_WAIT(); asm volatile("" ::: "memory");
}
struct TrMat { const float* W; int K, ldw; const float* scale; bf16_t* WT; int nblk; int kind; };
__device__ __forceinline__ int tr_srccol(int kind, int n0) {
    switch (kind) {
    case 0: return n0;
    case 1: return n0 < 1536 ? n0 : n0 + 8;
    case 2: return n0 < 384 ? n0 : (n0 < 416 ? n0 + 256 : (n0 < 512 ? -1 : (n0 < 768 ? n0 - 128 : n0 - 96)));
    default: return n0; }
}
__device__ __forceinline__ void tr_mat_item(const TrMat& m, int item, LAS float* scr, int lane) {
    const int kb = item / m.nblk, nb = item % m.nblk, k0 = 64 * kb, n0 = 32 * nb; const int sc = tr_srccol(m.kind, n0);
    tr_item(sc < 0 ? nullptr : m.W + (size_t)k0 * m.ldw + sc, m.ldw, 32, m.scale ? m.scale + k0 : nullptr, m.WT + (size_t)n0 * m.K + k0, m.K, scr, lane);
}

__device__ __forceinline__ void dense_mats(const Args& a, TrMat (&M)[6]) {
    unsigned char* ws = a.ws; const float* attn_norm = a.in[1];
    M[0] = TrMat{a.in[4], 1024, 3080, attn_norm, (bf16_t*)(ws + WS_WIN0), 96, 1};
    M[1] = TrMat{a.in[6], 1024, 1024, nullptr, (bf16_t*)(ws + WS_WOUT0), 32, 0};
    M[2] = TrMat{a.in[7], 1024, 1440, attn_norm + 1024, (bf16_t*)(ws + WS_WIN1), 48, 2};
    M[3] = TrMat{a.in[10], 384, 768, a.in[8], (bf16_t*)(ws + WS_WUQ), 24, 0};
    M[4] = TrMat{a.in[11], 256, 1024, a.in[9], (bf16_t*)(ws + WS_WUKV), 32, 0};
    M[5] = TrMat{a.in[13], 1024, 1024, nullptr, (bf16_t*)(ws + WS_WOUT1), 32, 0};
}
__device__ __forceinline__ void router_item(const Args& a, int it, LAS float* scr, int lane) {
    const float* ffn_norm = a.in[2]; const int l = it >> 5, r = it & 31, kb = r >> 1, nb = r & 1, k0 = 64 * kb;
    bf16_t* dst = (bf16_t*)(a.ws + WS_WR) + (size_t)l * 64 * 1024 + (size_t)(32 * nb) * 1024 + k0;
    if (nb == 0) tr_item(a.in[16] + (size_t)l * 1024 * 32 + (size_t)k0 * 32, 32, 32, ffn_norm + l * 1024 + k0, dst, 1024, scr, lane);
    else tr_item(a.in[14] + (size_t)l * 1024 * 4 + (size_t)k0 * 4, 4, 4, ffn_norm + l * 1024 + k0, dst, 1024, scr, lane);
}
template <int PART>
__device__ __forceinline__ void p0_prologue(const Args& a, LAS unsigned char* lds, int gw, int NGW, int wave, int lane) {
    unsigned char* ws = a.ws; LAS float* scr = (LAS float*)(lds + wave * 16384);
    const float* attn_norm = a.in[1];
    TrMat M[6]; dense_mats(a, M);
    const int cnt[6] = {16 * 96, 16 * 32, 16 * 48, 6 * 24, 4 * 32, 16 * 32};
    int base = 0;
#pragma unroll
    for (int mi = 0; mi < 6; ++mi) { if ((mi == 0) == (PART == 0)) { for (int it = (gw + NGW - base % NGW) % NGW; it < cnt[mi]; it += NGW) tr_mat_item(M[mi], it, scr, lane); base += cnt[mi]; } }
    if (PART == 1) for (int it = gw; it < 64; it += NGW) router_item(a, it, scr, lane);
    if (PART == 1) { f32x2* rope = (f32x2*)(ws + WS_ROPE);
      for (int i = gw * 64 + lane; i < S * 16; i += NGW * 64) { const int pos = i >> 4, j = i & 15; const float inv = powf(10000.0f, -(float)(2 * j) / 32.0f), ang = (float)pos * inv; float sn, cs; sincosf(ang, &sn, &cs); rope[i] = (f32x2){cs, sn}; } }
    if (PART == 0) { const float* x = a.in[0]; const float* win = a.in[4]; const float* bfp = a.in[5];
      bf16_t* XB = (bf16_t*)(ws + WS_XB); float* SS = (float*)(ws + WS_SS); float* LOGF = (float*)(ws + WS_LOGF);
      float wz[4][4][8];
#pragma unroll
      for (int j = 0; j < 4; ++j)
#pragma unroll
          for (int e = 0; e < 4; ++e) { const int k = 256 * j + 4 * lane + e; const float g = attn_norm[k]; const f32x4 w0 = *(const f32x4*)(win + (size_t)k * 3080 + 1536), w1 = *(const f32x4*)(win + (size_t)k * 3080 + 1540);
#pragma unroll
              for (int h = 0; h < 4; ++h) { wz[j][e][h] = w0[h] * g; wz[j][e][4 + h] = w1[h] * g; } }
      for (int row = gw; row < N; row += NGW) {
          const f32x4* xr = (const f32x4*)(x + (size_t)row * D) + lane; f32x4 v[4]; float ssq = 0.f; float zf[8];
#pragma unroll
          for (int h = 0; h < 8; ++h) zf[h] = 0.f;
#pragma unroll
          for (int j = 0; j < 4; ++j) { v[j] = xr[64 * j]; ssq += (v[j][0] * v[j][0] + v[j][1] * v[j][1]) + (v[j][2] * v[j][2] + v[j][3] * v[j][3]);
#pragma unroll
              for (int e = 0; e < 4; ++e)
#pragma unroll
                  for (int h = 0; h < 8; ++h) zf[h] += v[j][e] * wz[j][e][h]; }
          ssq = wave_sum(ssq);
#pragma unroll
          for (int h = 0; h < 8; ++h) zf[h] = wave_sum(zf[h]);
          u32x2* o8 = (u32x2*)(XB + (size_t)row * D) + lane;
#pragma unroll
          for (int j = 0; j < 4; ++j) { u32x2 wv; wv.x = cvtpk(v[j][0], v[j][1]); wv.y = cvtpk(v[j][2], v[j][3]); st8s(o8, 512 * j, wv); }
          if (lane == 0) SS[row] = ssq;
          const float rstd = 1.f / sqrtf(ssq * (1.f / D) + EPS);
          float zsel = zf[0];
#pragma unroll
          for (int h = 1; h < 8; ++h) zsel = (lane == h) ? zf[h] : zsel;
          if (lane < 8) { const float xg = zsel * rstd + bfp[lane]; LOGF[(size_t)row * 8 + lane] = fminf(xg, 0.f) - log1pf(expf(-fabsf(xg))); }
      } }
}
__device__ __forceinline__ void fox_cumsum(const Args& a, LAS unsigned char* lds, int G, const int tid) {
    const float* LOGF = (const float*)(a.ws + WS_LOGF); float* KB = (float*)(a.ws + WS_CB2); u32x4* KX = (u32x4*)(a.ws + WS_KEXT); LAS float* part = (LAS float*)lds;
    const int t = tid, lane = t & 63, wv = t >> 6;
    for (int bh = blockIdx.x; bh < 32; bh += G) { const int b = bh >> 3, h = bh & 7; float loc[8]; float run = 0.f;
#pragma unroll
        for (int i = 0; i < 8; ++i) { run += LOGF[(size_t)(b * S + t * 8 + i) * 8 + h]; loc[i] = run; }
        float inc = run;
#pragma unroll
        for (int o = 1; o < 64; o <<= 1) { const float up = __shfl_up(inc, o); if (lane >= o) inc += up; }
        __syncthreads();
        if (lane == 63) part[wv] = inc;
        __syncthreads();
        float off = inc - run;
        for (int i = 0; i < wv; ++i) off += part[i];
#pragma unroll
        for (int i = 0; i < 8; ++i) { const float kb = -LOG2E * (loc[i] + off); KB[(size_t)bh * S + t * 8 + i] = kb;
            const unsigned h1 = cvtpk(kb, 0.f) & 0xffffu; const float r1 = kb - bflo(h1); const unsigned h2 = cvtpk(r1, 0.f) & 0xffffu; const float r2 = r1 - bflo(h2); const unsigned h3 = cvtpk(r2, 0.f) & 0xffffu;
            KX[(size_t)bh * S + t * 8 + i] = (u32x4){h1 | (h2 << 16), h3, 0u, 0u}; }
    }
    __syncthreads();
}
__device__ __forceinline__ void attn_phase0(const Args& a, LAS unsigned char* lds, int vcu, int G, const int tid) {
    const bf16_t* QKV = (const bf16_t*)(a.ws + R1_QKV0); bf16_t* AO = (bf16_t*)(a.ws + R2_AO); bf16_t* DP = (bf16_t*)(a.ws + R2_DPART);
    float* DLSE = (float*)(a.ws + WS_DLSE); const float* KB = (const float*)(a.ws + WS_CB2);
    for (int it = vcu; it < 256 + 1536; it += G) {
        if (it < 256) { const int bh = it >> 3, s = it & 7, b = bh >> 3, h = bh & 7;
            for (int half = 0; half < 2; ++half) { const int qb = half ? 15 - s : s; att::UnitDesc u{};
                const bf16_t* base = QKV + (size_t)b * S * 3072 + h * 64;
                u.q = base + (size_t)(qb * 256) * 3072; u.qstride = 3072; u.k = base + 512; u.v = base + 1024; u.kstride = 3072;
                u.o = AO + (size_t)(b * S + qb * 256) * 1024 + h * 64; u.ostride = 1024; u.kbias = KB + (size_t)bh * S; u.kx = (const bf16_t*)(a.ws + WS_KEXT) + (size_t)bh * S * 8; u.kxstride = 8; u.q0 = qb * 256; u.W = 1 << 30;
                { int tid_ = tid; asm volatile("" : "+v"(tid_)); att::attn_unit_causal<5, true>(u, lds, tid_); } }
        } else { const int j = it - 256, bh = j / 48, rem = j % 48, br = rem >> 4, idx = rem & 15, b = bh >> 3, h = bh & 7;
            const int dil = br == 0 ? 1 : (br == 1 ? 4 : 16), c = br == 0 ? 0 : (br == 1 ? idx >> 2 : idx), qblk = br == 0 ? idx : (br == 1 ? idx & 3 : 0);
            att::UnitDesc u{}; const bf16_t* base = QKV + (size_t)(b * S + c) * 3072 + 1536 + h * 64; const long st = (long)dil * 3072;
            u.q = base + (size_t)(qblk * 256) * st; u.qstride = st; u.k = base + 512; u.v = base + 1024; u.kstride = st;
            const size_t tok0 = (size_t)b * S + c + (size_t)qblk * 256 * dil;
            u.o = DP + (size_t)br * N * 512 + tok0 * 512 + h * 64; u.ostride = (long)dil * 512;
            u.lse = DLSE + (size_t)br * N * 8 + tok0 * 8 + h; u.lsestride = (long)dil * 8; u.has_lse = true;
            u.q0 = qblk * 256; u.W = 128; u.alibi = exp2f(-(float)(h + 1)) * (float)dil * LOG2E;
            { int tid_ = tid; asm volatile("" : "+v"(tid_)); att::attn_unit<4, false, true>(u, lds, tid_); } }
    }
}
__device__ __forceinline__ void attn_phase1(const Args& a, LAS unsigned char* lds, int vcu, int G, const int tid) {
    const bf16_t* Z1 = (const bf16_t*)(a.ws + R1_Z1); const bf16_t* Q1 = (const bf16_t*)(a.ws + R1_Q1); const bf16_t* KV = (const bf16_t*)(a.ws + R1_KV1);
    bf16_t* AO = (bf16_t*)(a.ws + R2_AO); const float* sinks = a.in[12];
    for (int it = vcu; it < 256 + 512; it += G) {
        if (it < 256) { const int bh = it >> 3, s = it & 7, b = bh >> 3, h = bh & 7;
            for (int half = 0; half < 2; ++half) { const int qb = half ? 15 - s : s; att::UnitDesc u{};
                u.q = Q1 + (size_t)(b * S + qb * 256) * 768 + h * 96; u.qstride = 768;
                u.k = KV + (size_t)b * S * 1024 + h * 128; u.v = u.k + 64; u.kstride = 1024; u.kx = Z1 + (size_t)b * S * 1536 + 384; u.kxstride = 1536;
                u.o = AO + (size_t)(b * S + qb * 256) * 1024 + h * 64; u.ostride = 1024; u.q0 = qb * 256; u.W = 1 << 30;
                { int tid_ = tid; asm volatile("" : "+v"(tid_)); att::attn_unit_causal<6, false>(u, lds, tid_); } }
        } else { const int j = it - 256, b = j >> 7, hq = (j >> 4) & 7, qb = j & 15, kvh = hq >> 2; att::UnitDesc u{};
            const bf16_t* base = Z1 + (size_t)b * S * 1536;
            u.q = base + (size_t)(qb * 256) * 1536 + 768 + hq * 64; u.qstride = 1536; u.k = base + 1280 + kvh * 64; u.v = base + 1408 + kvh * 64; u.kstride = 1536;
            u.o = AO + (size_t)(b * S + qb * 256) * 1024 + 512 + hq * 64; u.ostride = 1024; u.q0 = qb * 256; u.W = 127;
            u.alibi = exp2f(-(float)(hq + 1)) * LOG2E; u.has_sink = true; u.sink = sinks[hq] * LOG2E;
            { int tid_ = tid; asm volatile("" : "+v"(tid_)); att::attn_unit<4, false, true>(u, lds, tid_); } }
    }
}
__device__ __forceinline__ void merge_phase(const Args& a, int gw, int NGW, int lane) {
    const bf16_t* DP = (const bf16_t*)(a.ws + R2_DPART); const float* DLSE = (const float*)(a.ws + WS_DLSE); bf16_t* AO = (bf16_t*)(a.ws + R2_AO);
    for (int tok = gw; tok < N; tok += NGW) { const int h = lane >> 3;
        const float l0 = DLSE[(size_t)tok * 8 + h], l1 = DLSE[(size_t)N * 8 + (size_t)tok * 8 + h], l2 = DLSE[(size_t)2 * N * 8 + (size_t)tok * 8 + h];
        const float mx = fmaxf(l0, fmaxf(l1, l2)); float w0 = exp2f(l0 - mx), w1 = exp2f(l1 - mx), w2 = exp2f(l2 - mx); const float inv = 1.f / (w0 + w1 + w2); w0 *= inv; w1 *= inv; w2 *= inv;
        const u32x4 a0 = *(const u32x4*)(DP + (size_t)tok * 512 + lane * 8), a1 = *(const u32x4*)(DP + (size_t)N * 512 + (size_t)tok * 512 + lane * 8), a2 = *(const u32x4*)(DP + (size_t)2 * N * 512 + (size_t)tok * 512 + lane * 8);
        u32x4 o;
#pragma unroll
        for (int i = 0; i < 4; ++i) { const float lo = w0 * bflo(a0[i]) + w1 * bflo(a1[i]) + w2 * bflo(a2[i]), hi = w0 * bfhi(a0[i]) + w1 * bfhi(a1[i]) + w2 * bfhi(a2[i]); o[i] = cvtpk(lo, hi); }
        st16s(AO + (size_t)tok * 1024 + 512 + lane * 8, 0, o); }
}
__device__ __forceinline__ void route_phase(const Args& a, int layer, LAS unsigned char* lds, int vcu, int G, int wave, int lane) {
    const bf16_t* HB = (const bf16_t*)(a.ws + WS_XB); const bf16_t* WR = (const bf16_t*)(a.ws + WS_WR) + (size_t)layer * 64 * 1024;
    const float* SSP = (const float*)(a.ws + WS_SSP); const float* bg = a.in[15] + layer * 4; const float* br = a.in[17] + layer * 32;
    unsigned* cnt = (unsigned*)(a.ws + WS_CTL) + CW_CNT + layer * 1024;
    unsigned* LT = (unsigned*)(a.ws + WS_LT); float* LW = (float*)(a.ws + WS_LW); float* LR = (float*)(a.ws + WS_LR);
    const int r32 = lane & 31, hi = lane >> 5, kq = wave & 3, half = wave >> 2;
    for (int b0 = vcu * 2; b0 < N / 32; b0 += G * 2) {
        const int blk = b0 + half; const bool live = blk < N / 32; const int tok = (live ? blk : 0) * 32 + r32;
        f32x16 c0 = f32x16{}, c1 = f32x16{}; int E_ = 0, myrank_ = 0, mycnt_ = 0; float wsel_ = 0.f, rstd_ = 0.f;
        const bf16_t* xb = HB + (size_t)tok * 1024 + kq * 256 + hi * 8; const bf16_t* wa = WR + (size_t)r32 * 1024 + kq * 256 + hi * 8;
        if (live) {
#pragma unroll 8
            for (int k0 = 0; k0 < 256; k0 += 16) { const bf16x8 bx = *(const bf16x8*)(xb + k0), a0 = *(const bf16x8*)(wa + k0), a1 = *(const bf16x8*)(wa + 32 * 1024 + k0);
                c0 = __builtin_amdgcn_mfma_f32_32x32x16_bf16(a0, bx, c0, 0, 0, 0); c1 = __builtin_amdgcn_mfma_f32_32x32x16_bf16(a1, bx, c1, 0, 0, 0); } }
        LAS f32x4* red = (LAS f32x4*)(lds + wave * 16384 + 9216) + lane * 5;
        if (kq != 0) { red[0] = (f32x4){c0[0], c0[1], c0[2], c0[3]}; red[1] = (f32x4){c0[4], c0[5], c0[6], c0[7]}; red[2] = (f32x4){c0[8], c0[9], c0[10], c0[11]}; red[3] = (f32x4){c0[12], c0[13], c0[14], c0[15]}; red[4] = (f32x4){c1[0], c1[1], c1[2], c1[3]}; }
        __syncthreads();
        if (kq == 0 && live) {
#pragma unroll
            for (int q = 1; q < 4; ++q) { const LAS f32x4* rq = (const LAS f32x4*)(lds + (wave + q) * 16384 + 9216) + lane * 5;
#pragma unroll
                for (int g = 0; g < 4; ++g) { const f32x4 t = rq[g]; c0[4 * g] += t[0]; c0[4 * g + 1] += t[1]; c0[4 * g + 2] += t[2]; c0[4 * g + 3] += t[3]; }
                const f32x4 t = rq[4]; c1[0] += t[0]; c1[1] += t[1]; c1[2] += t[2]; c1[3] += t[3]; }
            const f32x4* sp = (const f32x4*)(SSP + (size_t)tok * 16); const f32x4 s0 = sp[0], s1 = sp[1], s2 = sp[2], s3 = sp[3];
            const float ssq = ((s0[0] + s0[1]) + (s0[2] + s0[3])) + ((s1[0] + s1[1]) + (s1[2] + s1[3])) + ((s2[0] + s2[1]) + (s2[2] + s2[3])) + ((s3[0] + s3[1]) + (s3[2] + s3[3]));
            const float rstd = 1.f / sqrtf(ssq * (1.f / 1024.f) + EPS);
            float gl[4];
#pragma unroll
            for (int j = 0; j < 4; ++j) { const float mine = c1[j]; const float other = __shfl_xor(mine, 32); gl[j] = (hi == 0 ? mine : other) * rstd + bg[j]; }
            int gi = 0; float gm = gl[0];
#pragma unroll
            for (int j = 1; j < 4; ++j) if (gl[j] > gm) { gm = gl[j]; gi = j; }
            float den = 0.f;
#pragma unroll
            for (int j = 0; j < 4; ++j) den += __expf(gl[j] - gm);
            const float gwt = 1.f / den;
            float mine4[4];
#pragma unroll
            for (int j = 0; j < 4; ++j) { float v = c0[j]; v = (gi == 1) ? c0[4 + j] : v; v = (gi == 2) ? c0[8 + j] : v; v = (gi == 3) ? c0[12 + j] : v; mine4[j] = v; }
            float el[8];
#pragma unroll
            for (int j = 0; j < 4; ++j) { const float other = __shfl_xor(mine4[j], 32); el[j] = (hi == 0 ? mine4[j] : other); el[4 + j] = (hi == 0 ? other : mine4[j]); }
#pragma unroll
            for (int j = 0; j < 8; ++j) el[j] = el[j] * rstd + br[gi * 8 + j];
            int i1 = 0; float v1 = el[0];
#pragma unroll
            for (int j = 1; j < 8; ++j) if (el[j] > v1) { v1 = el[j]; i1 = j; }
            int i2 = -1; float v2 = -INFINITY;
#pragma unroll
            for (int j = 0; j < 8; ++j) if (j != i1 && el[j] > v2) { v2 = el[j]; i2 = j; }
            const float e2 = __expf(v2 - v1); const float w1 = gwt / (1.f + e2), w2 = gwt * e2 / (1.f + e2);
            const int E = gi * 8 + (hi == 0 ? i1 : i2); const float wsel = hi == 0 ? w1 : w2;
            int myrank = 0, mycnt = 0; const unsigned long long ltmask = (1ull << lane) - 1ull;
#pragma unroll 4
            for (int j = 0; j < 32; ++j) { const unsigned long long mj = __ballot(E == j); if (E == j) myrank = __popcll(mj & ltmask); if (lane == j) mycnt = __popcll(mj); }
            E_ = E; wsel_ = wsel; rstd_ = rstd; myrank_ = myrank; mycnt_ = mycnt;
        }
        LAS unsigned* ag = (LAS unsigned*)(lds + MISC_OFF + 256);
        if (kq == 0 && half == 1 && lane < 32) ag[lane] = live ? (unsigned)mycnt_ : 0u;
        __syncthreads();
        unsigned basev = 0;
        if (kq == 0 && half == 0 && lane < 32) { const unsigned mine = live ? (unsigned)mycnt_ : 0u, tot = mine + ag[lane];
            if (tot > 0u) basev = atomicAdd(cnt + lane * 16, tot);
            ag[32 + lane] = basev + mine; }
        __syncthreads();
        if (kq == 0 && live) {
            if (half == 1 && lane < 32) basev = ag[32 + lane];
            const unsigned base = (unsigned)__shfl((int)basev, E_);
            const size_t pos = (size_t)E_ * N + base + myrank_;
            LT[pos] = (unsigned)tok | ((unsigned)hi << 31); LW[pos] = wsel_; LR[pos] = rstd_;
        }
        __syncthreads();
    }
}
constexpr int MOE_CONV_ITEMS = 32 * 256 + 32 * 128;
struct TrDesc { const float* src; int lds_; const float* scale; bf16_t* dst; int ldd; };
__device__ __forceinline__ TrDesc moe_desc(const Args& a, int layer, int it) {
    const float* wg = a.in[18] + (size_t)layer * 32 * 1024 * 256; const float* wu = a.in[19] + (size_t)layer * 32 * 1024 * 256; const float* wd = a.in[20] + (size_t)layer * 32 * 256 * 1024;
    const float* g = a.in[2] + layer * 1024; bf16_t* WGU = (bf16_t*)(a.ws + (layer ? R2_WGU1 : R1_WGU)); bf16_t* WD = (bf16_t*)(a.ws + (layer ? R2_WD1 : R1_WD));
    if (it < 32 * 256) { const int e = it >> 8, r = it & 255, kb = r >> 4, nb = r & 15, k0 = 64 * kb, n0 = 32 * nb;
        const int t = n0 >> 8, s = (n0 >> 7) & 1, j = n0 & 127; const float* src = (s ? wu : wg) + (size_t)e * 1024 * 256 + (size_t)k0 * 256 + 128 * t + j;
        return TrDesc{src, 256, g + k0, WGU + ((size_t)e * 512 + n0) * 1024 + k0, 1024};
    } else { const int i2 = it - 32 * 256, e = i2 >> 7, r = i2 & 127, kb = r >> 5, nb = r & 31, k0 = 64 * kb, n0 = 32 * nb;
        return TrDesc{wd + (size_t)e * 256 * 1024 + (size_t)k0 * 1024 + n0, 1024, nullptr, WD + ((size_t)e * 1024 + n0) * 256 + k0, 256}; }
}
__device__ __forceinline__ void tr_load(const TrDesc& d, float (&v)[32], int lane) {
    const int c0 = lane & 31, kh = lane >> 5;
#pragma unroll
    for (int i = 0; i < 32; ++i) v[i] = d.src[(size_t)(2 * i + kh) * d.lds_ + c0];
}
__device__ __forceinline__ void tr_store(const TrDesc& d, const float (&v)[32], LAS float* scr, int lane) {
    const int c0 = lane & 31, kh = lane >> 5, c = lane & 7; f32x4 s0 = (f32x4){1.f, 1.f, 1.f, 1.f}, s1 = s0;
    if (d.scale) { s0 = *(const f32x4*)(d.scale + 8 * c); s1 = *(const f32x4*)(d.scale + 8 * c + 4); }
#pragma unroll
    for (int i = 0; i < 32; ++i) scr[(2 * i + kh) * 33 + c0] = v[i];
    LDS_WAIT(); asm volatile("" ::: "memory");
#pragma unroll
    for (int j = 0; j < 4; ++j) { const int n = (lane >> 3) + 8 * j; const LAS float* s = scr + (8 * c) * 33 + n;
        u32x4 o; o.x = cvtpk(s[0 * 33] * s0[0], s[1 * 33] * s0[1]); o.y = cvtpk(s[2 * 33] * s0[2], s[3 * 33] * s0[3]); o.z = cvtpk(s[4 * 33] * s1[0], s[5 * 33] * s1[1]); o.w = cvtpk(s[6 * 33] * s1[2], s[7 * 33] * s1[3]);
        st16s(d.dst + (size_t)n * d.ldd + 8 * c, 0, o); }
    LDS_WAIT(); asm volatile("" ::: "memory");
}
__device__ __forceinline__ void moe_convert(const Args& a, int layer, LAS unsigned char* lds, int gw, int NGW, int wave, int lane) {
    LAS float* scr = (LAS float*)(lds + wave * 16384);
    int it = gw; if (it >= MOE_CONV_ITEMS) return;
    TrDesc da = moe_desc(a, layer, it), db = da; float va[32], vb[32]; tr_load(da, va, lane);
    for (;;) {
        const int it2 = it + NGW; const bool h2 = it2 < MOE_CONV_ITEMS;
        if (h2) { db = moe_desc(a, layer, it2); tr_load(db, vb, lane); }
        tr_store(da, va, scr, lane); if (!h2) break;
        const int it3 = it2 + NGW; const bool h3 = it3 < MOE_CONV_ITEMS;
        if (h3) { da = moe_desc(a, layer, it3); tr_load(da, va, lane); }
        tr_store(db, vb, scr, lane); if (!h3) break;
        it = it3; }
}
__device__ __forceinline__ void combine_phase(const Args& a, bool last, int gw, int NGW, int lane) {
    const bf16_t* Y = (const bf16_t*)(a.ws + (last ? Y1_BASE : R2_Y)); bf16_t* XB = (bf16_t*)(a.ws + WS_XB); float* SS = (float*)(a.ws + WS_SS); const float* g = a.in[3];
    for (int row = gw; row < N; row += NGW) {
        u32x2* xr = (u32x2*)(XB + (size_t)row * D) + lane; const u32x2* y0 = (const u32x2*)(Y + (size_t)row * D) + lane; const u32x2* y1 = (const u32x2*)(Y + (size_t)N * D + (size_t)row * D) + lane;
        f32x4 v[4]; float ssq = 0.f; u32x2 hx[4], p[4], q[4];
#pragma unroll
        for (int j = 0; j < 4; ++j) { hx[j] = xr[64 * j]; p[j] = y0[64 * j]; q[j] = y1[64 * j]; }
#pragma unroll
        for (int j = 0; j < 4; ++j) {
            v[j][0] = bflo(hx[j].x) + bflo(p[j].x) + bflo(q[j].x); v[j][1] = bfhi(hx[j].x) + bfhi(p[j].x) + bfhi(q[j].x); v[j][2] = bflo(hx[j].y) + bflo(p[j].y) + bflo(q[j].y); v[j][3] = bfhi(hx[j].y) + bfhi(p[j].y) + bfhi(q[j].y);
            ssq += (v[j][0] * v[j][0] + v[j][1] * v[j][1]) + (v[j][2] * v[j][2] + v[j][3] * v[j][3]); }
        ssq = wave_sum(ssq);
        if (!last) {
#pragma unroll
            for (int j = 0; j < 4; ++j) { u32x2 wv; wv.x = cvtpk(v[j][0], v[j][1]); wv.y = cvtpk(v[j][2], v[j][3]); st8s(xr, 512 * j, wv); }
            if (lane == 0) SS[row] = ssq;
        } else { const float rstd = 1.f / sqrtf(ssq * (1.f / D) + EPS); f32x4* orow = (f32x4*)(a.out + (size_t)row * D) + lane;
#pragma unroll
            for (int j = 0; j < 4; ++j) { const f32x4 gg = ((const f32x4*)g)[lane + 64 * j]; st16fs(orow, 1024 * j, v[j] * rstd * gg); } }
    }
}
__device__ __forceinline__ void moe_tables(const Args& a, int layer, LAS unsigned char* lds, const int tid) {
    LAS int* pre = (LAS int*)(lds + MISC_PRE); LAS int* cn = (LAS int*)(lds + MISC_CNT);
    const unsigned* cnt = (const unsigned*)(a.ws + WS_CTL) + CW_CNT + layer * 1024;
    __syncthreads();
    if (tid < 64) {
        const int e = tid & 31; const int c = (int)__hip_atomic_load(cnt + e * 16, __ATOMIC_RELAXED, __HIP_MEMORY_SCOPE_AGENT);
        const int tiles = (c + 255) >> 8, full = c >> 8, tail = c & 255; int pt = tiles, pf = full;
#pragma unroll
        for (int o = 1; o < 32; o <<= 1) { const int ut = __shfl_up(pt, o, 32), uf = __shfl_up(pf, o, 32); if (e >= o) { pt += ut; pf += uf; } }
        int rank = 0, ntail = 0;
#pragma unroll 8
        for (int j = 0; j < 32; ++j) { const int tj = __shfl(tail, j, 32); ntail += tj ? 1 : 0; rank += (tj > tail || (tj == tail && j < e)) ? 1 : 0; }
        if (tid < 32) { cn[e] = c; pre[e] = pt - tiles; pre[40 + e] = pf - full; if (tail) pre[80 + rank] = e;
            if (e == 31) { pre[32] = pt; pre[72] = pf; pre[112] = ntail; } }
    }
    __syncthreads();
}

__global__ void __launch_bounds__(NTHREADS, 2) mega(Args args) {
    extern __shared__ __attribute__((aligned(16))) unsigned char lds_raw[];
    LAS unsigned char* lds = (LAS unsigned char*)lds_raw;
    const int G = gridDim.x;
    const int lo = args.ph_lo, hi = args.ph_hi;
    if (args.use_bar) { if (threadIdx.x < 2) ((volatile LAS unsigned*)(lds + MISC_BAR))[threadIdx.x] = 0u; __syncthreads();
        (void)xcd_barrier_post((unsigned*)(args.ws + WS_CTL) + CW_BAR, (volatile LAS unsigned*)(lds + MISC_BAR)); }
#define IN(k) (lo <= (k) && (k) < hi)
#define SEAM(k) do { if (IN(k) && IN((k) + 1)) { const Args ba_ = load_args(); grid_barrier(ba_, lds); } } while (0)
#define LA() const Args args = load_args(); unsigned char* ws = args.ws; (void)ws; int tid = threadIdx.x; asm volatile("" : "+v"(tid)); int bx = blockIdx.x; asm volatile("" : "+s"(bx)); \
    const int lane = tid & 63, wave = __builtin_amdgcn_readfirstlane(tid >> 6), vcu = (G % 8 == 0) ? (bx % 8) * (G / 8) + bx / 8 : bx, gw = vcu * NWAVES + wave, NGW = G * NWAVES; (void)lane; (void)gw; (void)NGW
    if (IN(0)) { LA(); p0_prologue<0>(args, lds, gw, NGW, wave, lane); }
    SEAM(0);
    if (IN(1)) {
#pragma nounroll
        for (int pass = 0; pass < 2; ++pass) {
            { LA(); const int nfc = G > 64 ? 32 : 0;
              if (pass == (vcu & 1) && bx >= nfc) { __syncthreads(); p0_prologue<1>(args, lds, (bx - nfc) * NWAVES + wave, (G - nfc) * NWAVES, wave, lane); __syncthreads(); } }
            if (pass == 0) { LA(); fox_cumsum(args, lds, G, tid);
                pg8::Dense P; P.init((const bf16_t*)(ws + WS_XB), 1024, (const bf16_t*)(ws + WS_WIN0), N, 3072, 1024, G, bx);
                pg8::EpiQkv0 E{(bf16_t*)(ws + R1_QKV0), (const float*)(ws + WS_SS)};
                pg8::gemm_phase<pg8::EpiQkv0, pg8::Dense, false>(lds, P, E, tid); }
        }
    }
    SEAM(1);
    if (IN(2)) { LA(); attn_phase0(args, lds, vcu, G, tid); }
    SEAM(2);
#ifndef CONV_IN_WOUT
#define CONV_IN_WOUT 3
#endif
    if (IN(3)) { LA(); merge_phase(args, gw, NGW, lane); if (!(CONV_IN_WOUT & 1)) moe_convert(args, 0, lds, gw, NGW, wave, lane); }
    SEAM(3);
    for (int layer = 0; layer < 2; ++layer) {
        const int pb = layer == 0 ? 4 : 12;
        if (layer == 1) {
            if (IN(9)) { LA();
                unsigned* rdy = (unsigned*)(ws + WS_CTL) + CW_RDY2;
                { pg8::DenseT<1> P; P.init((const bf16_t*)(ws + WS_XB), 1024, (const bf16_t*)(ws + WS_WIN1), N, 1536, 1024, G, bx); P.ready = rdy;
                  pg8::EpiWin1 E{(bf16_t*)(ws + R1_Z1), (const float*)(ws + WS_SS), (float*)(ws + WS_SSZ), (const f32x2*)(ws + WS_ROPE)};
                  pg8::gemm_phase<pg8::EpiWin1, pg8::DenseT<1>, false>(lds, P, E, tid); }
                { const int ce = bx >= 128 ? bx - 128 : (bx >= 64 ? 64 + bx : (1 << 20));
                  pg8::DenseT<2> P; P.init((const bf16_t*)(ws + R1_Z1), 1536, (const bf16_t*)(ws + WS_WUQ), N, 768, 384, 1 << 20, ce); P.ready = rdy; P.need = 16u; P.sel = 0;
                  pg8::EpiUq E{(bf16_t*)(ws + R1_Q1), (const float*)(ws + WS_SSZ), (const f32x2*)(ws + WS_ROPE)};
                  int tid2 = threadIdx.x; asm volatile("" : "+v"(tid2));
                  pg8::gemm_phase<pg8::EpiUq, pg8::DenseT<2>, false>(lds, P, E, tid2); }
                { const int ce = bx >= 128 ? bx - 128 : (1 << 20);
                  pg8::DenseT<2> P; P.init((const bf16_t*)(ws + R1_Z1) + 512, 1536, (const bf16_t*)(ws + WS_WUKV), N, 1024, 256, 128, ce); P.ready = rdy; P.need = 8u; P.sel = 1;
                  pg8::EpiUkv E{(bf16_t*)(ws + R1_KV1), (const float*)(ws + WS_SSZ)};
                  int tid3 = threadIdx.x; asm volatile("" : "+v"(tid3));
                  pg8::gemm_phase<pg8::EpiUkv, pg8::DenseT<2>, false>(lds, P, E, tid3); } }
            SEAM(10);
            if (IN(11)) { LA(); attn_phase1(args, lds, vcu, G, tid); if (!(CONV_IN_WOUT & 2)) moe_convert(args, 1, lds, gw, NGW, wave, lane); }
            SEAM(11);
        }
        if (IN(pb)) { LA();
            const bool cv = (CONV_IN_WOUT >> layer) & 1;
            if (cv && !(vcu & 1)) { moe_convert(args, layer, lds, gw, NGW, wave, lane); __syncthreads(); }
            { pg8::Dense P; P.init((const bf16_t*)(ws + R2_AO), 1024, (const bf16_t*)(ws + (layer == 0 ? WS_WOUT0 : WS_WOUT1)), N, 1024, 1024, G, bx);
              pg8::EpiOut E{(bf16_t*)(ws + WS_XB), (float*)(ws + WS_SSP)};
              pg8::gemm_phase<pg8::EpiOut, pg8::Dense, false>(lds, P, E, tid); }
            if (cv && (vcu & 1)) { __syncthreads(); int l2 = threadIdx.x & 63; asm volatile("" : "+v"(l2)); moe_convert(args, layer, lds, gw, NGW, wave, l2); } }
        SEAM(pb);
        if (IN(pb + 1)) { LA(); route_phase(args, layer, lds, vcu, G, wave, lane); }
        SEAM(pb + 1);
        if (IN(pb + 2)) { LA(); moe_tables(args, layer, lds, tid);
            unsigned* rdy = (unsigned*)(ws + WS_CTL) + CW_RDY + layer * 8192;
            { pg8::MoeProb<1> P{(const LAS int*)(lds + MISC_PRE), (const LAS int*)(lds + MISC_CNT), 2, G, vcu, 1024, 1024, (const bf16_t*)(ws + WS_XB), (const bf16_t*)(ws + (layer ? R2_WGU1 : R1_WGU)), (size_t)512 * 1024, (const unsigned*)(ws + WS_LT), true, rdy, 16u};
              pg8::EpiGateUp E{(bf16_t*)(ws + R1_ACT), (const float*)(ws + WS_LW), (const float*)(ws + WS_LR)};
              pg8::gemm_phase<pg8::EpiGateUp, pg8::MoeProb<1>, true>(lds, P, E, tid, (LAS unsigned*)(lds + MISC_STASH)); }
            { int tid2 = threadIdx.x; asm volatile("" : "+v"(tid2));
              pg8::MoeProb<2> P{(const LAS int*)(lds + MISC_PRE), (const LAS int*)(lds + MISC_CNT), 4, G, vcu, 256, 256, (const bf16_t*)(ws + R1_ACT), (const bf16_t*)(ws + (layer ? R2_WD1 : R1_WD)), (size_t)1024 * 256, (const unsigned*)(ws + WS_LT), false, rdy, 16u};
              pg8::EpiDown E{(bf16_t*)(ws + (layer ? Y1_BASE : R2_Y)), (const unsigned*)(ws + WS_LT)};
              pg8::gemm_phase<pg8::EpiDown, pg8::MoeProb<2>, false>(lds, P, E, tid2); } }
        SEAM(pb + 3);
        if (IN(pb + 4)) { LA(); combine_phase(args, layer == 1, gw, NGW, lane); }
        if (layer == 0) SEAM(8);
    }
#undef IN
#undef SEAM
#undef LA
}
}
extern "C" void kernel_launch(void* const* d_in, const int* in_sizes, int n_in, void* d_out, int out_size, void* d_ws, size_t ws_size, hipStream_t stream) {
    using namespace mk;
    static int grid = 0;
    if (grid == 0) {
        if (n_in != 21 || out_size != N * D || ws_size < 283 * MiB) { fprintf(stderr, "kernel_launch: unexpected problem (n_in %d out %d ws %zu)\n", n_in, out_size, ws_size); grid = -1; return; }
        int dev = 0, cus = 0, per_cu = 0;
        if (hipGetDevice(&dev) != hipSuccess || hipDeviceGetAttribute(&cus, hipDeviceAttributeMultiprocessorCount, dev) != hipSuccess) { grid = -1; return; }
        if (hipFuncSetAttribute((const void*)mega, hipFuncAttributeMaxDynamicSharedMemorySize, LDS_BYTES) != hipSuccess) { fprintf(stderr, "kernel_launch: hipFuncSetAttribute failed\n"); grid = -1; return; }
        if (hipOccupancyMaxActiveBlocksPerMultiprocessor(&per_cu, (const void*)mega, NTHREADS, LDS_BYTES) != hipSuccess || per_cu < 1) { fprintf(stderr, "kernel_launch: occupancy query says %d blocks per CU\n", per_cu); (void)hipGetLastError(); grid = -1; return; }
        grid = cus;
    }
    if (grid < 0) return;
    Args a{};
    for (int i = 0; i < 21; ++i) a.in[i] = (const float*)d_in[i];
    a.out = (float*)d_out; a.ws = (unsigned char*)d_ws; a.H = (float*)d_out; a.use_bar = 1; a.ph_lo = 0; a.ph_hi = NPHASE;
    (void)hipMemsetAsync((char*)d_ws + WS_CTL, 0, CTL_ZERO_BYTES, stream);
    hipLaunchKernelGGL(mega, dim3(grid), dim3(NTHREADS), LDS_BYTES, stream, a);
}
```

```cpp
#define CONV_IN_WOUT 3
#include <hip/hip_runtime.h>
#include <cstdio>
#include <cstdint>
#include <cmath>
#define LAS __attribute__((address_space(3)))
#define GAS __attribute__((address_space(1)))
typedef unsigned short bf16_t;
typedef short bf16x8 __attribute__((ext_vector_type(8)));
typedef short s16x4 __attribute__((ext_vector_type(4)));
typedef float f32x2 __attribute__((ext_vector_type(2)));
typedef float f32x4 __attribute__((ext_vector_type(4)));
typedef float f32x16 __attribute__((ext_vector_type(16)));
typedef unsigned u32x2 __attribute__((ext_vector_type(2)));
typedef unsigned u32x4 __attribute__((ext_vector_type(4)));
typedef __bf16 bf16x2_t __attribute__((ext_vector_type(2)));
__device__ __forceinline__ unsigned cvtpk(float lo, float hi) { f32x2 v = {lo, hi}; bf16x2_t b = __builtin_convertvector(v, bf16x2_t); return __builtin_bit_cast(unsigned, b); }
__device__ __forceinline__ float bf2f(unsigned short u) { return __uint_as_float((unsigned)u << 16); }
__device__ __forceinline__ float bflo(unsigned u) { return __uint_as_float(u << 16); }
__device__ __forceinline__ float bfhi(unsigned u) { return __uint_as_float(u & 0xffff0000u); }
#ifndef WT_G
#define WT_G 0
#endif
#ifndef WT_A
#define WT_A 0
#endif
#ifndef WT_S
#define WT_S 0
#endif
template <int WTF> __device__ __forceinline__ void st16x(void* p, int off, u32x4 v) {
    if constexpr (WTF) asm volatile("global_store_dwordx4 %0, %1, off offset:%2 sc1\n\ts_nop 1" :: "v"(p), "v"(v), "i"(off) : "memory");
    else *(u32x4*)((char*)p + off) = v;
}
template <int WTF> __device__ __forceinline__ void st8x(void* p, int off, u32x2 v) {
    if constexpr (WTF) asm volatile("global_store_dwordx2 %0, %1, off offset:%2 sc1" :: "v"(p), "v"(v), "i"(off) : "memory");
    else *(u32x2*)((char*)p + off) = v;
}
template <int WTF> __device__ __forceinline__ void st4x(void* p, int off, unsigned v) {
    if constexpr (WTF) asm volatile("global_store_dword %0, %1, off offset:%2 sc1" :: "v"(p), "v"(v), "i"(off) : "memory");
    else *(unsigned*)((char*)p + off) = v;
}
#define st16g st16x<WT_G>
#define st8g  st8x<WT_G>
#define st16a st16x<WT_A>
#define st16s st16x<WT_S>
#define st8s  st8x<WT_S>
__device__ __forceinline__ void st16fs(void* p, int off, f32x4 v) { st16x<WT_S>(p, off, __builtin_bit_cast(u32x4, v)); }

namespace pg8 {
constexpr int BM = 256, BK = 64, HALF = 128, HTB = HALF * BK * 2  , STAGE_BYTES = 8 * HTB, NXCD = 8, WGM = 8;
__host__ __device__ __forceinline__ int lds_byte(int r, int c) { const int st = (r >> 4) * 2 + (c >> 5), rr = r & 15, cc = c & 31, ob = rr * 64 + cc * 2; return st * 1024 + (ob ^ (((ob >> 9) & 1) << 5)); }
__host__ __device__ __forceinline__ void stage_rc(int b, int& R, int& C) { const int st = b / 1024, sb = b % 1024, swz = sb ^ (((sb >> 9) & 1) << 5); R = (st >> 1) * 16 + swz / 64; C = (st & 1) * 32 + (swz % 64) / 2; }
__host__ __device__ __forceinline__ int perm32(int rho) { const int n = rho >> 4, i = rho & 15; return 8 * (i >> 2) + 4 * n + (i & 3); }

struct Unit { int pm, pn, e, rt, rows; };

template <int MODE>
struct DenseT {
    static constexpr bool ROWSKIP = false;
    const bf16_t* A; const bf16_t* Bt; int lda, K; int nM, nN, nwg, G, c; unsigned* ready; unsigned need; int sel;
    __device__ void init(const bf16_t* A_, int lda_, const bf16_t* Bt_, int M, int N, int K_, int G_, int c_) { A = A_; lda = lda_; Bt = Bt_; K = K_; nM = M / BM; nN = N / BM; nwg = nM * nN; G = G_; c = c_; ready = nullptr; need = 0u; sel = 0; }
    __device__ __forceinline__ bool next(int i, Unit& u) const {
        const long L = (long)i * G + c; if (L >= nwg) return false;
        int wgid = (int)L; { const int q = nwg / NXCD, r = nwg % NXCD, xcd = wgid % NXCD, off = wgid / NXCD; wgid = (xcd < r ? xcd * (q + 1) : r * (q + 1) + (xcd - r) * q) + off; }
        const int nig = WGM * nN, gid = wgid / nig, fm = gid * WGM, gsz = (nM - fm) < WGM ? (nM - fm) : WGM;
        u.pm = fm + ((wgid % nig) % gsz); u.pn = (wgid % nig) / gsz; u.e = 0; u.rt = 0; u.rows = 256; return true;
    }
    __device__ __forceinline__ const char* a_base(const Unit& u) const { return (const char*)A + (size_t)u.pm * BM * lda * 2; }
    __device__ __forceinline__ const char* b_base(const Unit& u) const { return (const char*)Bt + (size_t)u.pn * BM * K * 2; }
    __device__ __forceinline__ void a_ready(const Unit& u) const {
        if constexpr (MODE == 2) {
            if (threadIdx.x < 64) {
                unsigned polls = 0;
                while ((unsigned)__builtin_amdgcn_readfirstlane((int)__hip_atomic_load(ready + 32 * (2 * u.pm + sel), __ATOMIC_RELAXED, __HIP_MEMORY_SCOPE_AGENT)) < need) {
                    __builtin_amdgcn_s_sleep(2); if (++polls > (1u << 19)) break; }
            }
            asm volatile("" ::: "memory"); __builtin_amdgcn_s_barrier(); asm volatile("" ::: "memory");
        }
    }
    __device__ __forceinline__ void done(const Unit& u) const {
        if constexpr (MODE == 1) {
            if (u.pn < 3) {
                asm volatile("s_waitcnt vmcnt(0)" ::: "memory");
                if ((threadIdx.x & 63) == 0) __hip_atomic_fetch_add(ready + 32 * (2 * u.pm + (u.pn == 2 ? 1 : 0)), 1u, __ATOMIC_RELAXED, __HIP_MEMORY_SCOPE_AGENT); }
        }
    }
    __device__ __forceinline__ void a_voff(const Unit&, int R0, int C0, int R1, int C1, unsigned (&vo)[2][2]) const {
        vo[0][0] = (unsigned)(R0 * lda + C0) * 2u; vo[0][1] = (unsigned)(R1 * lda + C1) * 2u; vo[1][0] = vo[0][0]; vo[1][1] = vo[0][1]; }
    __device__ __forceinline__ size_t a_hstep() const { return (size_t)HALF * lda * 2; }
};
using Dense = DenseT<0>;

__device__ __forceinline__ void glds_s(const char* sbase, unsigned voff, unsigned lds_dst) { unsigned keep;
    asm volatile("s_mov_b32 %0, m0\n\ts_mov_b32 m0, %2\n\ts_nop 0\n\tglobal_load_lds_dwordx4 %1, %3\n\ts_mov_b32 m0, %0" : "=&s"(keep) : "v"(voff), "s"(lds_dst), "s"(sbase) : "memory"); }
template <class Epi, class Prob, bool GATHER>
__device__ __forceinline__ void gemm_phase(LAS unsigned char* lds, const Prob& S, const Epi& E, const int tid, LAS unsigned* stash = nullptr) {
    const int wid = __builtin_amdgcn_readfirstlane(tid >> 6), lane = tid & 63, wr = wid >> 2, wc = wid & 3, fr = lane & 15, fq = lane >> 4;
    const int K = S.K, nt = K / BK;
    int R0, C0, R1, C1; stage_rc(tid * 16, R0, C0); stage_rc(tid * 16 + 8192, R1, C1);
    unsigned voffB[2];
    { const int Rb0 = Epi::WIDE ? ((R0 >> 5) * 64 + perm32(R0 & 31)) : Epi::PERM ? ((R0 & ~31) + perm32(R0 & 31)) : R0, Rb1 = Epi::WIDE ? ((R1 >> 5) * 64 + perm32(R1 & 31)) : Epi::PERM ? ((R1 & ~31) + perm32(R1 & 31)) : R1;
      voffB[0] = (unsigned)(Rb0 * K + C0) * 2u; voffB[1] = (unsigned)(Rb1 * K + C1) * 2u; }
    const size_t kstep = (size_t)(BK * 2);
    const size_t hstepB = (size_t)(Epi::WIDE ? 32 : HALF) * K * 2;
    const size_t hstepA = GATHER ? 0 : S.a_hstep();
    const unsigned ldsb = (unsigned)(uintptr_t)lds + (unsigned)wid * 1024u;
    const int aoff = lds_byte(wr * 64 + fr, fq * 8), boff = lds_byte(wc * 32 + fr, fq * 8);
#define PG8_SA(b, h) (((b) * 2 + (h)) * HTB)
#define PG8_SB(b, h) ((4 + (b) * 2 + (h)) * HTB)
#define PG8_STAGE(bufoff, gbase, voff) do { _Pragma("unroll") for (int _i = 0; _i < 2; ++_i) \
        glds_s((const char*)(gbase), (voff)[_i], ldsb + (unsigned)((bufoff) + _i * 8192)); } while (0)
#define PG8_LDA(dst, b, h) do { _Pragma("unroll") for (int m = 0; m < 4; ++m) _Pragma("unroll") for (int k = 0; k < 2; ++k) dst[m][k] = *(const LAS bf16x8*)(lds + PG8_SA(b, h) + aoff + m * 2048 + k * 1024); } while (0)
#define PG8_LDB(dst, b, h) do { _Pragma("unroll") for (int n = 0; n < 2; ++n) _Pragma("unroll") for (int k = 0; k < 2; ++k) dst[n][k] = *(const LAS bf16x8*)(lds + PG8_SB(b, h) + boff + n * 2048 + k * 1024); } while (0)
#define PG8_MMA(ai, bj, At, Bt) do { __builtin_amdgcn_s_setprio(1); _Pragma("unroll") for (int m = 0; m < 4; ++m) { if (!Prob::ROWSKIP || (ai) * HALF + wr * 64 + m * 16 < rows_cur) { _Pragma("unroll") for (int n = 0; n < 2; ++n) _Pragma("unroll") for (int k = 0; k < 2; ++k) \
        acc[ai][bj][m][n] = __builtin_amdgcn_mfma_f32_16x16x32_bf16(Bt[n][k], At[m][k], acc[ai][bj][m][n], 0, 0, 0); } } __builtin_amdgcn_s_setprio(0); } while (0)
#define PG8_WAIT_V(n) asm volatile("s_waitcnt vmcnt(" #n ")" ::: "memory")
#define PG8_WAIT_L(n) asm volatile("s_waitcnt lgkmcnt(" #n ")" ::: "memory")
#define PG8_BAR __builtin_amdgcn_s_barrier()
#define PG8_SCHED __builtin_amdgcn_sched_barrier(0)
    Unit cur, nxt; int ui = 0;
    if (!S.next(0, cur)) return;
    bool has_next = S.next(1, nxt);
    unsigned voffA[2][2];
    S.a_voff(cur, R0, C0, R1, C1, voffA);
    LAS u32x4* const st4 = (LAS u32x4*)stash + tid;
    if (GATHER) { unsigned vn[2][2]; if (has_next) S.a_voff(nxt, R0, C0, R1, C1, vn); else { vn[0][0] = voffA[0][0]; vn[0][1] = voffA[0][1]; vn[1][0] = voffA[1][0]; vn[1][1] = voffA[1][1]; }
        *st4 = (u32x4){vn[0][0], vn[0][1], vn[1][0], vn[1][1]};
        asm volatile("s_waitcnt vmcnt(0)" : "+v"(voffA[0][0]), "+v"(voffA[0][1]), "+v"(voffA[1][0]), "+v"(voffA[1][1]) :: "memory"); }
    f32x4 acc[2][2][4][2];
#pragma unroll
    for (int a = 0; a < 2; ++a)
#pragma unroll
        for (int b = 0; b < 2; ++b)
#pragma unroll
            for (int m = 0; m < 4; ++m)
#pragma unroll
                for (int n = 0; n < 2; ++n) acc[a][b][m][n] = (f32x4){0.f, 0.f, 0.f, 0.f};
    bf16x8 At[4][2], B0[2][2], B1[2][2];
    const char* cA = S.a_base(cur); const char* cB = S.b_base(cur); int rows_cur = cur.rows; (void)rows_cur;
    S.a_ready(cur);
    PG8_STAGE(PG8_SB(0, 0), cB, voffB); PG8_STAGE(PG8_SB(0, 1), cB + hstepB, voffB); PG8_STAGE(PG8_SA(0, 0), cA, voffA[0]); PG8_STAGE(PG8_SA(0, 1), cA + hstepA, voffA[1]);
    if (wr == 1) PG8_BAR;
    PG8_WAIT_V(2); PG8_BAR;
    PG8_STAGE(PG8_SB(1, 0), cB + kstep, voffB); PG8_STAGE(PG8_SA(1, 0), cA + kstep, voffA[0]); PG8_STAGE(PG8_SB(1, 1), cB + hstepB + kstep, voffB);
    PG8_WAIT_V(6); PG8_BAR;
    for (;;) {
        const char* nA = has_next ? S.a_base(nxt) : cA; const char* nB = has_next ? S.b_base(nxt) : cB;
#pragma unroll 1
        for (int t = 0; t < nt; t += 2) {
            const bool last = (t == nt - 2);
            if (last && has_next) S.a_ready(nxt);
            const char* a1 = cA + (size_t)(t + 1) * kstep;
            const char* a2 = last ? nA : cA + (size_t)(t + 2) * kstep; const char* b2 = last ? nB : cB + (size_t)(t + 2) * kstep;
            const char* a3 = a2 + kstep; const char* b3 = b2 + kstep;
            unsigned v20 = voffA[0][0], v21 = voffA[0][1], v30 = voffA[1][0], v31 = voffA[1][1];
            if (GATHER) { if (last) { const u32x4 n4 = *st4; v20 = n4.x; v21 = n4.y; v30 = n4.z; v31 = n4.w; } }
            const unsigned vh0[2] = {v20, v21}, vh1[2] = {v30, v31};
            PG8_LDB(B0, 0, 0); PG8_LDB(B1, 0, 1); PG8_SCHED; PG8_LDA(At, 0, 0); PG8_STAGE(PG8_SA(1, 1), a1 + hstepA, voffA[1]);
            PG8_WAIT_V(8); PG8_WAIT_L(0); PG8_BAR; PG8_MMA(0, 0, At, B0); PG8_MMA(0, 1, At, B1); PG8_BAR; PG8_SCHED;
            PG8_LDA(At, 0, 1); PG8_STAGE(PG8_SB(0, 0), b2, voffB); PG8_STAGE(PG8_SB(0, 1), b2 + hstepB, voffB); PG8_STAGE(PG8_SA(0, 0), a2, vh0);
            PG8_WAIT_V(8); PG8_WAIT_L(0); PG8_BAR; PG8_MMA(1, 0, At, B0); PG8_MMA(1, 1, At, B1); PG8_BAR; PG8_SCHED;
            PG8_LDB(B0, 1, 0); PG8_LDB(B1, 1, 1); PG8_SCHED; PG8_LDA(At, 1, 0); PG8_STAGE(PG8_SA(0, 1), a2 + hstepA, vh1);
            PG8_WAIT_V(8); PG8_WAIT_L(0); PG8_BAR; PG8_MMA(0, 0, At, B0); PG8_MMA(0, 1, At, B1); PG8_BAR; PG8_SCHED;
            PG8_LDA(At, 1, 1); PG8_STAGE(PG8_SB(1, 0), b3, voffB); PG8_STAGE(PG8_SB(1, 1), b3 + hstepB, voffB); PG8_STAGE(PG8_SA(1, 0), a3, vh0);
            PG8_WAIT_V(8); PG8_WAIT_L(0); PG8_BAR; PG8_MMA(1, 0, At, B0); PG8_MMA(1, 1, At, B1); PG8_BAR; PG8_SCHED;
        }
        if (wr == 0) PG8_BAR;
        { int fr_e = fr, fq_e = fq; asm volatile("" : "+v"(fr_e), "+v"(fq_e));
          E(acc, cur, wr, wc, fr_e, fq_e); }
        S.done(cur);
        if (!has_next) break;
#pragma unroll
        for (int a = 0; a < 2; ++a)
#pragma unroll
            for (int b = 0; b < 2; ++b)
#pragma unroll
                for (int m = 0; m < 4; ++m)
#pragma unroll
                    for (int n = 0; n < 2; ++n) acc[a][b][m][n] = (f32x4){0.f, 0.f, 0.f, 0.f};
        cur = nxt; cA = nA; cB = nB; ++ui; rows_cur = cur.rows;
        has_next = S.next(ui + 1, nxt);
        if (GATHER) {
            { const u32x4 n4 = *st4; voffA[0][0] = n4.x; voffA[0][1] = n4.y; voffA[1][0] = n4.z; voffA[1][1] = n4.w; }
            if (has_next) { unsigned vn[2][2]; S.a_voff(nxt, R0, C0, R1, C1, vn);
                asm volatile("s_waitcnt vmcnt(0)" : "+v"(vn[0][0]), "+v"(vn[0][1]), "+v"(vn[1][0]), "+v"(vn[1][1]) :: "memory");
                *st4 = (u32x4){vn[0][0], vn[0][1], vn[1][0], vn[1][1]}; }
        }
        if (wr == 1) PG8_BAR;
    }
    PG8_WAIT_V(0);
    PG8_BAR;
#undef PG8_SA
#undef PG8_SB
#undef PG8_STAGE
#undef PG8_LDA
#undef PG8_LDB
#undef PG8_MMA
#undef PG8_WAIT_V
#undef PG8_WAIT_L
#undef PG8_BAR
#undef PG8_SCHED
}
}
namespace mk {
constexpr int NB = 4, S = 4096, D = 1024, N = NB * S;
constexpr float EPS = 1e-6f, LOG2E = 1.4426950408889634f;
constexpr float C2_64 = 0.125f * LOG2E, C2_96 = 0.10206207261596575f * LOG2E;
constexpr size_t MiB = 1u << 20;
constexpr size_t WS_CTL = 0, CTL_ZERO_BYTES = 1 * MiB;
constexpr size_t WS_SS = 1 * MiB;
constexpr size_t WS_RSTD = WS_SS + (size_t)N * 4;
constexpr size_t WS_SSP = WS_RSTD + (size_t)N * 4;
constexpr size_t WS_LOGF = WS_SSP + (size_t)N * 64;
constexpr size_t WS_CB2 = WS_LOGF + (size_t)N * 32;
constexpr size_t WS_ROPE = WS_CB2 + (size_t)32 * S * 4;
constexpr size_t WS_DLSE = WS_ROPE + (size_t)S * 16 * 8;
constexpr size_t WS_SSZ = WS_DLSE + (size_t)3 * N * 32;
constexpr size_t WS_LT = WS_SSZ + (size_t)N * 48;
constexpr size_t WS_LW = WS_LT + (size_t)32 * N * 4;
constexpr size_t WS_LR = WS_LW + (size_t)32 * N * 4;
constexpr size_t WS_SMALL_END = WS_LR + (size_t)32 * N * 4;
constexpr size_t WS_KEXT = WS_LT;
static_assert(WS_SMALL_END <= 13 * MiB, "small arrays");
constexpr size_t WS_WIN0 = 13 * MiB;
constexpr size_t WS_WOUT0 = WS_WIN0 + 6 * MiB;
constexpr size_t WS_WIN1 = WS_WOUT0 + 2 * MiB;
constexpr size_t WS_WUQ = WS_WIN1 + 3 * MiB;
constexpr size_t WS_WUKV = WS_WUQ + 768 * 384 * 2;
constexpr size_t WS_WOUT1 = WS_WUKV + 1024 * 256 * 2;
constexpr size_t WS_WR = WS_WOUT1 + 2 * MiB;
static_assert(WS_WR + 2 * 64 * 1024 * 2 <= 28 * MiB, "weights");
constexpr size_t WS_XB = 28 * MiB;
constexpr size_t WS_R1 = 60 * MiB;
constexpr size_t WS_R2 = 164 * MiB;
constexpr size_t WS_END = 244 * MiB;
constexpr size_t R1_QKV0 = WS_R1;
constexpr size_t R1_Z1 = WS_R1, R1_Q1 = WS_R1 + 48 * MiB, R1_KV1 = WS_R1 + 72 * MiB;
constexpr size_t R1_WGU = WS_R1, R1_WD = WS_R1 + 32 * MiB, R1_ACT = WS_R1 + 48 * MiB;
constexpr size_t R2_AO = WS_R2, R2_DPART = WS_R2 + 32 * MiB;
constexpr size_t R2_Y = WS_R2;
constexpr size_t Y1_BASE = 128 * MiB;
constexpr size_t R2_WGU1 = WS_R2 + 32 * MiB, R2_WD1 = WS_R2 + 64 * MiB;
constexpr int CW_CNT = 64;
constexpr int CW_BAR = 4096;
constexpr int CW_RDY2 = 49152;
constexpr int CW_RDY = 16384;
}

#ifndef WIDE_QKV
#define WIDE_QKV 0
#endif
namespace pg8 {
using mk::EPS;
struct EpiQkv0 {
    static constexpr bool PERM = true; static constexpr bool WIDE = (WIDE_QKV != 0);
    bf16_t* O; const float* ss;
    __device__ __forceinline__ void operator()(const f32x4 (&acc)[2][2][4][2], const Unit& u, int wr, int wc, int fr, int fq) const {
        const int row0 = u.pm * BM + wr * 64 + fr, col0 = u.pn * BM + (WIDE ? wc * 64 : wc * 32) + 8 * fq;
        const float sc = (u.pn < 2 || u.pn == 6 || u.pn == 7) ? mk::C2_64 : 1.f;
        float rs[8];
#pragma unroll
        for (int i = 0; i < 8; ++i) rs[i] = ss[row0 + (i >> 2) * HALF + (i & 3) * 16];
#pragma unroll
        for (int i = 0; i < 8; ++i) rs[i] = sc / sqrtf(rs[i] * (1.f / 1024.f) + EPS);
#pragma unroll
        for (int ai = 0; ai < 2; ++ai)
#pragma unroll
            for (int m = 0; m < 4; ++m) { const int row = row0 + ai * HALF + m * 16; const float r_ = rs[ai * 4 + m];
                bf16_t* rowp = O + (size_t)row * 3072 + col0;
#pragma unroll
                for (int bj = 0; bj < 2; ++bj) { const f32x4 v0 = acc[ai][bj][m][0] * r_, v1 = acc[ai][bj][m][1] * r_;
                    u32x4 w; w.x = cvtpk(v0[0], v0[1]); w.y = cvtpk(v0[2], v0[3]); w.z = cvtpk(v1[0], v1[1]); w.w = cvtpk(v1[2], v1[3]);
                    st16g(rowp, WIDE ? bj * 64 : bj * HALF * 2, w); } }
    }
};
struct EpiOut {
    static constexpr bool PERM = false; static constexpr bool WIDE = false;
    bf16_t* X; float* ssp;
    __device__ __forceinline__ void operator()(const f32x4 (&acc)[2][2][4][2], const Unit& u, int wr, int wc, int fr, int fq) const {
        const int row0 = u.pm * BM + wr * 64 + fr, col0 = u.pn * BM + wc * 32 + 4 * fq;
        u32x2 rb[8][4];
#pragma unroll
        for (int i = 0; i < 8; ++i) { const size_t off = (size_t)(row0 + (i >> 2) * HALF + (i & 3) * 16) * 1024 + col0;
#pragma unroll
            for (int qq = 0; qq < 4; ++qq) rb[i][qq] = *(const u32x2*)(X + off + (qq >> 1) * HALF + (qq & 1) * 16); }
#pragma unroll
        for (int i = 0; i < 8; ++i) { const int ai = i >> 2, m = i & 3; const int row = row0 + ai * HALF + m * 16; const size_t off = (size_t)row * 1024 + col0; float q = 0.f;
#pragma unroll
            for (int qq = 0; qq < 4; ++qq) { const f32x4 a4 = acc[ai][qq >> 1][m][qq & 1]; const u32x2 r2 = rb[i][qq];
                const float v0 = bflo(r2.x) + a4[0], v1 = bfhi(r2.x) + a4[1], v2 = bflo(r2.y) + a4[2], v3 = bfhi(r2.y) + a4[3];
                u32x2 w; w.x = cvtpk(v0, v1); w.y = cvtpk(v2, v3); st8g(X + off, ((qq >> 1) * HALF + (qq & 1) * 16) * 2, w);
                q += (v0 * v0 + v1 * v1) + (v2 * v2 + v3 * v3); }
            q += __shfl_xor(q, 16); q += __shfl_xor(q, 32);
            if (fq == 0) ssp[(size_t)row * 16 + u.pn * 4 + wc] = q; }
    }
};
struct EpiWin1 {
    static constexpr bool PERM = false; static constexpr bool WIDE = false;
    bf16_t* Z; const float* ss; float* ssz; const f32x2* rope;
    __device__ __forceinline__ void operator()(const f32x4 (&acc)[2][2][4][2], const Unit& u, int wr, int wc, int fr, int fq) const {
        const int row0 = u.pm * BM + wr * 64 + fr, col0 = u.pn * BM + wc * 32 + 4 * fq; const int pn = u.pn;
        const float sc = (pn == 3 || pn == 4) ? mk::C2_64 : 1.f; const bool ropew = (pn == 1 && wc == 0);
        float rs[8];
#pragma unroll
        for (int i = 0; i < 8; ++i) rs[i] = ss[row0 + (i >> 2) * HALF + (i & 3) * 16];
#pragma unroll
        for (int i = 0; i < 8; ++i) rs[i] = sc / sqrtf(rs[i] * (1.f / 1024.f) + EPS);
#pragma unroll
        for (int ai = 0; ai < 2; ++ai) {
            f32x4 cs[4][2];
            if (ropew) {
#pragma unroll
                for (int m = 0; m < 4; ++m) { const f32x4* rp = (const f32x4*)(rope + (size_t)((row0 + ai * HALF + m * 16) & (mk::S - 1)) * 16 + 4 * fq); cs[m][0] = rp[0]; cs[m][1] = rp[1]; } }
#pragma unroll
            for (int m = 0; m < 4; ++m) { const int row = row0 + ai * HALF + m * 16; const float r_ = rs[ai * 4 + m];
                bf16_t* rowp = Z + (size_t)row * 1536 + col0; float q = 0.f;
#pragma unroll
                for (int bj = 0; bj < 2; ++bj) { f32x4 v0 = acc[ai][bj][m][0] * r_, v1 = acc[ai][bj][m][1] * r_;
                    if (pn == 1 && bj == 1) {
                        if (wc != 0) continue;
#pragma unroll
                        for (int j = 0; j < 4; ++j) { const float c_ = cs[m][j >> 1][2 * (j & 1)], s_ = cs[m][j >> 1][2 * (j & 1) + 1]; const float t1 = v0[j], t2 = v1[j]; v0[j] = t1 * c_ - t2 * s_; v1[j] = t1 * s_ + t2 * c_; }
                    } else if (pn < 3) q += (v0[0] * v0[0] + v0[1] * v0[1]) + (v0[2] * v0[2] + v0[3] * v0[3]) + (v1[0] * v1[0] + v1[1] * v1[1]) + (v1[2] * v1[2] + v1[3] * v1[3]);
                    u32x2 w0, w1; w0.x = cvtpk(v0[0], v0[1]); w0.y = cvtpk(v0[2], v0[3]); w1.x = cvtpk(v1[0], v1[1]); w1.y = cvtpk(v1[2], v1[3]);
                    st8x<1>(rowp, bj * HALF * 2, w0); st8x<1>(rowp, bj * HALF * 2 + 32, w1); }
                if (pn < 3) { q += __shfl_xor(q, 16); q += __shfl_xor(q, 32); if (fq == 0) st4x<1>(pn < 2 ? ssz + (size_t)row * 8 + pn * 4 + wc : ssz + (size_t)mk::N * 8 + (size_t)row * 4 + wc, 0, __float_as_uint(q)); } }
        }
    }
};
struct EpiUq {
    static constexpr bool PERM = false; static constexpr bool WIDE = false;
    bf16_t* Q; const float* ssz; const f32x2* rope;
    __device__ __forceinline__ void operator()(const f32x4 (&acc)[2][2][4][2], const Unit& u, int wr, int wc, int fr, int fq) const {
        const int row0 = u.pm * BM + wr * 64 + fr, col0 = u.pn * BM + wc * 32 + 4 * fq;
        const bool rp0 = ((u.pn * 8 + wc) % 3 == 2), rp1 = ((u.pn * 8 + 4 + wc) % 3 == 2);
        float rs[8];
#pragma unroll
        for (int hb = 0; hb < 2; ++hb) { f32x4 sa[4], sb[4];
#pragma unroll
          for (int i = 0; i < 4; ++i) { const f32x4* sp = (const f32x4*)(ssz + (size_t)(row0 + hb * HALF + i * 16) * 8); sa[i] = sp[0]; sb[i] = sp[1]; }
#pragma unroll
          for (int i = 0; i < 4; ++i) rs[hb * 4 + i] = mk::C2_96 / sqrtf(((sa[i][0] + sa[i][1]) + (sa[i][2] + sa[i][3]) + (sb[i][0] + sb[i][1]) + (sb[i][2] + sb[i][3])) * (1.f / 384.f) + EPS);
          asm volatile("" ::: "memory"); }
#pragma unroll
        for (int ai = 0; ai < 2; ++ai)
#pragma unroll
            for (int mp = 0; mp < 2; ++mp) {
                f32x4 cs[2][2];
                if (rp0 || rp1) {
#pragma unroll
                    for (int mm = 0; mm < 2; ++mm) { const f32x4* rp = (const f32x4*)(rope + (size_t)((row0 + ai * HALF + (2 * mp + mm) * 16) & (mk::S - 1)) * 16 + 4 * fq); cs[mm][0] = rp[0]; cs[mm][1] = rp[1]; } }
#pragma unroll
                for (int mm = 0; mm < 2; ++mm) { const int m = 2 * mp + mm; const int row = row0 + ai * HALF + m * 16; const float r_ = rs[ai * 4 + m];
                    bf16_t* rowp = Q + (size_t)row * 768 + col0;
#pragma unroll
                    for (int bj = 0; bj < 2; ++bj) { f32x4 v0 = acc[ai][bj][m][0] * r_, v1 = acc[ai][bj][m][1] * r_;
                        if (bj == 0 ? rp0 : rp1) {
#pragma unroll
                            for (int j = 0; j < 4; ++j) { const float c_ = cs[mm][j >> 1][2 * (j & 1)], s_ = cs[mm][j >> 1][2 * (j & 1) + 1]; const float t1 = v0[j], t2 = v1[j]; v0[j] = t1 * c_ - t2 * s_; v1[j] = t1 * s_ + t2 * c_; } }
                        u32x2 w0, w1; w0.x = cvtpk(v0[0], v0[1]); w0.y = cvtpk(v0[2], v0[3]); w1.x = cvtpk(v1[0], v1[1]); w1.y = cvtpk(v1[2], v1[3]);
                        st8g(rowp, bj * HALF * 2, w0); st8g(rowp, bj * HALF * 2 + 32, w1); } }
                asm volatile("" ::: "memory"); }
    }
};
struct EpiUkv {
    static constexpr bool PERM = true; static constexpr bool WIDE = false;
    bf16_t* O; const float* ssz;
    __device__ __forceinline__ void operator()(const f32x4 (&acc)[2][2][4][2], const Unit& u, int wr, int wc, int fr, int fq) const {
        const int row0 = u.pm * BM + wr * 64 + fr, col0 = u.pn * BM + wc * 32 + 8 * fq;
        float rs[8];
        { f32x4 sa[8];
#pragma unroll
          for (int i = 0; i < 8; ++i) sa[i] = *(const f32x4*)(ssz + (size_t)mk::N * 8 + (size_t)(row0 + (i >> 2) * HALF + (i & 3) * 16) * 4);
#pragma unroll
          for (int i = 0; i < 8; ++i) rs[i] = 1.f / sqrtf(((sa[i][0] + sa[i][1]) + (sa[i][2] + sa[i][3])) * (1.f / 256.f) + EPS); }
#pragma unroll
        for (int ai = 0; ai < 2; ++ai)
#pragma unroll
            for (int m = 0; m < 4; ++m) { const int row = row0 + ai * HALF + m * 16; const float r_ = rs[ai * 4 + m];
                bf16_t* rowp = O + (size_t)row * 1024 + col0;
#pragma unroll
                for (int bj = 0; bj < 2; ++bj) { const f32x4 v0 = acc[ai][bj][m][0] * r_, v1 = acc[ai][bj][m][1] * r_;
                    u32x4 w; w.x = cvtpk(v0[0], v0[1]); w.y = cvtpk(v0[2], v0[3]); w.z = cvtpk(v1[0], v1[1]); w.w = cvtpk(v1[2], v1[3]);
                    st16g(rowp, bj * HALF * 2, w); } }
    }
};
template <int MODE>
struct MoeProb {
    static constexpr bool ROWSKIP = true;
    const LAS int* pre; const LAS int* cnt; int NT, G, c, K, lda;
    const bf16_t* A; const bf16_t* Bt; size_t bstride;
    const unsigned* lt;
    bool gather; unsigned* ready; unsigned need;
    __device__ __forceinline__ bool next(int i, Unit& u) const {
        const int totF = pre[72]; long L;
        if constexpr (MODE == 1) {
            const int F = totF * NT, Tn = pre[112] * NT, r = F % G, nfull = F / G + (c < r ? 1 : 0), Z = G - r;
            if (i < nfull) L = (long)i * G + c;
            else { const int k = i - nfull; int j;
                if (c >= r) { if (k > 1) return false; j = (c - r) + Z * k; if (j >= 2 * Z) return false; }
                else { if (k > 0) return false; j = 2 * Z + c; }
                if (j >= Tn) return false; L = F + j; }
        } else { L = (long)i * G + c; const int total = (totF + pre[112]) * NT; if (L >= total) return false; }
        int f = (int)L / NT; u.pn = (int)L % NT; int e = 0;
        if (f < totF) {
#pragma unroll
            for (int j = 1; j < 32; ++j) if (pre[40 + j] <= f) e = j;
            u.rt = f - pre[40 + e]; u.rows = 256;
        } else { e = pre[80 + f - totF]; u.rt = cnt[e] >> 8; u.rows = cnt[e] & 255; }
        e = __builtin_amdgcn_readfirstlane(e); u.e = e; u.rt = __builtin_amdgcn_readfirstlane(u.rt); u.rows = __builtin_amdgcn_readfirstlane(u.rows); u.pm = __builtin_amdgcn_readfirstlane(pre[e]) + u.rt; return true;
    }
    __device__ __forceinline__ void a_ready(const Unit& u) const {
        if constexpr (MODE == 2) {
            if (threadIdx.x < 64) {
                unsigned polls = 0;
                while ((unsigned)__builtin_amdgcn_readfirstlane((int)__hip_atomic_load(ready + 32 * u.pm, __ATOMIC_RELAXED, __HIP_MEMORY_SCOPE_AGENT)) < need) {
                    __builtin_amdgcn_s_sleep(2); if (++polls > (1u << 19)) break; }
            }
            asm volatile("" ::: "memory"); __builtin_amdgcn_s_barrier(); asm volatile("" ::: "memory");
        }
    }
    __device__ __forceinline__ void done(const Unit& u) const {
        if constexpr (MODE == 1) {
            asm volatile("s_waitcnt vmcnt(0)" ::: "memory");
            if ((threadIdx.x & 63) == 0) __hip_atomic_fetch_add(ready + 32 * u.pm, 1u, __ATOMIC_RELAXED, __HIP_MEMORY_SCOPE_AGENT);
        }
    }
    __device__ __forceinline__ const char* a_base(const Unit& u) const { return gather ? (const char*)A : (const char*)A + (size_t)u.pm * BM * lda * 2; }
    __device__ __forceinline__ size_t a_hstep() const { return (size_t)HALF * lda * 2; }
    __device__ __forceinline__ const char* b_base(const Unit& u) const { return (const char*)Bt + ((size_t)u.e * bstride + (size_t)u.pn * BM * K) * 2; }
    __device__ __forceinline__ void a_voff(const Unit& u, int R0, int C0, int R1, int C1, unsigned (&vo)[2][2]) const {
        if (gather) { const unsigned* l = lt + (size_t)u.e * mk::N + u.rt * 256;
            const unsigned t00 = (R0 < u.rows) ? (l[R0] & 0x7fffffffu) : 0u, t01 = (R1 < u.rows) ? (l[R1] & 0x7fffffffu) : 0u;
            const unsigned t10 = (R0 + HALF < u.rows) ? (l[R0 + HALF] & 0x7fffffffu) : 0u, t11 = (R1 + HALF < u.rows) ? (l[R1 + HALF] & 0x7fffffffu) : 0u;
            vo[0][0] = (t00 * (unsigned)lda + C0) * 2u; vo[0][1] = (t01 * (unsigned)lda + C1) * 2u; vo[1][0] = (t10 * (unsigned)lda + C0) * 2u; vo[1][1] = (t11 * (unsigned)lda + C1) * 2u;
        } else { vo[0][0] = (unsigned)(R0 * lda + C0) * 2u; vo[0][1] = (unsigned)(R1 * lda + C1) * 2u; vo[1][0] = vo[0][0]; vo[1][1] = vo[0][1]; }
    }
};
struct EpiGateUp {
    static constexpr bool PERM = true; static constexpr bool WIDE = false;
    bf16_t* act; const float* lw; const float* lr;
    __device__ __forceinline__ void operator()(const f32x4 (&acc)[2][2][4][2], const Unit& u, int wr, int wc, int fr, int fq) const {
        const int rl0 = wr * 64 + fr, col0 = u.pn * 128 + wc * 32 + 8 * fq; const size_t lbase = (size_t)u.e * mk::N + u.rt * 256;
        float wv[8], rv[8];
#pragma unroll
        for (int i = 0; i < 8; ++i) { const int rl = rl0 + (i >> 2) * HALF + (i & 3) * 16; const bool ok = rl < u.rows; wv[i] = ok ? lw[lbase + rl] : 0.f; rv[i] = ok ? lr[lbase + rl] : 0.f; }
#pragma unroll
        for (int ai = 0; ai < 2; ++ai)
#pragma unroll
            for (int m = 0; m < 4; ++m) { const int rl = rl0 + ai * HALF + m * 16; if (rl >= u.rows) continue;
                const float w = wv[ai * 4 + m], rs = rv[ai * 4 + m]; float o[8];
#pragma unroll
                for (int n = 0; n < 2; ++n)
#pragma unroll
                    for (int j = 0; j < 4; ++j) { const float g = acc[ai][0][m][n][j] * rs, up = acc[ai][1][m][n][j] * rs;
                        o[n * 4 + j] = g * __builtin_amdgcn_rcpf(1.f + __builtin_amdgcn_exp2f(-g * mk::LOG2E)) * up * w; }
                u32x4 pk; pk.x = cvtpk(o[0], o[1]); pk.y = cvtpk(o[2], o[3]); pk.z = cvtpk(o[4], o[5]); pk.w = cvtpk(o[6], o[7]);
                st16x<1>(act + ((size_t)u.pm * 256 + rl) * 256 + col0, 0, pk);   }
    }
};
struct EpiDown {
    static constexpr bool PERM = true; static constexpr bool WIDE = false;
    bf16_t* Y; const unsigned* lt;
    __device__ __forceinline__ void operator()(const f32x4 (&acc)[2][2][4][2], const Unit& u, int wr, int wc, int fr, int fq) const {
        const int rl0 = wr * 64 + fr, col0 = u.pn * BM + wc * 32 + 8 * fq; const size_t lbase = (size_t)u.e * mk::N + u.rt * 256;
        unsigned tk[8];
#pragma unroll
        for (int i = 0; i < 8; ++i) { const int rl = rl0 + (i >> 2) * HALF + (i & 3) * 16; tk[i] = (rl < u.rows) ? lt[lbase + rl] : 0u; }
#pragma unroll
        for (int ai = 0; ai < 2; ++ai)
#pragma unroll
            for (int m = 0; m < 4; ++m) { const int rl = rl0 + ai * HALF + m * 16; if (rl >= u.rows) continue;
                const unsigned t_ = tk[ai * 4 + m]; bf16_t* rowp = Y + ((size_t)(t_ >> 31) * mk::N + (t_ & 0x7fffffffu)) * 1024 + col0;
#pragma unroll
                for (int bj = 0; bj < 2; ++bj) { const f32x4 v0 = acc[ai][bj][m][0], v1 = acc[ai][bj][m][1];
                    u32x4 w; w.x = cvtpk(v0[0], v0[1]); w.y = cvtpk(v0[2], v0[3]); w.z = cvtpk(v1[0], v1[1]); w.w = cvtpk(v1[2], v1[3]);
                    st16g(rowp, bj * HALF * 2, w); } }
    }
};
}
namespace att {
constexpr int SLOT_K = 12288, SLOT_V = 8192, SLOT_KB = 256, SLOT = SLOT_K + SLOT_V + SLOT_KB;
constexpr int LDS_WS = 2 * SLOT, LDS_OST = LDS_WS + 8 * 256, LDS_BYTES = LDS_OST + 8 * 4608;
struct UnitDesc {
    const bf16_t* q; long qstride;
    const bf16_t* k; const bf16_t* v; long kstride;
    const bf16_t* kx; long kxstride;
    bf16_t* o; long ostride;
    float* lse; long lsestride;
    const float* kbias;
    int q0, W; float alibi, sink;
    bool has_sink, has_lse;
};
__device__ __forceinline__ int crow(int r, int hi) { return (r & 3) + 8 * (r >> 2) + 4 * hi; }
#define ATT_MX3(a, b, c) __builtin_fmaxf(__builtin_fmaxf((a), (b)), (c))
__device__ __forceinline__ float rowmax(const f32x16& p0, const f32x16& p1) {
    float a = ATT_MX3(p0[0], p0[1], p1[0]), b = ATT_MX3(p0[2], p0[3], p1[1]); a = ATT_MX3(a, p1[2], p1[3]);
#pragma unroll
    for (int r = 4; r < 16; r += 4) { a = ATT_MX3(a, p0[r], p0[r + 1]); b = ATT_MX3(b, p0[r + 2], p0[r + 3]); a = ATT_MX3(a, p1[r], p1[r + 1]); b = ATT_MX3(b, p1[r + 2], p1[r + 3]); }
    float m = __builtin_fmaxf(a, b); auto rr = __builtin_amdgcn_permlane32_swap(__float_as_uint(m), __float_as_uint(m), false, false);
    return __builtin_fmaxf(__uint_as_float(rr[0]), __uint_as_float(rr[1])); }
typedef short v4i16_t __attribute__((ext_vector_type(4)));
__device__ __forceinline__ s16x4 vtr(const LAS unsigned char* p) { return __builtin_bit_cast(s16x4, __builtin_amdgcn_ds_read_tr16_b64_v4i16((LAS v4i16_t*)p)); }

__device__ __forceinline__ void att_store_ot(const f32x16 (&o)[2], float inv, LAS bf16_t* stg, bf16_t* O, long ostride, int lane) {
    const int r32 = lane & 31, hi = lane >> 5;
#pragma unroll
    for (int d0 = 0; d0 < 2; ++d0)
#pragma unroll
        for (int g = 0; g < 4; ++g) { u32x2 p; p.x = cvtpk(o[d0][4 * g] * inv, o[d0][4 * g + 1] * inv); p.y = cvtpk(o[d0][4 * g + 2] * inv, o[d0][4 * g + 3] * inv);
            *(LAS u32x2*)(stg + r32 * 72 + 32 * d0 + 8 * g + 4 * hi) = p; }
#pragma unroll
    for (int i = 0; i < 4; ++i) { const int row = i * 8 + (lane >> 3), ch = lane & 7; const u32x4 v = *(const LAS u32x4*)(stg + row * 72 + ch * 8); st16a(O + (long)row * ostride + ch * 8, 0, v); }
}

template <int NDQ, bool FOX, bool BAND>
__device__ __forceinline__ void attn_unit(const UnitDesc& u, LAS unsigned char* lds, const int tid) {
    const int lane = tid & 63, r32 = lane & 31, hi = lane >> 5; const int w = __builtin_amdgcn_readfirstlane(tid >> 6);
    const int q0 = u.q0, Qw = q0 + 32 * w;
    const int t_lo = BAND ? ((q0 - u.W) > 0 ? ((q0 - u.W) >> 6) : 0) : 0, t_hi = (q0 + 255) >> 6;
    LAS float* wsf = (LAS float*)(lds + LDS_WS) + w * 64;
    const bf16_t* ksrc = u.k + (long)lane * u.kstride + w * 8;
    const bf16_t* kxsrc = (NDQ > 4) ? u.kx + (long)lane * u.kxstride + (NDQ == 6 ? (w & 3) * 8 : 0) : nullptr;
    const bf16_t* vsrc = u.v + (long)(16 * (w & 3) + (lane >> 2)) * u.kstride + (w >> 2) * 32 + (lane & 3) * 8;
#define ATT_DMA(t, bsel) do { LAS unsigned char* kb_ = lds + (bsel) * SLOT; \
        __builtin_amdgcn_global_load_lds((const unsigned*)(ksrc + (long)(t) * 64 * u.kstride), (LAS unsigned*)(kb_ + w * 1024), 16, 0, 0); \
        if (NDQ > 4) { if (w < 2 * (NDQ - 4)) __builtin_amdgcn_global_load_lds((const unsigned*)(kxsrc + (long)(t) * 64 * u.kxstride), (LAS unsigned*)(kb_ + (8 + w) * 1024), 16, 0, 0); } \
        __builtin_amdgcn_global_load_lds((const unsigned*)(vsrc + (long)(t) * 64 * u.kstride), (LAS unsigned*)(kb_ + SLOT_K + w * 1024), 16, 0, 0); } while (0)
    ATT_DMA(t_lo, 0);
    bf16x8 qr[NDQ];
    { const bf16_t* Qw_ = u.q + (long)(32 * w + r32) * u.qstride + hi * 8;
#pragma unroll
      for (int d0 = 0; d0 < (FOX ? 4 : NDQ); ++d0) qr[d0] = *(const bf16x8*)(Qw_ + d0 * 16);
      if (FOX) { const short one = hi ? (short)0 : (short)0x3F80; qr[4] = (bf16x8){one, one, one, 0, 0, 0, 0, 0}; } }
    const float ci = 0.f;
    f32x16 negm;
#pragma unroll
    for (int r = 0; r < 16; ++r) negm[r] = ci;
    float m_run = -1e30f, l_run = 0.f; f32x16 o[2]; o[0] = f32x16{}; o[1] = f32x16{};
    const int koff = hi * 1024 + r32 * 16;
    const int voff = SLOT_K + ((lane >> 4) & 1) * 32 + (lane & 3) * 8 + (4 * hi + ((lane & 15) >> 2)) * 64;
    for (int t = t_lo; t <= t_hi; ++t) {
        const int bsel = (t - t_lo) & 1;
        asm volatile("s_waitcnt vmcnt(0)" ::: "memory");
        __syncthreads();
        if (t < t_hi) ATT_DMA(t + 1, bsel ^ 1);
        const int k0 = 64 * t;
        bool active = (k0 <= Qw + 31); if (BAND) active = active && (Qw - (k0 + 63) <= u.W);
        if (!active) continue;
        const LAS unsigned char* kb = lds + bsel * SLOT;
        f32x16 p0, p1;
        if (BAND) {
#pragma unroll
            for (int r = 0; r < 16; ++r) { p0[r] = 0.f; p1[r] = 0.f; }
        } else { p0 = negm; p1 = negm; }
        __builtin_amdgcn_s_setprio(1);
#pragma unroll
        for (int d0 = 0; d0 < NDQ; ++d0) { const bf16x8 a0 = *(const LAS bf16x8*)(kb + koff + d0 * 2048), a1 = *(const LAS bf16x8*)(kb + koff + d0 * 2048 + 512);
            p0 = __builtin_amdgcn_mfma_f32_32x32x16_bf16(a0, qr[d0], p0, 0, 0, 0); p1 = __builtin_amdgcn_mfma_f32_32x32x16_bf16(a1, qr[d0], p1, 0, 0, 0); }
        __builtin_amdgcn_s_setprio(0);
        const int dbase = Qw + r32 - k0 - 4 * hi;
        float alpha = 1.f; float sacc = 0.f;
        if (BAND) {
#pragma unroll
            for (int r = 0; r < 16; ++r) { const int d0_ = dbase - ((r & 3) + 8 * (r >> 2)), d1_ = d0_ - 32;
                p0[r] = ((unsigned)d0_ <= (unsigned)u.W) ? p0[r] - u.alibi * (float)d0_ : -INFINITY;
                p1[r] = ((unsigned)d1_ <= (unsigned)u.W) ? p1[r] - u.alibi * (float)d1_ : -INFINITY; }
            const float rm = rowmax(p0, p1), m_new = __builtin_fmaxf(m_run, rm);
            alpha = __builtin_amdgcn_exp2f(m_run - m_new);
#pragma unroll
            for (int r = 0; r < 16; ++r) { o[0][r] *= alpha; o[1][r] *= alpha; }
            m_run = m_new;
#pragma unroll
            for (int r = 0; r < 16; ++r) { p0[r] = __builtin_amdgcn_exp2f(p0[r] - m_new); p1[r] = __builtin_amdgcn_exp2f(p1[r] - m_new); sacc += p0[r] + p1[r]; }
        } else {
            if (k0 + 63 > Qw) {
#pragma unroll
                for (int r = 0; r < 16; ++r) { const int d0_ = dbase - ((r & 3) + 8 * (r >> 2));
                    if (d0_ < 0) p0[r] = -INFINITY; if (d0_ < 32) p1[r] = -INFINITY; }
            }
            const float rm = rowmax(p0, p1);
            if (t == 0 || __any(rm > 8.0f)) {
                const float dl = (t == 0) ? rm : __builtin_fmaxf(rm, 0.f);
                alpha = __builtin_amdgcn_exp2f(-dl);
#pragma unroll
                for (int r = 0; r < 16; ++r) { p0[r] -= dl; p1[r] -= dl; negm[r] -= dl; }
                if (t != 0) {
#pragma unroll
                    for (int r = 0; r < 16; ++r) { o[0][r] *= alpha; o[1][r] *= alpha; }
                }
            }
#pragma unroll
            for (int r = 0; r < 16; ++r) { p0[r] = __builtin_amdgcn_exp2f(p0[r]); p1[r] = __builtin_amdgcn_exp2f(p1[r]); sacc += p0[r] + p1[r]; }
        }
        l_run = l_run * alpha + sacc;
        u32x4 pw[4];
#pragma unroll
        for (int j = 0; j < 4; ++j) { pw[0][j] = cvtpk(p0[2 * j], p0[2 * j + 1]); pw[1][j] = cvtpk(p0[8 + 2 * j], p0[9 + 2 * j]); pw[2][j] = cvtpk(p1[2 * j], p1[2 * j + 1]); pw[3][j] = cvtpk(p1[8 + 2 * j], p1[9 + 2 * j]); }
        const LAS unsigned char* vp = kb + voff;
        __builtin_amdgcn_s_setprio(1);
#pragma unroll
        for (int d0 = 0; d0 < 2; ++d0)
#pragma unroll
            for (int ks = 0; ks < 4; ++ks) { const s16x4 lo = vtr(vp + d0 * 4096 + ks * 1024), hh = vtr(vp + d0 * 4096 + ks * 1024 + 512);
                const bf16x8 vf = (bf16x8){lo[0], lo[1], lo[2], lo[3], hh[0], hh[1], hh[2], hh[3]};
                o[d0] = __builtin_amdgcn_mfma_f32_32x32x16_bf16(vf, __builtin_bit_cast(bf16x8, pw[ks]), o[d0], 0, 0, 0); }
        __builtin_amdgcn_s_setprio(0);
    }
#undef ATT_DMA
    { auto rr = __builtin_amdgcn_permlane32_swap(__float_as_uint(l_run), __float_as_uint(l_run), false, false); l_run = __uint_as_float(rr[0]) + __uint_as_float(rr[1]); }
    if (BAND) { if (u.has_sink) l_run += __builtin_amdgcn_exp2f(u.sink - m_run);
                if (u.has_lse) { if (hi == 0) u.lse[(long)(32 * w + r32) * u.lsestride] = m_run + __builtin_amdgcn_logf(l_run); } }
    att_store_ot(o, __builtin_amdgcn_rcpf(l_run), (LAS bf16_t*)(lds + LDS_OST) + w * 2304, u.o + (long)(32 * w) * u.ostride, u.ostride, lane);
    __syncthreads();
}

constexpr int P_LDS_WS = 3 * SLOT, P_LDS_OST = P_LDS_WS + 8 * 256, P_LDS_BYTES = P_LDS_OST + 8 * 4608;
template <int NDQ, bool FOX>
__device__ __forceinline__ void attn_unit_causal(const UnitDesc& u, LAS unsigned char* lds, const int tid) {
    const int lane = tid & 63, r32 = lane & 31, hi = lane >> 5; const int w = __builtin_amdgcn_readfirstlane(tid >> 6);
    const int q0 = u.q0, Qw = q0 + 32 * w, t_hi = (q0 + 255) >> 6, tl = (Qw + 31) >> 6;
    LAS float* wsf = (LAS float*)(lds + P_LDS_WS) + w * 64;
    const unsigned kvo = (unsigned)(lane * (int)u.kstride + w * 8) * 2u, kxo = (unsigned)(lane * (int)u.kxstride + (NDQ == 6 ? (w & 3) * 8 : 0)) * 2u;
    const unsigned vvo = (unsigned)((16 * (w & 3) + (lane >> 2)) * (int)u.kstride + (w >> 2) * 32 + (lane & 3) * 8) * 2u;
    const unsigned ldsb = (unsigned)(uintptr_t)lds + (unsigned)w * 1024u;
#define ATT_DMA(t, slot) do { const unsigned kb_ = ldsb + (unsigned)((slot) * SLOT); \
        pg8::glds_s((const char*)(u.k + (long)(t) * 64 * u.kstride), kvo, kb_); \
        if (w < 2 * (NDQ - 4)) pg8::glds_s((const char*)(u.kx + (long)(t) * 64 * u.kxstride), kxo, kb_ + 8192u); \
        pg8::glds_s((const char*)(u.v + (long)(t) * 64 * u.kstride), vvo, kb_ + (unsigned)SLOT_K); } while (0)
    ATT_DMA(0, 0);
    bf16x8 qr[NDQ];
    { const bf16_t* Qw_ = u.q + (long)(32 * w + r32) * u.qstride + hi * 8;
#pragma unroll
      for (int d0 = 0; d0 < (FOX ? 4 : NDQ); ++d0) qr[d0] = *(const bf16x8*)(Qw_ + d0 * 16);
      if (FOX) { const short one = hi ? (short)0 : (short)0x3F80; qr[NDQ - 1] = (bf16x8){one, one, one, 0, 0, 0, 0, 0}; } }
    float m_ref = -1e30f; f32x16 o[2]; float l_run = 0.f; o[0] = f32x16{}; o[1] = f32x16{};
    constexpr float THR = 30.f;
    const int koff = hi * 1024 + r32 * 16;
    const int voff = SLOT_K + ((lane >> 4) & 1) * 32 + (lane & 3) * 8 + (4 * hi + ((lane & 15) >> 2)) * 64;
    const int dq = r32 - 4 * hi;
#define ATT_KF(kbp, d0, n) (*(const LAS bf16x8*)((kbp) + koff + (d0) * 2048 + (n) * 512))
#define ATT_MASK(P0, P1, t) do { const int db_ = Qw + dq - 64 * (t); _Pragma("unroll") for (int r = 0; r < 16; ++r) { const int d_ = db_ - ((r & 3) + 8 * (r >> 2)); if (d_ < 0) P0[r] = -INFINITY; if (d_ < 32) P1[r] = -INFINITY; } } while (0)
#define ATT_SB() __builtin_amdgcn_sched_barrier(0)
#define ATT_PIN8(X0, X1, b) asm volatile("" : "+v"(X0[b]), "+v"(X0[b + 1]), "+v"(X0[b + 2]), "+v"(X0[b + 3]), "+v"(X1[b]), "+v"(X1[b + 1]), "+v"(X1[b + 2]), "+v"(X1[b + 3]))
    asm volatile("s_waitcnt vmcnt(0)" ::: "memory"); __syncthreads();
    if (t_hi >= 1) ATT_DMA(1, 1);
    f32x16 sa0 = f32x16{}, sa1 = f32x16{}, sb0, sb1;
    { const LAS unsigned char* kb = lds;
#pragma unroll
      for (int d0 = 0; d0 < NDQ; ++d0) { sa0 = __builtin_amdgcn_mfma_f32_32x32x16_bf16(ATT_KF(kb, d0, 0), qr[d0], sa0, 0, 0, 0); sa1 = __builtin_amdgcn_mfma_f32_32x32x16_bf16(ATT_KF(kb, d0, 1), qr[d0], sa1, 0, 0, 0); }
      if (tl == 0) ATT_MASK(sa0, sa1, 0); }
    int slot = 0, t = 0;
#define ATT_STEP(C0, C1, N0, N1) do { \
        const int slot1 = slot == 2 ? 0 : slot + 1, slot2 = slot1 == 2 ? 0 : slot1 + 1; \
        asm volatile("s_waitcnt vmcnt(0)" ::: "memory");                 \
        __syncthreads();                                                 \
        if (t + 2 <= t_hi) ATT_DMA(t + 2, slot2); \
        const LAS unsigned char* kbn = lds + slot1 * SLOT; const LAS unsigned char* vp = lds + slot * SLOT + voff; \
        { const float rm = rowmax(C0, C1); \
          if (__any(rm - m_ref > THR)) { const float m_new = __builtin_fmaxf(m_ref, rm), alpha = __builtin_amdgcn_exp2f(m_ref - m_new); m_ref = m_new; \
            _Pragma("unroll") for (int r = 0; r < 16; ++r) { o[0][r] *= alpha; o[1][r] *= alpha; } l_run *= alpha; } } \
        float sacc = 0.f; u32x4 pw[4]; \
        N0 = f32x16{}; N1 = f32x16{}; \
        { bf16x8 ka = ATT_KF(kbn, 0, 0), kb2 = ATT_KF(kbn, 0, 1); \
          _Pragma("unroll") for (int d0 = 0; d0 < NDQ; ++d0) { \
            bf16x8 na = ka, nb = kb2; if (d0 + 1 < NDQ) { na = ATT_KF(kbn, d0 + 1, 0); nb = ATT_KF(kbn, d0 + 1, 1); } \
            if (d0 < 4) { ATT_PIN8(C0, C1, 4 * d0); } \
            N0 = __builtin_amdgcn_mfma_f32_32x32x16_bf16(ka, qr[d0], N0, 0, 0, 0); N1 = __builtin_amdgcn_mfma_f32_32x32x16_bf16(kb2, qr[d0], N1, 0, 0, 0); \
            if (d0 < 4) { \
                _Pragma("unroll") for (int r = 4 * d0; r < 4 * d0 + 4; ++r) { C0[r] = __builtin_amdgcn_exp2f(C0[r] - m_ref); C1[r] = __builtin_amdgcn_exp2f(C1[r] - m_ref); sacc += C0[r] + C1[r]; } \
                ATT_PIN8(C0, C1, 4 * d0); asm volatile("" : "+v"(sacc)); } \
            ka = na; kb2 = nb; ATT_SB(); } } \
        l_run += sacc; \
        _Pragma("unroll") for (int j = 0; j < 4; ++j) { pw[0][j] = cvtpk(C0[2 * j], C0[2 * j + 1]); pw[1][j] = cvtpk(C0[8 + 2 * j], C0[9 + 2 * j]); pw[2][j] = cvtpk(C1[2 * j], C1[2 * j + 1]); pw[3][j] = cvtpk(C1[8 + 2 * j], C1[9 + 2 * j]); } \
        __builtin_amdgcn_s_setprio(1); \
        _Pragma("unroll") for (int ks = 0; ks < 4; ++ks) _Pragma("unroll") for (int d0 = 0; d0 < 2; ++d0) { const s16x4 lo = vtr(vp + d0 * 4096 + ks * 1024), hh = vtr(vp + d0 * 4096 + ks * 1024 + 512); \
                const bf16x8 vf = (bf16x8){lo[0], lo[1], lo[2], lo[3], hh[0], hh[1], hh[2], hh[3]}; \
                o[d0] = __builtin_amdgcn_mfma_f32_32x32x16_bf16(vf, __builtin_bit_cast(bf16x8, pw[ks]), o[d0], 0, 0, 0); \
                if (d0 == 1 && (ks & 1)) ATT_SB(); } \
        __builtin_amdgcn_s_setprio(0); \
        if (t + 1 == tl) ATT_MASK(N0, N1, t + 1); \
        slot = slot1; ++t; } while (0)
    for (; t + 1 <= tl; ) { ATT_STEP(sa0, sa1, sb0, sb1); ATT_STEP(sb0, sb1, sa0, sa1); }
    if (t <= tl) ATT_STEP(sa0, sa1, sb0, sb1);
    for (; t <= t_hi; ++t) { const int slot1 = slot == 2 ? 0 : slot + 1, slot2 = slot1 == 2 ? 0 : slot1 + 1;
        asm volatile("s_waitcnt vmcnt(0)" ::: "memory"); __syncthreads();
        if (t + 2 <= t_hi) ATT_DMA(t + 2, slot2);
        slot = slot1; }
#undef ATT_STEP
#undef ATT_DMA
#undef ATT_KF
#undef ATT_MASK
#undef ATT_SB
#undef ATT_PIN8
    { auto rr = __builtin_amdgcn_permlane32_swap(__float_as_uint(l_run), __float_as_uint(l_run), false, false); l_run = __uint_as_float(rr[0]) + __uint_as_float(rr[1]); }
    att_store_ot(o, __builtin_amdgcn_rcpf(l_run), (LAS bf16_t*)(lds + P_LDS_OST) + w * 2304, u.o + (long)(32 * w) * u.ostride, u.ostride, lane);
    __syncthreads();
}
}
namespace mk {
constexpr int NWAVES = 8, NTHREADS = 512;
constexpr int RING_BYTES = 131072, MISC_OFF = RING_BYTES, LDS_BYTES = 147456;
constexpr int MISC_PRE = MISC_OFF + 1024, MISC_CNT = MISC_PRE + 512, MISC_STASH = MISC_OFF + 2048;
constexpr int NPHASE = 17;
#define LDS_WAIT() asm volatile("s_waitcnt lgkmcnt(0)" ::: "memory")

struct Args { const float* in[21]; float* out; unsigned char* ws; float* H; int ph_lo, ph_hi; int use_bar, pad; };

typedef const __attribute__((address_space(4))) Args* cargs_t;
__device__ __forceinline__ Args load_args() {
#if defined(__HIP_DEVICE_COMPILE__)
    cargs_t p = (cargs_t)__builtin_amdgcn_kernarg_segment_ptr(); asm volatile("" : "+s"(p)); Args a;
#pragma unroll
    for (int i = 0; i < 21; ++i) a.in[i] = p->in[i];
    a.out = p->out; a.ws = p->ws; a.H = p->H; a.ph_lo = p->ph_lo; a.ph_hi = p->ph_hi; a.use_bar = p->use_bar; a.pad = 0; return a;
#else
    return Args{};
#endif
}

#define XB_TMO      128
#define XB_XCNT(j)  (256  + 64 * (j))
#define XB_XSUB(j)  (1280 + 64 * (j))
#define XB_XGEN(j)  (2304 + 64 * (j))
#define XB_TOP      3328
#define XB_TOPGEN   3392
#define XCD_BAR_WORDS 3456
#define XB_SPIN_CAP (1u << 18)
__device__ __forceinline__ unsigned xb_ld(unsigned* p)              { return __hip_atomic_load(p, __ATOMIC_RELAXED, __HIP_MEMORY_SCOPE_AGENT); }
__device__ __forceinline__ unsigned xb_add(unsigned* p, unsigned v) { return __hip_atomic_fetch_add(p, v, __ATOMIC_RELAXED, __HIP_MEMORY_SCOPE_AGENT); }
__device__ __forceinline__ unsigned xb_xcc_id() { return (unsigned)__builtin_amdgcn_s_getreg((3 << 11) | 20) & 0xFu; }
#define XB_SPIN(cond, bar) do { unsigned _sp = 0; while (cond) { __builtin_amdgcn_s_sleep(1); \
    if ((++_sp & 255u) == 0u) { if (xb_ld(&(bar)[XB_TMO])) break; if (_sp > XB_SPIN_CAP) { atomicAdd(&(bar)[XB_TMO], 1u); break; } } } } while (0)
struct XcdBarrier { unsigned* bar; unsigned x; volatile LAS unsigned* st; };
__device__ __forceinline__ XcdBarrier xcd_barrier_post(unsigned* bar, volatile LAS unsigned* st) {
    XcdBarrier b; b.bar = bar; b.x = xb_xcc_id(); b.st = st;
    if (threadIdx.x == 0) (void)xb_add(&bar[XB_XCNT(b.x)], 1u);
    return b;
}
__device__ __forceinline__ void xcd_barrier_complete(unsigned* bar, unsigned x, unsigned& nloc, unsigned& nx) {
    const unsigned G = gridDim.x * gridDim.y * gridDim.z;
    unsigned sum, cnt, mine, sp = 0u;
    for (;;) {
        sum = 0u; cnt = 0u; mine = 0u;
#pragma unroll
        for (unsigned j = 0; j < 16; ++j) { const unsigned c = xb_ld(&bar[XB_XCNT(j)]); sum += c; cnt += (c > 0u) ? 1u : 0u; mine = (j == x) ? c : mine; }
        if (sum == G) break;
        __builtin_amdgcn_s_sleep(1);
        if ((++sp & 255u) == 0u) { if (xb_ld(&bar[XB_TMO])) break; if (sp > XB_SPIN_CAP) { atomicAdd(&bar[XB_TMO], 1u); break; } }
    }
    nloc = mine > 0u ? mine : 1u; nx = cnt > 0u ? cnt : 1u;
}
__device__ __forceinline__ void xcd_barrier(const XcdBarrier& b) {
    asm volatile("s_waitcnt vmcnt(0)" ::: "memory");
    __syncthreads();
    if (threadIdx.x == 0) {
        unsigned* bar = b.bar;
        __builtin_amdgcn_s_waitcnt(0);
        unsigned nloc = b.st[0], nx = b.st[1];
        if (nloc == 0u) { xcd_barrier_complete(bar, b.x, nloc, nx); b.st[0] = nloc; b.st[1] = nx; }
        const unsigned old = xb_add(&bar[XB_XSUB(b.x)], 1u);
        const unsigned gen = old / nloc;
        if (old + 1u == (gen + 1u) * nloc) {
            __builtin_amdgcn_fence(__ATOMIC_RELEASE, "agent");
            asm volatile("s_waitcnt vmcnt(0)" ::: "memory");
            const unsigned og = xb_add(&bar[XB_TOP], 1u);
            const unsigned tg = og / nx;
            if (og + 1u == (tg + 1u) * nx) xb_add(&bar[XB_TOPGEN], 1u);
            else XB_SPIN(xb_ld(&bar[XB_TOPGEN]) == tg, bar);
            __builtin_amdgcn_fence(__ATOMIC_ACQUIRE, "agent");
            xb_add(&bar[XB_XGEN(b.x)], 1u);
            asm volatile("s_waitcnt vmcnt(0)" ::: "memory");
        } else {
            XB_SPIN(xb_ld(&bar[XB_XGEN(b.x)]) == gen, bar);
            __builtin_amdgcn_fence(__ATOMIC_ACQUIRE, "agent");
            asm volatile("s_waitcnt vmcnt(0)" ::: "memory");
        }
    }
    __syncthreads();
}
constexpr int MISC_BAR = MISC_OFF + 64;
__device__ __forceinline__ void grid_barrier(const Args& a, LAS unsigned char* lds) {
    XcdBarrier b; b.bar = (unsigned*)(a.ws + WS_CTL) + CW_BAR; b.x = xb_xcc_id(); b.st = (volatile LAS unsigned*)(lds + MISC_BAR);
    xcd_barrier(b);
}
__device__ __forceinline__ float wave_sum(float v) {
#pragma unroll
    for (int o = 1; o < 64; o <<= 1) v += __shfl_xor(v, o);
    return v;
}
__device__ __forceinline__ void tr_item(const float* src, int lds_, int ncols, const float* scale, bf16_t* dst, int ldd, LAS float* scr, int lane) {
    float v[32]; const int c0 = lane & 31, kh = lane >> 5;
#pragma unroll
    for (int i = 0; i < 32; ++i) v[i] = (src && c0 < ncols) ? src[(size_t)(2 * i + kh) * lds_ + c0] : 0.f;
    const int c = lane & 7; f32x4 s0 = (f32x4){1.f, 1.f, 1.f, 1.f}, s1 = s0;
    if (scale) { s0 = *(const f32x4*)(scale + 8 * c); s1 = *(const f32x4*)(scale + 8 * c + 4); }
#pragma unroll
    for (int i = 0; i < 32; ++i) scr[(2 * i + kh) * 33 + c0] = v[i];
    LDS_WAIT(); asm volatile("" ::: "memory");
#pragma unroll
    for (int j = 0; j < 4; ++j) { const int n = (lane >> 3) + 8 * j; const LAS float* s = scr + (8 * c) * 33 + n;
        u32x4 o; o.x = cvtpk(s[0 * 33] * s0[0], s[1 * 33] * s0[1]); o.y = cvtpk(s[2 * 33] * s0[2], s[3 * 33] * s0[3]); o.z = cvtpk(s[4 * 33] * s1[0], s[5 * 33] * s1[1]); o.w = cvtpk(s[6 * 33] * s1[2], s[7 * 33] * s1[3]);
        st16s(dst + (size_t)n * ldd + 8 * c, 0, o); }
    LDS_WAIT(); asm volatile("" ::: "memory");
}
struct TrMat { const float* W; int K, ldw; const float* scale; bf16_t* WT; int nblk; int kind; };
__device__ __forceinline__ int tr_srccol(int kind, int n0) {
    switch (kind) {
    case 0: return n0;
    case 1: return n0 < 1536 ? n0 : n0 + 8;
    case 2: return n0 < 384 ? n0 : (n0 < 416 ? n0 + 256 : (n0 < 512 ? -1 : (n0 < 768 ? n0 - 128 : n0 - 96)));
    default: return n0; }
}
__device__ __forceinline__ void tr_mat_item(const TrMat& m, int item, LAS float* scr, int lane) {
    const int kb = item / m.nblk, nb = item % m.nblk, k0 = 64 * kb, n0 = 32 * nb; const int sc = tr_srccol(m.kind, n0);
    tr_item(sc < 0 ? nullptr : m.W + (size_t)k0 * m.ldw + sc, m.ldw, 32, m.scale ? m.scale + k0 : nullptr, m.WT + (size_t)n0 * m.K + k0, m.K, scr, lane);
}

__device__ __forceinline__ void dense_mats(const Args& a, TrMat (&M)[6]) {
    unsigned char* ws = a.ws; const float* attn_norm = a.in[1];
    M[0] = TrMat{a.in[4], 1024, 3080, attn_norm, (bf16_t*)(ws + WS_WIN0), 96, 1};
    M[1] = TrMat{a.in[6], 1024, 1024, nullptr, (bf16_t*)(ws + WS_WOUT0), 32, 0};
    M[2] = TrMat{a.in[7], 1024, 1440, attn_norm + 1024, (bf16_t*)(ws + WS_WIN1), 48, 2};
    M[3] = TrMat{a.in[10], 384, 768, a.in[8], (bf16_t*)(ws + WS_WUQ), 24, 0};
    M[4] = TrMat{a.in[11], 256, 1024, a.in[9], (bf16_t*)(ws + WS_WUKV), 32, 0};
    M[5] = TrMat{a.in[13], 1024, 1024, nullptr, (bf16_t*)(ws + WS_WOUT1), 32, 0};
}
__device__ __forceinline__ void router_item(const Args& a, int it, LAS float* scr, int lane) {
    const float* ffn_norm = a.in[2]; const int l = it >> 5, r = it & 31, kb = r >> 1, nb = r & 1, k0 = 64 * kb;
    bf16_t* dst = (bf16_t*)(a.ws + WS_WR) + (size_t)l * 64 * 1024 + (size_t)(32 * nb) * 1024 + k0;
    if (nb == 0) tr_item(a.in[16] + (size_t)l * 1024 * 32 + (size_t)k0 * 32, 32, 32, ffn_norm + l * 1024 + k0, dst, 1024, scr, lane);
    else tr_item(a.in[14] + (size_t)l * 1024 * 4 + (size_t)k0 * 4, 4, 4, ffn_norm + l * 1024 + k0, dst, 1024, scr, lane);
}
template <int PART>
__device__ __forceinline__ void p0_prologue(const Args& a, LAS unsigned char* lds, int gw, int NGW, int wave, int lane) {
    unsigned char* ws = a.ws; LAS float* scr = (LAS float*)(lds + wave * 16384);
    const float* attn_norm = a.in[1];
    TrMat M[6]; dense_mats(a, M);
    const int cnt[6] = {16 * 96, 16 * 32, 16 * 48, 6 * 24, 4 * 32, 16 * 32};
    int base = 0;
#pragma unroll
    for (int mi = 0; mi < 6; ++mi) { if ((mi == 0) == (PART == 0)) { for (int it = (gw + NGW - base % NGW) % NGW; it < cnt[mi]; it += NGW) tr_mat_item(M[mi], it, scr, lane); base += cnt[mi]; } }
    if (PART == 1) for (int it = gw; it < 64; it += NGW) router_item(a, it, scr, lane);
    if (PART == 1) { f32x2* rope = (f32x2*)(ws + WS_ROPE);
      for (int i = gw * 64 + lane; i < S * 16; i += NGW * 64) { const int pos = i >> 4, j = i & 15; const float inv = powf(10000.0f, -(float)(2 * j) / 32.0f), ang = (float)pos * inv; float sn, cs; sincosf(ang, &sn, &cs); rope[i] = (f32x2){cs, sn}; } }
    if (PART == 0) { const float* x = a.in[0]; const float* win = a.in[4]; const float* bfp = a.in[5];
      bf16_t* XB = (bf16_t*)(ws + WS_XB); float* SS = (float*)(ws + WS_SS); float* LOGF = (float*)(ws + WS_LOGF);
      float wz[4][4][8];
#pragma unroll
      for (int j = 0; j < 4; ++j)
#pragma unroll
          for (int e = 0; e < 4; ++e) { const int k = 256 * j + 4 * lane + e; const float g = attn_norm[k]; const f32x4 w0 = *(const f32x4*)(win + (size_t)k * 3080 + 1536), w1 = *(const f32x4*)(win + (size_t)k * 3080 + 1540);
#pragma unroll
              for (int h = 0; h < 4; ++h) { wz[j][e][h] = w0[h] * g; wz[j][e][4 + h] = w1[h] * g; } }
      for (int row = gw; row < N; row += NGW) {
          const f32x4* xr = (const f32x4*)(x + (size_t)row * D) + lane; f32x4 v[4]; float ssq = 0.f; float zf[8];
#pragma unroll
          for (int h = 0; h < 8; ++h) zf[h] = 0.f;
#pragma unroll
          for (int j = 0; j < 4; ++j) { v[j] = xr[64 * j]; ssq += (v[j][0] * v[j][0] + v[j][1] * v[j][1]) + (v[j][2] * v[j][2] + v[j][3] * v[j][3]);
#pragma unroll
              for (int e = 0; e < 4; ++e)
#pragma unroll
                  for (int h = 0; h < 8; ++h) zf[h] += v[j][e] * wz[j][e][h]; }
          ssq = wave_sum(ssq);
#pragma unroll
          for (int h = 0; h < 8; ++h) zf[h] = wave_sum(zf[h]);
          u32x2* o8 = (u32x2*)(XB + (size_t)row * D) + lane;
#pragma unroll
          for (int j = 0; j < 4; ++j) { u32x2 wv; wv.x = cvtpk(v[j][0], v[j][1]); wv.y = cvtpk(v[j][2], v[j][3]); st8s(o8, 512 * j, wv); }
          if (lane == 0) SS[row] = ssq;
          const float rstd = 1.f / sqrtf(ssq * (1.f / D) + EPS);
          float zsel = zf[0];
#pragma unroll
          for (int h = 1; h < 8; ++h) zsel = (lane == h) ? zf[h] : zsel;
          if (lane < 8) { const float xg = zsel * rstd + bfp[lane]; LOGF[(size_t)row * 8 + lane] = fminf(xg, 0.f) - log1pf(expf(-fabsf(xg))); }
      } }
}
__device__ __forceinline__ void fox_cumsum(const Args& a, LAS unsigned char* lds, int G, const int tid) {
    const float* LOGF = (const float*)(a.ws + WS_LOGF); float* KB = (float*)(a.ws + WS_CB2); u32x4* KX = (u32x4*)(a.ws + WS_KEXT); LAS float* part = (LAS float*)lds;
    const int t = tid, lane = t & 63, wv = t >> 6;
    for (int bh = blockIdx.x; bh < 32; bh += G) { const int b = bh >> 3, h = bh & 7; float loc[8]; float run = 0.f;
#pragma unroll
        for (int i = 0; i < 8; ++i) { run += LOGF[(size_t)(b * S + t * 8 + i) * 8 + h]; loc[i] = run; }
        float inc = run;
#pragma unroll
        for (int o = 1; o < 64; o <<= 1) { const float up = __shfl_up(inc, o); if (lane >= o) inc += up; }
        __syncthreads();
        if (lane == 63) part[wv] = inc;
        __syncthreads();
        float off = inc - run;
        for (int i = 0; i < wv; ++i) off += part[i];
#pragma unroll
        for (int i = 0; i < 8; ++i) { const float kb = -LOG2E * (loc[i] + off); KB[(size_t)bh * S + t * 8 + i] = kb;
            const unsigned h1 = cvtpk(kb, 0.f) & 0xffffu; const float r1 = kb - bflo(h1); const unsigned h2 = cvtpk(r1, 0.f) & 0xffffu; const float r2 = r1 - bflo(h2); const unsigned h3 = cvtpk(r2, 0.f) & 0xffffu;
            KX[(size_t)bh * S + t * 8 + i] = (u32x4){h1 | (h2 << 16), h3, 0u, 0u}; }
    }
    __syncthreads();
}
__device__ __forceinline__ void attn_phase0(const Args& a, LAS unsigned char* lds, int vcu, int G, const int tid) {
    const bf16_t* QKV = (const bf16_t*)(a.ws + R1_QKV0); bf16_t* AO = (bf16_t*)(a.ws + R2_AO); bf16_t* DP = (bf16_t*)(a.ws + R2_DPART);
    float* DLSE = (float*)(a.ws + WS_DLSE); const float* KB = (const float*)(a.ws + WS_CB2);
    for (int it = vcu; it < 256 + 1536; it += G) {
        if (it < 256) { const int bh = it >> 3, s = it & 7, b = bh >> 3, h = bh & 7;
            for (int half = 0; half < 2; ++half) { const int qb = half ? 15 - s : s; att::UnitDesc u{};
                const bf16_t* base = QKV + (size_t)b * S * 3072 + h * 64;
                u.q = base + (size_t)(qb * 256) * 3072; u.qstride = 3072; u.k = base + 512; u.v = base + 1024; u.kstride = 3072;
                u.o = AO + (size_t)(b * S + qb * 256) * 1024 + h * 64; u.ostride = 1024; u.kbias = KB + (size_t)bh * S; u.kx = (const bf16_t*)(a.ws + WS_KEXT) + (size_t)bh * S * 8; u.kxstride = 8; u.q0 = qb * 256; u.W = 1 << 30;
                { int tid_ = tid; asm volatile("" : "+v"(tid_)); att::attn_unit_causal<5, true>(u, lds, tid_); } }
        } else { const int j = it - 256, bh = j / 48, rem = j % 48, br = rem >> 4, idx = rem & 15, b = bh >> 3, h = bh & 7;
            const int dil = br == 0 ? 1 : (br == 1 ? 4 : 16), c = br == 0 ? 0 : (br == 1 ? idx >> 2 : idx), qblk = br == 0 ? idx : (br == 1 ? idx & 3 : 0);
            att::UnitDesc u{}; const bf16_t* base = QKV + (size_t)(b * S + c) * 3072 + 1536 + h * 64; const long st = (long)dil * 3072;
            u.q = base + (size_t)(qblk * 256) * st; u.qstride = st; u.k = base + 512; u.v = base + 1024; u.kstride = st;
            const size_t tok0 = (size_t)b * S + c + (size_t)qblk * 256 * dil;
            u.o = DP + (size_t)br * N * 512 + tok0 * 512 + h * 64; u.ostride = (long)dil * 512;
            u.lse = DLSE + (size_t)br * N * 8 + tok0 * 8 + h; u.lsestride = (long)dil * 8; u.has_lse = true;
            u.q0 = qblk * 256; u.W = 128; u.alibi = exp2f(-(float)(h + 1)) * (float)dil * LOG2E;
            { int tid_ = tid; asm volatile("" : "+v"(tid_)); att::attn_unit<4, false, true>(u, lds, tid_); } }
    }
}
__device__ __forceinline__ void attn_phase1(const Args& a, LAS unsigned char* lds, int vcu, int G, const int tid) {
    const bf16_t* Z1 = (const bf16_t*)(a.ws + R1_Z1); const bf16_t* Q1 = (const bf16_t*)(a.ws + R1_Q1); const bf16_t* KV = (const bf16_t*)(a.ws + R1_KV1);
    bf16_t* AO = (bf16_t*)(a.ws + R2_AO); const float* sinks = a.in[12];
    for (int it = vcu; it < 256 + 512; it += G) {
        if (it < 256) { const int bh = it >> 3, s = it & 7, b = bh >> 3, h = bh & 7;
            for (int half = 0; half < 2; ++half) { const int qb = half ? 15 - s : s; att::UnitDesc u{};
                u.q = Q1 + (size_t)(b * S + qb * 256) * 768 + h * 96; u.qstride = 768;
                u.k = KV + (size_t)b * S * 1024 + h * 128; u.v = u.k + 64; u.kstride = 1024; u.kx = Z1 + (size_t)b * S * 1536 + 384; u.kxstride = 1536;
                u.o = AO + (size_t)(b * S + qb * 256) * 1024 + h * 64; u.ostride = 1024; u.q0 = qb * 256; u.W = 1 << 30;
                { int tid_ = tid; asm volatile("" : "+v"(tid_)); att::attn_unit_causal<6, false>(u, lds, tid_); } }
        } else { const int j = it - 256, b = j >> 7, hq = (j >> 4) & 7, qb = j & 15, kvh = hq >> 2; att::UnitDesc u{};
            const bf16_t* base = Z1 + (size_t)b * S * 1536;
            u.q = base + (size_t)(qb * 256) * 1536 + 768 + hq * 64; u.qstride = 1536; u.k = base + 1280 + kvh * 64; u.v = base + 1408 + kvh * 64; u.kstride = 1536;
            u.o = AO + (size_t)(b * S + qb * 256) * 1024 + 512 + hq * 64; u.ostride = 1024; u.q0 = qb * 256; u.W = 127;
            u.alibi = exp2f(-(float)(hq + 1)) * LOG2E; u.has_sink = true; u.sink = sinks[hq] * LOG2E;
            { int tid_ = tid; asm volatile("" : "+v"(tid_)); att::attn_unit<4, false, true>(u, lds, tid_); } }
    }
}
__device__ __forceinline__ void merge_phase(const Args& a, int gw, int NGW, int lane) {
    const bf16_t* DP = (const bf16_t*)(a.ws + R2_DPART); const float* DLSE = (const float*)(a.ws + WS_DLSE); bf16_t* AO = (bf16_t*)(a.ws + R2_AO);
    for (int tok = gw; tok < N; tok += NGW) { const int h = lane >> 3;
        const float l0 = DLSE[(size_t)tok * 8 + h], l1 = DLSE[(size_t)N * 8 + (size_t)tok * 8 + h], l2 = DLSE[(size_t)2 * N * 8 + (size_t)tok * 8 + h];
        const float mx = fmaxf(l0, fmaxf(l1, l2)); float w0 = exp2f(l0 - mx), w1 = exp2f(l1 - mx), w2 = exp2f(l2 - mx); const float inv = 1.f / (w0 + w1 + w2); w0 *= inv; w1 *= inv; w2 *= inv;
        const u32x4 a0 = *(const u32x4*)(DP + (size_t)tok * 512 + lane * 8), a1 = *(const u32x4*)(DP + (size_t)N * 512 + (size_t)tok * 512 + lane * 8), a2 = *(const u32x4*)(DP + (size_t)2 * N * 512 + (size_t)tok * 512 + lane * 8);
        u32x4 o;
#pragma unroll
        for (int i = 0; i < 4; ++i) { const float lo = w0 * bflo(a0[i]) + w1 * bflo(a1[i]) + w2 * bflo(a2[i]), hi = w0 * bfhi(a0[i]) + w1 * bfhi(a1[i]) + w2 * bfhi(a2[i]); o[i] = cvtpk(lo, hi); }
        st16s(AO + (size_t)tok * 1024 + 512 + lane * 8, 0, o); }
}
__device__ __forceinline__ void route_phase(const Args& a, int layer, LAS unsigned char* lds, int vcu, int G, int wave, int lane) {
    const bf16_t* HB = (const bf16_t*)(a.ws + WS_XB); const bf16_t* WR = (const bf16_t*)(a.ws + WS_WR) + (size_t)layer * 64 * 1024;
    const float* SSP = (const float*)(a.ws + WS_SSP); const float* bg = a.in[15] + layer * 4; const float* br = a.in[17] + layer * 32;
    unsigned* cnt = (unsigned*)(a.ws + WS_CTL) + CW_CNT + layer * 1024;
    unsigned* LT = (unsigned*)(a.ws + WS_LT); float* LW = (float*)(a.ws + WS_LW); float* LR = (float*)(a.ws + WS_LR);
    const int r32 = lane & 31, hi = lane >> 5, kq = wave & 3, half = wave >> 2;
    for (int b0 = vcu * 2; b0 < N / 32; b0 += G * 2) {
        const int blk = b0 + half; const bool live = blk < N / 32; const int tok = (live ? blk : 0) * 32 + r32;
        f32x16 c0 = f32x16{}, c1 = f32x16{}; int E_ = 0, myrank_ = 0, mycnt_ = 0; float wsel_ = 0.f, rstd_ = 0.f;
        const bf16_t* xb = HB + (size_t)tok * 1024 + kq * 256 + hi * 8; const bf16_t* wa = WR + (size_t)r32 * 1024 + kq * 256 + hi * 8;
        if (live) {
#pragma unroll 8
            for (int k0 = 0; k0 < 256; k0 += 16) { const bf16x8 bx = *(const bf16x8*)(xb + k0), a0 = *(const bf16x8*)(wa + k0), a1 = *(const bf16x8*)(wa + 32 * 1024 + k0);
                c0 = __builtin_amdgcn_mfma_f32_32x32x16_bf16(a0, bx, c0, 0, 0, 0); c1 = __builtin_amdgcn_mfma_f32_32x32x16_bf16(a1, bx, c1, 0, 0, 0); } }
        LAS f32x4* red = (LAS f32x4*)(lds + wave * 16384 + 9216) + lane * 5;
        if (kq != 0) { red[0] = (f32x4){c0[0], c0[1], c0[2], c0[3]}; red[1] = (f32x4){c0[4], c0[5], c0[6], c0[7]}; red[2] = (f32x4){c0[8], c0[9], c0[10], c0[11]}; red[3] = (f32x4){c0[12], c0[13], c0[14], c0[15]}; red[4] = (f32x4){c1[0], c1[1], c1[2], c1[3]}; }
        __syncthreads();
        if (kq == 0 && live) {
#pragma unroll
            for (int q = 1; q < 4; ++q) { const LAS f32x4* rq = (const LAS f32x4*)(lds + (wave + q) * 16384 + 9216) + lane * 5;
#pragma unroll
                for (int g = 0; g < 4; ++g) { const f32x4 t = rq[g]; c0[4 * g] += t[0]; c0[4 * g + 1] += t[1]; c0[4 * g + 2] += t[2]; c0[4 * g + 3] += t[3]; }
                const f32x4 t = rq[4]; c1[0] += t[0]; c1[1] += t[1]; c1[2] += t[2]; c1[3] += t[3]; }
            const f32x4* sp = (const f32x4*)(SSP + (size_t)tok * 16); const f32x4 s0 = sp[0], s1 = sp[1], s2 = sp[2], s3 = sp[3];
            const float ssq = ((s0[0] + s0[1]) + (s0[2] + s0[3])) + ((s1[0] + s1[1]) + (s1[2] + s1[3])) + ((s2[0] + s2[1]) + (s2[2] + s2[3])) + ((s3[0] + s3[1]) + (s3[2] + s3[3]));
            const float rstd = 1.f / sqrtf(ssq * (1.f / 1024.f) + EPS);
            float gl[4];
#pragma unroll
            for (int j = 0; j < 4; ++j) { const float mine = c1[j]; const float other = __shfl_xor(mine, 32); gl[j] = (hi == 0 ? mine : other) * rstd + bg[j]; }
            int gi = 0; float gm = gl[0];
#pragma unroll
            for (int j = 1; j < 4; ++j) if (gl[j] > gm) { gm = gl[j]; gi = j; }
            float den = 0.f;
#pragma unroll
            for (int j = 0; j < 4; ++j) den += __expf(gl[j] - gm);
            const float gwt = 1.f / den;
            float mine4[4];
#pragma unroll
            for (int j = 0; j < 4; ++j) { float v = c0[j]; v = (gi == 1) ? c0[4 + j] : v; v = (gi == 2) ? c0[8 + j] : v; v = (gi == 3) ? c0[12 + j] : v; mine4[j] = v; }
            float el[8];
#pragma unroll
            for (int j = 0; j < 4; ++j) { const float other = __shfl_xor(mine4[j], 32); el[j] = (hi == 0 ? mine4[j] : other); el[4 + j] = (hi == 0 ? other : mine4[j]); }
#pragma unroll
            for (int j = 0; j < 8; ++j) el[j] = el[j] * rstd + br[gi * 8 + j];
            int i1 = 0; float v1 = el[0];
#pragma unroll
            for (int j = 1; j < 8; ++j) if (el[j] > v1) { v1 = el[j]; i1 = j; }
            int i2 = -1; float v2 = -INFINITY;
#pragma unroll
            for (int j = 0; j < 8; ++j) if (j != i1 && el[j] > v2) { v2 = el[j]; i2 = j; }
            const float e2 = __expf(v2 - v1); const float w1 = gwt / (1.f + e2), w2 = gwt * e2 / (1.f + e2);
            const int E = gi * 8 + (hi == 0 ? i1 : i2); const float wsel = hi == 0 ? w1 : w2;
            int myrank = 0, mycnt = 0; const unsigned long long ltmask = (1ull << lane) - 1ull;
#pragma unroll 4
            for (int j = 0; j < 32; ++j) { const unsigned long long mj = __ballot(E == j); if (E == j) myrank = __popcll(mj & ltmask); if (lane == j) mycnt = __popcll(mj); }
            E_ = E; wsel_ = wsel; rstd_ = rstd; myrank_ = myrank; mycnt_ = mycnt;
        }
        LAS unsigned* ag = (LAS unsigned*)(lds + MISC_OFF + 256);
        if (kq == 0 && half == 1 && lane < 32) ag[lane] = live ? (unsigned)mycnt_ : 0u;
        __syncthreads();
        unsigned basev = 0;
        if (kq == 0 && half == 0 && lane < 32) { const unsigned mine = live ? (unsigned)mycnt_ : 0u, tot = mine + ag[lane];
            if (tot > 0u) basev = atomicAdd(cnt + lane * 16, tot);
            ag[32 + lane] = basev + mine; }
        __syncthreads();
        if (kq == 0 && live) {
            if (half == 1 && lane < 32) basev = ag[32 + lane];
            const unsigned base = (unsigned)__shfl((int)basev, E_);
            const size_t pos = (size_t)E_ * N + base + myrank_;
            LT[pos] = (unsigned)tok | ((unsigned)hi << 31); LW[pos] = wsel_; LR[pos] = rstd_;
        }
        __syncthreads();
    }
}
constexpr int MOE_CONV_ITEMS = 32 * 256 + 32 * 128;
struct TrDesc { const float* src; int lds_; const float* scale; bf16_t* dst; int ldd; };
__device__ __forceinline__ TrDesc moe_desc(const Args& a, int layer, int it) {
    const float* wg = a.in[18] + (size_t)layer * 32 * 1024 * 256; const float* wu = a.in[19] + (size_t)layer * 32 * 1024 * 256; const float* wd = a.in[20] + (size_t)layer * 32 * 256 * 1024;
    const float* g = a.in[2] + layer * 1024; bf16_t* WGU = (bf16_t*)(a.ws + (layer ? R2_WGU1 : R1_WGU)); bf16_t* WD = (bf16_t*)(a.ws + (layer ? R2_WD1 : R1_WD));
    if (it < 32 * 256) { const int e = it >> 8, r = it & 255, kb = r >> 4, nb = r & 15, k0 = 64 * kb, n0 = 32 * nb;
        const int t = n0 >> 8, s = (n0 >> 7) & 1, j = n0 & 127; const float* src = (s ? wu : wg) + (size_t)e * 1024 * 256 + (size_t)k0 * 256 + 128 * t + j;
        return TrDesc{src, 256, g + k0, WGU + ((size_t)e * 512 + n0) * 1024 + k0, 1024};
    } else { const int i2 = it - 32 * 256, e = i2 >> 7, r = i2 & 127, kb = r >> 5, nb = r & 31, k0 = 64 * kb, n0 = 32 * nb;
        return TrDesc{wd + (size_t)e * 256 * 1024 + (size_t)k0 * 1024 + n0, 1024, nullptr, WD + ((size_t)e * 1024 + n0) * 256 + k0, 256}; }
}
__device__ __forceinline__ void tr_load(const TrDesc& d, float (&v)[32], int lane) {
    const int c0 = lane & 31, kh = lane >> 5;
#pragma unroll
    for (int i = 0; i < 32; ++i) v[i] = d.src[(size_t)(2 * i + kh) * d.lds_ + c0];
}
__device__ __forceinline__ void tr_store(const TrDesc& d, const float (&v)[32], LAS float* scr, int lane) {
    const int c0 = lane & 31, kh = lane >> 5, c = lane & 7; f32x4 s0 = (f32x4){1.f, 1.f, 1.f, 1.f}, s1 = s0;
    if (d.scale) { s0 = *(const f32x4*)(d.scale + 8 * c); s1 = *(const f32x4*)(d.scale + 8 * c + 4); }
#pragma unroll
    for (int i = 0; i < 32; ++i) scr[(2 * i + kh) * 33 + c0] = v[i];
    LDS_WAIT(); asm volatile("" ::: "memory");
#pragma unroll
    for (int j = 0; j < 4; ++j) { const int n = (lane >> 3) + 8 * j; const LAS float* s = scr + (8 * c) * 33 + n;
        u32x4 o; o.x = cvtpk(s[0 * 33] * s0[0], s[1 * 33] * s0[1]); o.y = cvtpk(s[2 * 33] * s0[2], s[3 * 33] * s0[3]); o.z = cvtpk(s[4 * 33] * s1[0], s[5 * 33] * s1[1]); o.w = cvtpk(s[6 * 33] * s1[2], s[7 * 33] * s1[3]);
        st16s(d.dst + (size_t)n * d.ldd + 8 * c, 0, o); }
    LDS_WAIT(); asm volatile("" ::: "memory");
}
__device__ __forceinline__ void moe_convert(const Args& a, int layer, LAS unsigned char* lds, int gw, int NGW, int wave, int lane) {
    LAS float* scr = (LAS float*)(lds + wave * 16384);
    int it = gw; if (it >= MOE_CONV_ITEMS) return;
    TrDesc da = moe_desc(a, layer, it), db = da; float va[32], vb[32]; tr_load(da, va, lane);
    for (;;) {
        const int it2 = it + NGW; const bool h2 = it2 < MOE_CONV_ITEMS;
        if (h2) { db = moe_desc(a, layer, it2); tr_load(db, vb, lane); }
        tr_store(da, va, scr, lane); if (!h2) break;
        const int it3 = it2 + NGW; const bool h3 = it3 < MOE_CONV_ITEMS;
        if (h3) { da = moe_desc(a, layer, it3); tr_load(da, va, lane); }
        tr_store(db, vb, scr, lane); if (!h3) break;
        it = it3; }
}
__device__ __forceinline__ void combine_phase(const Args& a, bool last, int gw, int NGW, int lane) {
    const bf16_t* Y = (const bf16_t*)(a.ws + (last ? Y1_BASE : R2_Y)); bf16_t* XB = (bf16_t*)(a.ws + WS_XB); float* SS = (float*)(a.ws + WS_SS); const float* g = a.in[3];
    for (int row = gw; row < N; row += NGW) {
        u32x2* xr = (u32x2*)(XB + (size_t)row * D) + lane; const u32x2* y0 = (const u32x2*)(Y + (size_t)row * D) + lane; const u32x2* y1 = (const u32x2*)(Y + (size_t)N * D + (size_t)row * D) + lane;
        f32x4 v[4]; float ssq = 0.f; u32x2 hx[4], p[4], q[4];
#pragma unroll
        for (int j = 0; j < 4; ++j) { hx[j] = xr[64 * j]; p[j] = y0[64 * j]; q[j] = y1[64 * j]; }
#pragma unroll
        for (int j = 0; j < 4; ++j) {
            v[j][0] = bflo(hx[j].x) + bflo(p[j].x) + bflo(q[j].x); v[j][1] = bfhi(hx[j].x) + bfhi(p[j].x) + bfhi(q[j].x); v[j][2] = bflo(hx[j].y) + bflo(p[j].y) + bflo(q[j].y); v[j][3] = bfhi(hx[j].y) + bfhi(p[j].y) + bfhi(q[j].y);
            ssq += (v[j][0] * v[j][0] + v[j][1] * v[j][1]) + (v[j][2] * v[j][2] + v[j][3] * v[j][3]); }
        ssq = wave_sum(ssq);
        if (!last) {
#pragma unroll
            for (int j = 0; j < 4; ++j) { u32x2 wv; wv.x = cvtpk(v[j][0], v[j][1]); wv.y = cvtpk(v[j][2], v[j][3]); st8s(xr, 512 * j, wv); }
            if (lane == 0) SS[row] = ssq;
        } else { const float rstd = 1.f / sqrtf(ssq * (1.f / D) + EPS); f32x4* orow = (f32x4*)(a.out + (size_t)row * D) + lane;
#pragma unroll
            for (int j = 0; j < 4; ++j) { const f32x4 gg = ((const f32x4*)g)[lane + 64 * j]; st16fs(orow, 1024 * j, v[j] * rstd * gg); } }
    }
}
__device__ __forceinline__ void moe_tables(const Args& a, int layer, LAS unsigned char* lds, const int tid) {
    LAS int* pre = (LAS int*)(lds + MISC_PRE); LAS int* cn = (LAS int*)(lds + MISC_CNT);
    const unsigned* cnt = (const unsigned*)(a.ws + WS_CTL) + CW_CNT + layer * 1024;
    __syncthreads();
    if (tid < 64) {
        const int e = tid & 31; const int c = (int)__hip_atomic_load(cnt + e * 16, __ATOMIC_RELAXED, __HIP_MEMORY_SCOPE_AGENT);
        const int tiles = (c + 255) >> 8, full = c >> 8, tail = c & 255; int pt = tiles, pf = full;
#pragma unroll
        for (int o = 1; o < 32; o <<= 1) { const int ut = __shfl_up(pt, o, 32), uf = __shfl_up(pf, o, 32); if (e >= o) { pt += ut; pf += uf; } }
        int rank = 0, ntail = 0;
#pragma unroll 8
        for (int j = 0; j < 32; ++j) { const int tj = __shfl(tail, j, 32); ntail += tj ? 1 : 0; rank += (tj > tail || (tj == tail && j < e)) ? 1 : 0; }
        if (tid < 32) { cn[e] = c; pre[e] = pt - tiles; pre[40 + e] = pf - full; if (tail) pre[80 + rank] = e;
            if (e == 31) { pre[32] = pt; pre[72] = pf; pre[112] = ntail; } }
    }
    __syncthreads();
}

__global__ void __launch_bounds__(NTHREADS, 2) mega(Args args) {
    extern __shared__ __attribute__((aligned(16))) unsigned char lds_raw[];
    LAS unsigned char* lds = (LAS unsigned char*)lds_raw;
    const int G = gridDim.x;
    const int lo = args.ph_lo, hi = args.ph_hi;
    if (args.use_bar) { if (threadIdx.x < 2) ((volatile LAS unsigned*)(lds + MISC_BAR))[threadIdx.x] = 0u; __syncthreads();
        (void)xcd_barrier_post((unsigned*)(args.ws + WS_CTL) + CW_BAR, (volatile LAS unsigned*)(lds + MISC_BAR)); }
#define IN(k) (lo <= (k) && (k) < hi)
#define SEAM(k) do { if (IN(k) && IN((k) + 1)) { const Args ba_ = load_args(); grid_barrier(ba_, lds); } } while (0)
#define LA() const Args args = load_args(); unsigned char* ws = args.ws; (void)ws; int tid = threadIdx.x; asm volatile("" : "+v"(tid)); int bx = blockIdx.x; asm volatile("" : "+s"(bx)); \
    const int lane = tid & 63, wave = __builtin_amdgcn_readfirstlane(tid >> 6), vcu = (G % 8 == 0) ? (bx % 8) * (G / 8) + bx / 8 : bx, gw = vcu * NWAVES + wave, NGW = G * NWAVES; (void)lane; (void)gw; (void)NGW
    if (IN(0)) { LA(); p0_prologue<0>(args, lds, gw, NGW, wave, lane); }
    SEAM(0);
    if (IN(1)) {
#pragma nounroll
        for (int pass = 0; pass < 2; ++pass) {
            { LA(); const int nfc = G > 64 ? 32 : 0;
              if (pass == (vcu & 1) && bx >= nfc) { __syncthreads(); p0_prologue<1>(args, lds, (bx - nfc) * NWAVES + wave, (G - nfc) * NWAVES, wave, lane); __syncthreads(); } }
            if (pass == 0) { LA(); fox_cumsum(args, lds, G, tid);
                pg8::Dense P; P.init((const bf16_t*)(ws + WS_XB), 1024, (const bf16_t*)(ws + WS_WIN0), N, 3072, 1024, G, bx);
                pg8::EpiQkv0 E{(bf16_t*)(ws + R1_QKV0), (const float*)(ws + WS_SS)};
                pg8::gemm_phase<pg8::EpiQkv0, pg8::Dense, false>(lds, P, E, tid); }
        }
    }
    SEAM(1);
    if (IN(2)) { LA(); attn_phase0(args, lds, vcu, G, tid); }
    SEAM(2);
#ifndef CONV_IN_WOUT
#define CONV_IN_WOUT 3
#endif
    if (IN(3)) { LA(); merge_phase(args, gw, NGW, lane); if (!(CONV_IN_WOUT & 1)) moe_convert(args, 0, lds, gw, NGW, wave, lane); }
    SEAM(3);
    for (int layer = 0; layer < 2; ++layer) {
        const int pb = layer == 0 ? 4 : 12;
        if (layer == 1) {
            if (IN(9)) { LA();
                unsigned* rdy = (unsigned*)(ws + WS_CTL) + CW_RDY2;
                { pg8::DenseT<1> P; P.init((const bf16_t*)(ws + WS_XB), 1024, (const bf16_t*)(ws + WS_WIN1), N, 1536, 1024, G, bx); P.ready = rdy;
                  pg8::EpiWin1 E{(bf16_t*)(ws + R1_Z1), (const float*)(ws + WS_SS), (float*)(ws + WS_SSZ), (const f32x2*)(ws + WS_ROPE)};
                  pg8::gemm_phase<pg8::EpiWin1, pg8::DenseT<1>, false>(lds, P, E, tid); }
                { const int ce = bx >= 128 ? bx - 128 : (bx >= 64 ? 64 + bx : (1 << 20));
                  pg8::DenseT<2> P; P.init((const bf16_t*)(ws + R1_Z1), 1536, (const bf16_t*)(ws + WS_WUQ), N, 768, 384, 1 << 20, ce); P.ready = rdy; P.need = 16u; P.sel = 0;
                  pg8::EpiUq E{(bf16_t*)(ws + R1_Q1), (const float*)(ws + WS_SSZ), (const f32x2*)(ws + WS_ROPE)};
                  int tid2 = threadIdx.x; asm volatile("" : "+v"(tid2));
                  pg8::gemm_phase<pg8::EpiUq, pg8::DenseT<2>, false>(lds, P, E, tid2); }
                { const int ce = bx >= 128 ? bx - 128 : (1 << 20);
                  pg8::DenseT<2> P; P.init((const bf16_t*)(ws + R1_Z1) + 512, 1536, (const bf16_t*)(ws + WS_WUKV), N, 1024, 256, 128, ce); P.ready = rdy; P.need = 8u; P.sel = 1;
                  pg8::EpiUkv E{(bf16_t*)(ws + R1_KV1), (const float*)(ws + WS_SSZ)};
                  int tid3 = threadIdx.x; asm volatile("" : "+v"(tid3));
                  pg8::gemm_phase<pg8::EpiUkv, pg8::DenseT<2>, false>(lds, P, E, tid3); } }
            SEAM(10);
            if (IN(11)) { LA(); attn_phase1(args, lds, vcu, G, tid); if (!(CONV_IN_WOUT & 2)) moe_convert(args, 1, lds, gw, NGW, wave, lane); }
            SEAM(11);
        }
        if (IN(pb)) { LA();
            const bool cv = (CONV_IN_WOUT >> layer) & 1;
            if (cv && !(vcu & 1)) { moe_convert(args, layer, lds, gw, NGW, wave, lane); __syncthreads(); }
            { pg8::Dense P; P.init((const bf16_t*)(ws + R2_AO), 1024, (const bf16_t*)(ws + (layer == 0 ? WS_WOUT0 : WS_WOUT1)), N, 1024, 1024, G, bx);
              pg8::EpiOut E{(bf16_t*)(ws + WS_XB), (float*)(ws + WS_SSP)};
              pg8::gemm_phase<pg8::EpiOut, pg8::Dense, false>(lds, P, E, tid); }
            if (cv && (vcu & 1)) { __syncthreads(); int l2 = threadIdx.x & 63; asm volatile("" : "+v"(l2)); moe_convert(args, layer, lds, gw, NGW, wave, l2); } }
        SEAM(pb);
        if (IN(pb + 1)) { LA(); route_phase(args, layer, lds, vcu, G, wave, lane); }
        SEAM(pb + 1);
        if (IN(pb + 2)) { LA(); moe_tables(args, layer, lds, tid);
            unsigned* rdy = (unsigned*)(ws + WS_CTL) + CW_RDY + layer * 8192;
            { pg8::MoeProb<1> P{(const LAS int*)(lds + MISC_PRE), (const LAS int*)(lds + MISC_CNT), 2, G, vcu, 1024, 1024, (const bf16_t*)(ws + WS_XB), (const bf16_t*)(ws + (layer ? R2_WGU1 : R1_WGU)), (size_t)512 * 1024, (const unsigned*)(ws + WS_LT), true, rdy, 16u};
              pg8::EpiGateUp E{(bf16_t*)(ws + R1_ACT), (const float*)(ws + WS_LW), (const float*)(ws + WS_LR)};
              pg8::gemm_phase<pg8::EpiGateUp, pg8::MoeProb<1>, true>(lds, P, E, tid, (LAS unsigned*)(lds + MISC_STASH)); }
            { int tid2 = threadIdx.x; asm volatile("" : "+v"(tid2));
              pg8::MoeProb<2> P{(const LAS int*)(lds + MISC_PRE), (const LAS int*)(lds + MISC_CNT), 4, G, vcu, 256, 256, (const bf16_t*)(ws + R1_ACT), (const bf16_t*)(ws + (layer ? R2_WD1 : R1_WD)), (size_t)1024 * 256, (const unsigned*)(ws + WS_LT), false, rdy, 16u};
              pg8::EpiDown E{(bf16_t*)(ws + (layer ? Y1_BASE : R2_Y)), (const unsigned*)(ws + WS_LT)};
              pg8::gemm_phase<pg8::EpiDown, pg8::MoeProb<2>, false>(lds, P, E, tid2); } }
        SEAM(pb + 3);
        if (IN(pb + 4)) { LA(); combine_phase(args, layer == 1, gw, NGW, lane); }
        if (layer == 0) SEAM(8);
    }
#undef IN
#undef SEAM
#undef LA
}
}
extern "C" void kernel_launch(void* const* d_in, const int* in_sizes, int n_in, void* d_out, int out_size, void* d_ws, size_t ws_size, hipStream_t stream) {
    using namespace mk;
    static int grid = 0;
    if (grid == 0) {
        if (n_in != 21 || out_size != N * D || ws_size < 283 * MiB) { fprintf(stderr, "kernel_launch: unexpected problem (n_in %d out %d ws %zu)\n", n_in, out_size, ws_size); grid = -1; return; }
        int dev = 0, cus = 0, per_cu = 0;
        if (hipGetDevice(&dev) != hipSuccess || hipDeviceGetAttribute(&cus, hipDeviceAttributeMultiprocessorCount, dev) != hipSuccess) { grid = -1; return; }
        if (hipFuncSetAttribute((const void*)mega, hipFuncAttributeMaxDynamicSharedMemorySize, LDS_BYTES) != hipSuccess) { fprintf(stderr, "kernel_launch: hipFuncSetAttribute failed\n"); grid = -1; return; }
        if (hipOccupancyMaxActiveBlocksPerMultiprocessor(&per_cu, (const void*)mega, NTHREADS, LDS_BYTES) != hipSuccess || per_cu < 1) { fprintf(stderr, "kernel_launch: occupancy query says %d blocks per CU\n", per_cu); (void)hipGetLastError(); grid = -1; return; }
        grid = cus;
    }
    if (grid < 0) return;
    Args a{};
    for (int i = 0; i < 21; ++i) a.in[i] = (const float*)d_in[i];
    a.out = (float*)d_out; a.ws = (unsigned char*)d_ws; a.H = (float*)d_out; a.use_bar = 1; a.ph_lo = 0; a.ph_hi = NPHASE;
    (void)hipMemsetAsync((char*)d_ws + WS_CTL, 0, CTL_ZERO_BYTES, stream);
    hipLaunchKernelGGL(mega, dim3(grid), dim3(NTHREADS), LDS_BYTES, stream, a);
}
```

```cpp
#define CONV_IN_WOUT 3
#include <hip/hip_runtime.h>
#include <cstdio>
#include <cstdint>
#include <cmath>
#define LAS __attribute__((address_space(3)))
#define GAS __attribute__((address_space(1)))
typedef unsigned short bf16_t;
typedef short bf16x8 __attribute__((ext_vector_type(8)));
typedef short s16x4 __attribute__((ext_vector_type(4)));
typedef float f32x2 __attribute__((ext_vector_type(2)));
typedef float f32x4 __attribute__((ext_vector_type(4)));
typedef float f32x16 __attribute__((ext_vector_type(16)));
typedef unsigned u32x2 __attribute__((ext_vector_type(2)));
typedef unsigned u32x4 __attribute__((ext_vector_type(4)));
typedef __bf16 bf16x2_t __attribute__((ext_vector_type(2)));
__device__ __forceinline__ unsigned cvtpk(float lo, float hi) { f32x2 v = {lo, hi}; bf16x2_t b = __builtin_convertvector(v, bf16x2_t); return __builtin_bit_cast(unsigned, b); }
__device__ __forceinline__ float bf2f(unsigned short u) { return __uint_as_float((unsigned)u << 16); }
__device__ __forceinline__ float bflo(unsigned u) { return __uint_as_float(u << 16); }
__device__ __forceinline__ float bfhi(unsigned u) { return __uint_as_float(u & 0xffff0000u); }
#ifndef WT_G
#define WT_G 0
#endif
#ifndef WT_A
#define WT_A 0
#endif
#ifndef WT_S
#define WT_S 0
#endif
template <int WTF> __device__ __forceinline__ void st16x(void* p, int off, u32x4 v) {
    if constexpr (WTF) asm volatile("global_store_dwordx4 %0, %1, off offset:%2 sc1\n\ts_nop 1" :: "v"(p), "v"(v), "i"(off) : "memory");
    else *(u32x4*)((char*)p + off) = v;
}
template <int WTF> __device__ __forceinline__ void st8x(void* p, int off, u32x2 v) {
    if constexpr (WTF) asm volatile("global_store_dwordx2 %0, %1, off offset:%2 sc1" :: "v"(p), "v"(v), "i"(off) : "memory");
    else *(u32x2*)((char*)p + off) = v;
}
template <int WTF> __device__ __forceinline__ void st4x(void* p, int off, unsigned v) {
    if constexpr (WTF) asm volatile("global_store_dword %0, %1, off offset:%2 sc1" :: "v"(p), "v"(v), "i"(off) : "memory");
    else *(unsigned*)((char*)p + off) = v;
}
#define st16g st16x<WT_G>
#define st8g  st8x<WT_G>
#define st16a st16x<WT_A>
#define st16s st16x<WT_S>
#define st8s  st8x<WT_S>
__device__ __forceinline__ void st16fs(void* p, int off, f32x4 v) { st16x<WT_S>(p, off, __builtin_bit_cast(u32x4, v)); }

namespace pg8 {
constexpr int BM = 256, BK = 64, HALF = 128, HTB = HALF * BK * 2  , STAGE_BYTES = 8 * HTB, NXCD = 8, WGM = 8;
__host__ __device__ __forceinline__ int lds_byte(int r, int c) { const int st = (r >> 4) * 2 + (c >> 5), rr = r & 15, cc = c & 31, ob = rr * 64 + cc * 2; return st * 1024 + (ob ^ (((ob >> 9) & 1) << 5)); }
__host__ __device__ __forceinline__ void stage_rc(int b, int& R, int& C) { const int st = b / 1024, sb = b % 1024, swz = sb ^ (((sb >> 9) & 1) << 5); R = (st >> 1) * 16 + swz / 64; C = (st & 1) * 32 + (swz % 64) / 2; }
__host__ __device__ __forceinline__ int perm32(int rho) { const int n = rho >> 4, i = rho & 15; return 8 * (i >> 2) + 4 * n + (i & 3); }

struct Unit { int pm, pn, e, rt, rows; };

template <int MODE>
struct DenseT {
    static constexpr bool ROWSKIP = false;
    const bf16_t* A; const bf16_t* Bt; int lda, K; int nM, nN, nwg, G, c; unsigned* ready; unsigned need; int sel;
    __device__ void init(const bf16_t* A_, int lda_, const bf16_t* Bt_, int M, int N, int K_, int G_, int c_) { A = A_; lda = lda_; Bt = Bt_; K = K_; nM = M / BM; nN = N / BM; nwg = nM * nN; G = G_; c = c_; ready = nullptr; need = 0u; sel = 0; }
    __device__ __forceinline__ bool next(int i, Unit& u) const {
        const long L = (long)i * G + c; if (L >= nwg) return false;
        int wgid = (int)L; { const int q = nwg / NXCD, r = nwg % NXCD, xcd = wgid % NXCD, off = wgid / NXCD; wgid = (xcd < r ? xcd * (q + 1) : r * (q + 1) + (xcd - r) * q) + off; }
        const int nig = WGM * nN, gid = wgid / nig, fm = gid * WGM, gsz = (nM - fm) < WGM ? (nM - fm) : WGM;
        u.pm = fm + ((wgid % nig) % gsz); u.pn = (wgid % nig) / gsz; u.e = 0; u.rt = 0; u.rows = 256; return true;
    }
    __device__ __forceinline__ const char* a_base(const Unit& u) const { return (const char*)A + (size_t)u.pm * BM * lda * 2; }
    __device__ __forceinline__ const char* b_base(const Unit& u) const { return (const char*)Bt + (size_t)u.pn * BM * K * 2; }
    __device__ __forceinline__ void a_ready(const Unit& u) const {
        if constexpr (MODE == 2) {
            if (threadIdx.x < 64) {
                unsigned polls = 0;
                while ((unsigned)__builtin_amdgcn_readfirstlane((int)__hip_atomic_load(ready + 32 * (2 * u.pm + sel), __ATOMIC_RELAXED, __HIP_MEMORY_SCOPE_AGENT)) < need) {
                    __builtin_amdgcn_s_sleep(2); if (++polls > (1u << 19)) break; }
            }
            asm volatile("" ::: "memory"); __builtin_amdgcn_s_barrier(); asm volatile("" ::: "memory");
        }
    }
    __device__ __forceinline__ void done(const Unit& u) const {
        if constexpr (MODE == 1) {
            if (u.pn < 3) {
                asm volatile("s_waitcnt vmcnt(0)" ::: "memory");
                if ((threadIdx.x & 63) == 0) __hip_atomic_fetch_add(ready + 32 * (2 * u.pm + (u.pn == 2 ? 1 : 0)), 1u, __ATOMIC_RELAXED, __HIP_MEMORY_SCOPE_AGENT); }
        }
    }
    __device__ __forceinline__ void a_voff(const Unit&, int R0, int C0, int R1, int C1, unsigned (&vo)[2][2]) const {
        vo[0][0] = (unsigned)(R0 * lda + C0) * 2u; vo[0][1] = (unsigned)(R1 * lda + C1) * 2u; vo[1][0] = vo[0][0]; vo[1][1] = vo[0][1]; }
    __device__ __forceinline__ size_t a_hstep() const { return (size_t)HALF * lda * 2; }
};
using Dense = DenseT<0>;

__device__ __forceinline__ void glds_s(const char* sbase, unsigned voff, unsigned lds_dst) { unsigned keep;
    asm volatile("s_mov_b32 %0, m0\n\ts_mov_b32 m0, %2\n\ts_nop 0\n\tglobal_load_lds_dwordx4 %1, %3\n\ts_mov_b32 m0, %0" : "=&s"(keep) : "v"(voff), "s"(lds_dst), "s"(sbase) : "memory"); }
template <class Epi, class Prob, bool GATHER>
__device__ __forceinline__ void gemm_phase(LAS unsigned char* lds, const Prob& S, const Epi& E, const int tid, LAS unsigned* stash = nullptr) {
    const int wid = __builtin_amdgcn_readfirstlane(tid >> 6), lane = tid & 63, wr = wid >> 2, wc = wid & 3, fr = lane & 15, fq = lane >> 4;
    const int K = S.K, nt = K / BK;
    int R0, C0, R1, C1; stage_rc(tid * 16, R0, C0); stage_rc(tid * 16 + 8192, R1, C1);
    unsigned voffB[2];
    { const int Rb0 = Epi::WIDE ? ((R0 >> 5) * 64 + perm32(R0 & 31)) : Epi::PERM ? ((R0 & ~31) + perm32(R0 & 31)) : R0, Rb1 = Epi::WIDE ? ((R1 >> 5) * 64 + perm32(R1 & 31)) : Epi::PERM ? ((R1 & ~31) + perm32(R1 & 31)) : R1;
      voffB[0] = (unsigned)(Rb0 * K + C0) * 2u; voffB[1] = (unsigned)(Rb1 * K + C1) * 2u; }
    const size_t kstep = (size_t)(BK * 2);
    const size_t hstepB = (size_t)(Epi::WIDE ? 32 : HALF) * K * 2;
    const size_t hstepA = GATHER ? 0 : S.a_hstep();
    const unsigned ldsb = (unsigned)(uintptr_t)lds + (unsigned)wid * 1024u;
    const int aoff = lds_byte(wr * 64 + fr, fq * 8), boff = lds_byte(wc * 32 + fr, fq * 8);
#define PG8_SA(b, h) (((b) * 2 + (h)) * HTB)
#define PG8_SB(b, h) ((4 + (b) * 2 + (h)) * HTB)
#define PG8_STAGE(bufoff, gbase, voff) do { _Pragma("unroll") for (int _i = 0; _i < 2; ++_i) \
        glds_s((const char*)(gbase), (voff)[_i], ldsb + (unsigned)((bufoff) + _i * 8192)); } while (0)
#define PG8_LDA(dst, b, h) do { _Pragma("unroll") for (int m = 0; m < 4; ++m) _Pragma("unroll") for (int k = 0; k < 2; ++k) dst[m][k] = *(const LAS bf16x8*)(lds + PG8_SA(b, h) + aoff + m * 2048 + k * 1024); } while (0)
#define PG8_LDB(dst, b, h) do { _Pragma("unroll") for (int n = 0; n < 2; ++n) _Pragma("unroll") for (int k = 0; k < 2; ++k) dst[n][k] = *(const LAS bf16x8*)(lds + PG8_SB(b, h) + boff + n * 2048 + k * 1024); } while (0)
#define PG8_MMA(ai, bj, At, Bt) do { __builtin_amdgcn_s_setprio(1); _Pragma("unroll") for (int m = 0; m < 4; ++m) { if (!Prob::ROWSKIP || (ai) * HALF + wr * 64 + m * 16 < rows_cur) { _Pragma("unroll") for (int n = 0; n < 2; ++n) _Pragma("unroll") for (int k = 0; k < 2; ++k) \
        acc[ai][bj][m][n] = __builtin_amdgcn_mfma_f32_16x16x32_bf16(Bt[n][k], At[m][k], acc[ai][bj][m][n], 0, 0, 0); } } __builtin_amdgcn_s_setprio(0); } while (0)
#define PG8_WAIT_V(n) asm volatile("s_waitcnt vmcnt(" #n ")" ::: "memory")
#define PG8_WAIT_L(n) asm volatile("s_waitcnt lgkmcnt(" #n ")" ::: "memory")
#define PG8_BAR __builtin_amdgcn_s_barrier()
#define PG8_SCHED __builtin_amdgcn_sched_barrier(0)
    Unit cur, nxt; int ui = 0;
    if (!S.next(0, cur)) return;
    bool has_next = S.next(1, nxt);
    unsigned voffA[2][2];
    S.a_voff(cur, R0, C0, R1, C1, voffA);
    LAS u32x4* const st4 = (LAS u32x4*)stash + tid;
    if (GATHER) { unsigned vn[2][2]; if (has_next) S.a_voff(nxt, R0, C0, R1, C1, vn); else { vn[0][0] = voffA[0][0]; vn[0][1] = voffA[0][1]; vn[1][0] = voffA[1][0]; vn[1][1] = voffA[1][1]; }
        *st4 = (u32x4){vn[0][0], vn[0][1], vn[1][0], vn[1][1]};
        asm volatile("s_waitcnt vmcnt(0)" : "+v"(voffA[0][0]), "+v"(voffA[0][1]), "+v"(voffA[1][0]), "+v"(voffA[1][1]) :: "memory"); }
    f32x4 acc[2][2][4][2];
#pragma unroll
    for (int a = 0; a < 2; ++a)
#pragma unroll
        for (int b = 0; b < 2; ++b)
#pragma unroll
            for (int m = 0; m < 4; ++m)
#pragma unroll
                for (int n = 0; n < 2; ++n) acc[a][b][m][n] = (f32x4){0.f, 0.f, 0.f, 0.f};
    bf16x8 At[4][2], B0[2][2], B1[2][2];
    const char* cA = S.a_base(cur); const char* cB = S.b_base(cur); int rows_cur = cur.rows; (void)rows_cur;
    S.a_ready(cur);
    PG8_STAGE(PG8_SB(0, 0), cB, voffB); PG8_STAGE(PG8_SB(0, 1), cB + hstepB, voffB); PG8_STAGE(PG8_SA(0, 0), cA, voffA[0]); PG8_STAGE(PG8_SA(0, 1), cA + hstepA, voffA[1]);
    if (wr == 1) PG8_BAR;
    PG8_WAIT_V(2); PG8_BAR;
    PG8_STAGE(PG8_SB(1, 0), cB + kstep, voffB); PG8_STAGE(PG8_SA(1, 0), cA + kstep, voffA[0]); PG8_STAGE(PG8_SB(1, 1), cB + hstepB + kstep, voffB);
    PG8_WAIT_V(6); PG8_BAR;
    for (;;) {
        const char* nA = has_next ? S.a_base(nxt) : cA; const char* nB = has_next ? S.b_base(nxt) : cB;
#pragma unroll 1
        for (int t = 0; t < nt; t += 2) {
            const bool last = (t == nt - 2);
            if (last && has_next) S.a_ready(nxt);
            const char* a1 = cA + (size_t)(t + 1) * kstep;
            const char* a2 = last ? nA : cA + (size_t)(t + 2) * kstep; const char* b2 = last ? nB : cB + (size_t)(t + 2) * kstep;
            const char* a3 = a2 + kstep; const char* b3 = b2 + kstep;
            unsigned v20 = voffA[0][0], v21 = voffA[0][1], v30 = voffA[1][0], v31 = voffA[1][1];
            if (GATHER) { if (last) { const u32x4 n4 = *st4; v20 = n4.x; v21 = n4.y; v30 = n4.z; v31 = n4.w; } }
            const unsigned vh0[2] = {v20, v21}, vh1[2] = {v30, v31};
            PG8_LDB(B0, 0, 0); PG8_LDB(B1, 0, 1); PG8_SCHED; PG8_LDA(At, 0, 0); PG8_STAGE(PG8_SA(1, 1), a1 + hstepA, voffA[1]);
            PG8_WAIT_V(8); PG8_WAIT_L(0); PG8_BAR; PG8_MMA(0, 0, At, B0); PG8_MMA(0, 1, At, B1); PG8_BAR; PG8_SCHED;
            PG8_LDA(At, 0, 1); PG8_STAGE(PG8_SB(0, 0), b2, voffB); PG8_STAGE(PG8_SB(0, 1), b2 + hstepB, voffB); PG8_STAGE(PG8_SA(0, 0), a2, vh0);
            PG8_WAIT_V(8); PG8_WAIT_L(0); PG8_BAR; PG8_MMA(1, 0, At, B0); PG8_MMA(1, 1, At, B1); PG8_BAR; PG8_SCHED;
            PG8_LDB(B0, 1, 0); PG8_LDB(B1, 1, 1); PG8_SCHED; PG8_LDA(At, 1, 0); PG8_STAGE(PG8_SA(0, 1), a2 + hstepA, vh1);
            PG8_WAIT_V(8); PG8_WAIT_L(0); PG8_BAR; PG8_MMA(0, 0, At, B0); PG8_MMA(0, 1, At, B1); PG8_BAR; PG8_SCHED;
            PG8_LDA(At, 1, 1); PG8_STAGE(PG8_SB(1, 0), b3, voffB); PG8_STAGE(PG8_SB(1, 1), b3 + hstepB, voffB); PG8_STAGE(PG8_SA(1, 0), a3, vh0);
            PG8_WAIT_V(8); PG8_WAIT_L(0); PG8_BAR; PG8_MMA(1, 0, At, B0); PG8_MMA(1, 1, At, B1); PG8_BAR; PG8_SCHED;
        }
        if (wr == 0) PG8_BAR;
        { int fr_e = fr, fq_e = fq; asm volatile("" : "+v"(fr_e), "+v"(fq_e));
          E(acc, cur, wr, wc, fr_e, fq_e); }
        S.done(cur);
        if (!has_next) break;
#pragma unroll
        for (int a = 0; a < 2; ++a)
#pragma unroll
            for (int b = 0; b < 2; ++b)
#pragma unroll
                for (int m = 0; m < 4; ++m)
#pragma unroll
                    for (int n = 0; n < 2; ++n) acc[a][b][m][n] = (f32x4){0.f, 0.f, 0.f, 0.f};
        cur = nxt; cA = nA; cB = nB; ++ui; rows_cur = cur.rows;
        has_next = S.next(ui + 1, nxt);
        if (GATHER) {
            { const u32x4 n4 = *st4; voffA[0][0] = n4.x; voffA[0][1] = n4.y; voffA[1][0] = n4.z; voffA[1][1] = n4.w; }
            if (has_next) { unsigned vn[2][2]; S.a_voff(nxt, R0, C0, R1, C1, vn);
                asm volatile("s_waitcnt vmcnt(0)" : "+v"(vn[0][0]), "+v"(vn[0][1]), "+v"(vn[1][0]), "+v"(vn[1][1]) :: "memory");
                *st4 = (u32x4){vn[0][0], vn[0][1], vn[1][0], vn[1][1]}; }
        }
        if (wr == 1) PG8_BAR;
    }
    PG8_WAIT_V(0);
    PG8_BAR;
#undef PG8_SA
#undef PG8_SB
#undef PG8_STAGE
#undef PG8_LDA
#undef PG8_LDB
#undef PG8_MMA
#undef PG8_WAIT_V
#undef PG8_WAIT_L
#undef PG8_BAR
#undef PG8_SCHED
}
}
namespace mk {
constexpr int NB = 4, S = 4096, D = 1024, N = NB * S;
constexpr float EPS = 1e-6f, LOG2E = 1.4426950408889634f;
constexpr float C2_64 = 0.125f * LOG2E, C2_96 = 0.10206207261596575f * LOG2E;
constexpr size_t MiB = 1u << 20;
constexpr size_t WS_CTL = 0, CTL_ZERO_BYTES = 1 * MiB;
constexpr size_t WS_SS = 1 * MiB;
constexpr size_t WS_RSTD = WS_SS + (size_t)N * 4;
constexpr size_t WS_SSP = WS_RSTD + (size_t)N * 4;
constexpr size_t WS_LOGF = WS_SSP + (size_t)N * 64;
constexpr size_t WS_CB2 = WS_LOGF + (size_t)N * 32;
constexpr size_t WS_ROPE = WS_CB2 + (size_t)32 * S * 4;
constexpr size_t WS_DLSE = WS_ROPE + (size_t)S * 16 * 8;
constexpr size_t WS_SSZ = WS_DLSE + (size_t)3 * N * 32;
constexpr size_t WS_LT = WS_SSZ + (size_t)N * 48;
constexpr size_t WS_LW = WS_LT + (size_t)32 * N * 4;
constexpr size_t WS_LR = WS_LW + (size_t)32 * N * 4;
constexpr size_t WS_SMALL_END = WS_LR + (size_t)32 * N * 4;
constexpr size_t WS_KEXT = WS_LT;
static_assert(WS_SMALL_END <= 13 * MiB, "small arrays");
constexpr size_t WS_WIN0 = 13 * MiB;
constexpr size_t WS_WOUT0 = WS_WIN0 + 6 * MiB;
constexpr size_t WS_WIN1 = WS_WOUT0 + 2 * MiB;
constexpr size_t WS_WUQ = WS_WIN1 + 3 * MiB;
constexpr size_t WS_WUKV = WS_WUQ + 768 * 384 * 2;
constexpr size_t WS_WOUT1 = WS_WUKV + 1024 * 256 * 2;
constexpr size_t WS_WR = WS_WOUT1 + 2 * MiB;
static_assert(WS_WR + 2 * 64 * 1024 * 2 <= 28 * MiB, "weights");
constexpr size_t WS_XB = 28 * MiB;
constexpr size_t WS_R1 = 60 * MiB;
constexpr size_t WS_R2 = 164 * MiB;
constexpr size_t WS_END = 244 * MiB;
constexpr size_t R1_QKV0 = WS_R1;
constexpr size_t R1_Z1 = WS_R1, R1_Q1 = WS_R1 + 48 * MiB, R1_KV1 = WS_R1 + 72 * MiB;
constexpr size_t R1_WGU = WS_R1, R1_WD = WS_R1 + 32 * MiB, R1_ACT = WS_R1 + 48 * MiB;
constexpr size_t R2_AO = WS_R2, R2_DPART = WS_R2 + 32 * MiB;
constexpr size_t R2_Y = WS_R2;
constexpr size_t Y1_BASE = 128 * MiB;
constexpr size_t R2_WGU1 = WS_R2 + 32 * MiB, R2_WD1 = WS_R2 + 64 * MiB;
constexpr int CW_CNT = 64;
constexpr int CW_BAR = 4096;
constexpr int CW_RDY2 = 49152;
constexpr int CW_RDY = 16384;
}

#ifndef WIDE_QKV
#define WIDE_QKV 0
#endif
namespace pg8 {
using mk::EPS;
struct EpiQkv0 {
    static constexpr bool PERM = true; static constexpr bool WIDE = (WIDE_QKV != 0);
    bf16_t* O; const float* ss;
    __device__ __forceinline__ void operator()(const f32x4 (&acc)[2][2][4][2], const Unit& u, int wr, int wc, int fr, int fq) const {
        const int row0 = u.pm * BM + wr * 64 + fr, col0 = u.pn * BM + (WIDE ? wc * 64 : wc * 32) + 8 * fq;
        const float sc = (u.pn < 2 || u.pn == 6 || u.pn == 7) ? mk::C2_64 : 1.f;
        float rs[8];
#pragma unroll
        for (int i = 0; i < 8; ++i) rs[i] = ss[row0 + (i >> 2) * HALF + (i & 3) * 16];
#pragma unroll
        for (int i = 0; i < 8; ++i) rs[i] = sc / sqrtf(rs[i] * (1.f / 1024.f) + EPS);
#pragma unroll
        for (int ai = 0; ai < 2; ++ai)
#pragma unroll
            for (int m = 0; m < 4; ++m) { const int row = row0 + ai * HALF + m * 16; const float r_ = rs[ai * 4 + m];
                bf16_t* rowp = O + (size_t)row * 3072 + col0;
#pragma unroll
                for (int bj = 0; bj < 2; ++bj) { const f32x4 v0 = acc[ai][bj][m][0] * r_, v1 = acc[ai][bj][m][1] * r_;
                    u32x4 w; w.x = cvtpk(v0[0], v0[1]); w.y = cvtpk(v0[2], v0[3]); w.z = cvtpk(v1[0], v1[1]); w.w = cvtpk(v1[2], v1[3]);
                    st16g(rowp, WIDE ? bj * 64 : bj * HALF * 2, w); } }
    }
};
struct EpiOut {
    static constexpr bool PERM = false; static constexpr bool WIDE = false;
    bf16_t* X; float* ssp;
    __device__ __forceinline__ void operator()(const f32x4 (&acc)[2][2][4][2], const Unit& u, int wr, int wc, int fr, int fq) const {
        const int row0 = u.pm * BM + wr * 64 + fr, col0 = u.pn * BM + wc * 32 + 4 * fq;
        u32x2 rb[8][4];
#pragma unroll
        for (int i = 0; i < 8; ++i) { const size_t off = (size_t)(row0 + (i >> 2) * HALF + (i & 3) * 16) * 1024 + col0;
#pragma unroll
            for (int qq = 0; qq < 4; ++qq) rb[i][qq] = *(const u32x2*)(X + off + (qq >> 1) * HALF + (qq & 1) * 16); }
#pragma unroll
        for (int i = 0; i < 8; ++i) { const int ai = i >> 2, m = i & 3; const int row = row0 + ai * HALF + m * 16; const size_t off = (size_t)row * 1024 + col0; float q = 0.f;
#pragma unroll
            for (int qq = 0; qq < 4; ++qq) { const f32x4 a4 = acc[ai][qq >> 1][m][qq & 1]; const u32x2 r2 = rb[i][qq];
                const float v0 = bflo(r2.x) + a4[0], v1 = bfhi(r2.x) + a4[1], v2 = bflo(r2.y) + a4[2], v3 = bfhi(r2.y) + a4[3];
                u32x2 w; w.x = cvtpk(v0, v1); w.y = cvtpk(v2, v3); st8g(X + off, ((qq >> 1) * HALF + (qq & 1) * 16) * 2, w);
                q += (v0 * v0 + v1 * v1) + (v2 * v2 + v3 * v3); }
            q += __shfl_xor(q, 16); q += __shfl_xor(q, 32);
            if (fq == 0) ssp[(size_t)row * 16 + u.pn * 4 + wc] = q; }
    }
};
struct EpiWin1 {
    static constexpr bool PERM = false; static constexpr bool WIDE = false;
    bf16_t* Z; const float* ss; float* ssz; const f32x2* rope;
    __device__ __forceinline__ void operator()(const f32x4 (&acc)[2][2][4][2], const Unit& u, int wr, int wc, int fr, int fq) const {
        const int row0 = u.pm * BM + wr * 64 + fr, col0 = u.pn * BM + wc * 32 + 4 * fq; const int pn = u.pn;
        const float sc = (pn == 3 || pn == 4) ? mk::C2_64 : 1.f; const bool ropew = (pn == 1 && wc == 0);
        float rs[8];
#pragma unroll
        for (int i = 0; i < 8; ++i) rs[i] = ss[row0 + (i >> 2) * HALF + (i & 3) * 16];
#pragma unroll
        for (int i = 0; i < 8; ++i) rs[i] = sc / sqrtf(rs[i] * (1.f / 1024.f) + EPS);
#pragma unroll
        for (int ai = 0; ai < 2; ++ai) {
            f32x4 cs[4][2];
            if (ropew) {
#pragma unroll
                for (int m = 0; m < 4; ++m) { const f32x4* rp = (const f32x4*)(rope + (size_t)((row0 + ai * HALF + m * 16) & (mk::S - 1)) * 16 + 4 * fq); cs[m][0] = rp[0]; cs[m][1] = rp[1]; } }
#pragma unroll
            for (int m = 0; m < 4; ++m) { const int row = row0 + ai * HALF + m * 16; const float r_ = rs[ai * 4 + m];
                bf16_t* rowp = Z + (size_t)row * 1536 + col0; float q = 0.f;
#pragma unroll
                for (int bj = 0; bj < 2; ++bj) { f32x4 v0 = acc[ai][bj][m][0] * r_, v1 = acc[ai][bj][m][1] * r_;
                    if (pn == 1 && bj == 1) {
                        if (wc != 0) continue;
#pragma unroll
                        for (int j = 0; j < 4; ++j) { const float c_ = cs[m][j >> 1][2 * (j & 1)], s_ = cs[m][j >> 1][2 * (j & 1) + 1]; const float t1 = v0[j], t2 = v1[j]; v0[j] = t1 * c_ - t2 * s_; v1[j] = t1 * s_ + t2 * c_; }
                    } else if (pn < 3) q += (v0[0] * v0[0] + v0[1] * v0[1]) + (v0[2] * v0[2] + v0[3] * v0[3]) + (v1[0] * v1[0] + v1[1] * v1[1]) + (v1[2] * v1[2] + v1[3] * v1[3]);
                    u32x2 w0, w1; w0.x = cvtpk(v0[0], v0[1]); w0.y = cvtpk(v0[2], v0[3]); w1.x = cvtpk(v1[0], v1[1]); w1.y = cvtpk(v1[2], v1[3]);
                    st8x<1>(rowp, bj * HALF * 2, w0); st8x<1>(rowp, bj * HALF * 2 + 32, w1); }
                if (pn < 3) { q += __shfl_xor(q, 16); q += __shfl_xor(q, 32); if (fq == 0) st4x<1>(pn < 2 ? ssz + (size_t)row * 8 + pn * 4 + wc : ssz + (size_t)mk::N * 8 + (size_t)row * 4 + wc, 0, __float_as_uint(q)); } }
        }
    }
};
struct EpiUq {
    static constexpr bool PERM = false; static constexpr bool WIDE = false;
    bf16_t* Q; const float* ssz; const f32x2* rope;
    __device__ __forceinline__ void operator()(const f32x4 (&acc)[2][2][4][2], const Unit& u, int wr, int wc, int fr, int fq) const {
        const int row0 = u.pm * BM + wr * 64 + fr, col0 = u.pn * BM + wc * 32 + 4 * fq;
        const bool rp0 = ((u.pn * 8 + wc) % 3 == 2), rp1 = ((u.pn * 8 + 4 + wc) % 3 == 2);
        float rs[8];
#pragma unroll
        for (int hb = 0; hb < 2; ++hb) { f32x4 sa[4], sb[4];
#pragma unroll
          for (int i = 0; i < 4; ++i) { const f32x4* sp = (const f32x4*)(ssz + (size_t)(row0 + hb * HALF + i * 16) * 8); sa[i] = sp[0]; sb[i] = sp[1]; }
#pragma unroll
          for (int i = 0; i < 4; ++i) rs[hb * 4 + i] = mk::C2_96 / sqrtf(((sa[i][0] + sa[i][1]) + (sa[i][2] + sa[i][3]) + (sb[i][0] + sb[i][1]) + (sb[i][2] + sb[i][3])) * (1.f / 384.f) + EPS);
          asm volatile("" ::: "memory"); }
#pragma unroll
        for (int ai = 0; ai < 2; ++ai)
#pragma unroll
            for (int mp = 0; mp < 2; ++mp) {
                f32x4 cs[2][2];
                if (rp0 || rp1) {
#pragma unroll
                    for (int mm = 0; mm < 2; ++mm) { const f32x4* rp = (const f32x4*)(rope + (size_t)((row0 + ai * HALF + (2 * mp + mm) * 16) & (mk::S - 1)) * 16 + 4 * fq); cs[mm][0] = rp[0]; cs[mm][1] = rp[1]; } }
#pragma unroll
                for (int mm = 0; mm < 2; ++mm) { const int m = 2 * mp + mm; const int row = row0 + ai * HALF + m * 16; const float r_ = rs[ai * 4 + m];
                    bf16_t* rowp = Q + (size_t)row * 768 + col0;
#pragma unroll
                    for (int bj = 0; bj < 2; ++bj) { f32x4 v0 = acc[ai][bj][m][0] * r_, v1 = acc[ai][bj][m][1] * r_;
                        if (bj == 0 ? rp0 : rp1) {
#pragma unroll
                            for (int j = 0; j < 4; ++j) { const float c_ = cs[mm][j >> 1][2 * (j & 1)], s_ = cs[mm][j >> 1][2 * (j & 1) + 1]; const float t1 = v0[j], t2 = v1[j]; v0[j] = t1 * c_ - t2 * s_; v1[j] = t1 * s_ + t2 * c_; } }
                        u32x2 w0, w1; w0.x = cvtpk(v0[0], v0[1]); w0.y = cvtpk(v0[2], v0[3]); w1.x = cvtpk(v1[0], v1[1]); w1.y = cvtpk(v1[2], v1[3]);
                        st8g(rowp, bj * HALF * 2, w0); st8g(rowp, bj * HALF * 2 + 32, w1); } }
                asm volatile("" ::: "memory"); }
    }
};
struct EpiUkv {
    static constexpr bool PERM = true; static constexpr bool WIDE = false;
    bf16_t* O; const float* ssz;
    __device__ __forceinline__ void operator()(const f32x4 (&acc)[2][2][4][2], const Unit& u, int wr, int wc, int fr, int fq) const {
        const int row0 = u.pm * BM + wr * 64 + fr, col0 = u.pn * BM + wc * 32 + 8 * fq;
        float rs[8];
        { f32x4 sa[8];
#pragma unroll
          for (int i = 0; i < 8; ++i) sa[i] = *(const f32x4*)(ssz + (size_t)mk::N * 8 + (size_t)(row0 + (i >> 2) * HALF + (i & 3) * 16) * 4);
#pragma unroll
          for (int i = 0; i < 8; ++i) rs[i] = 1.f / sqrtf(((sa[i][0] + sa[i][1]) + (sa[i][2] + sa[i][3])) * (1.f / 256.f) + EPS); }
#pragma unroll
        for (int ai = 0; ai < 2; ++ai)
#pragma unroll
            for (int m = 0; m < 4; ++m) { const int row = row0 + ai * HALF + m * 16; const float r_ = rs[ai * 4 + m];
                bf16_t* rowp = O + (size_t)row * 1024 + col0;
#pragma unroll
                for (int bj = 0; bj < 2; ++bj) { const f32x4 v0 = acc[ai][bj][m][0] * r_, v1 = acc[ai][bj][m][1] * r_;
                    u32x4 w; w.x = cvtpk(v0[0], v0[1]); w.y = cvtpk(v0[2], v0[3]); w.z = cvtpk(v1[0], v1[1]); w.w = cvtpk(v1[2], v1[3]);
                    st16g(rowp, bj * HALF * 2, w); } }
    }
};
template <int MODE>
struct MoeProb {
    static constexpr bool ROWSKIP = true;
    const LAS int* pre; const LAS int* cnt; int NT, G, c, K, lda;
    const bf16_t* A; const bf16_t* Bt; size_t bstride;
    const unsigned* lt;
    bool gather; unsigned* ready; unsigned need;
    __device__ __forceinline__ bool next(int i, Unit& u) const {
        const int totF = pre[72]; long L;
        if constexpr (MODE == 1) {
            const int F = totF * NT, Tn = pre[112] * NT, r = F % G, nfull = F / G + (c < r ? 1 : 0), Z = G - r;
            if (i < nfull) L = (long)i * G + c;
            else { const int k = i - nfull; int j;
                if (c >= r) { if (k > 1) return false; j = (c - r) + Z * k; if (j >= 2 * Z) return false; }
                else { if (k > 0) return false; j = 2 * Z + c; }
                if (j >= Tn) return false; L = F + j; }
        } else { L = (long)i * G + c; const int total = (totF + pre[112]) * NT; if (L >= total) return false; }
        int f = (int)L / NT; u.pn = (int)L % NT; int e = 0;
        if (f < totF) {
#pragma unroll
            for (int j = 1; j < 32; ++j) if (pre[40 + j] <= f) e = j;
            u.rt = f - pre[40 + e]; u.rows = 256;
        } else { e = pre[80 + f - totF]; u.rt = cnt[e] >> 8; u.rows = cnt[e] & 255; }
        e = __builtin_amdgcn_readfirstlane(e); u.e = e; u.rt = __builtin_amdgcn_readfirstlane(u.rt); u.rows = __builtin_amdgcn_readfirstlane(u.rows); u.pm = __builtin_amdgcn_readfirstlane(pre[e]) + u.rt; return true;
    }
    __device__ __forceinline__ void a_ready(const Unit& u) const {
        if constexpr (MODE == 2) {
            if (threadIdx.x < 64) {
                unsigned polls = 0;
                while ((unsigned)__builtin_amdgcn_readfirstlane((int)__hip_atomic_load(ready + 32 * u.pm, __ATOMIC_RELAXED, __HIP_MEMORY_SCOPE_AGENT)) < need) {
                    __builtin_amdgcn_s_sleep(2); if (++polls > (1u << 19)) break; }
            }
            asm volatile("" ::: "memory"); __builtin_amdgcn_s_barrier(); asm volatile("" ::: "memory");
        }
    }
    __device__ __forceinline__ void done(const Unit& u) const {
        if constexpr (MODE == 1) {
            asm volatile("s_waitcnt vmcnt(0)" ::: "memory");
            if ((threadIdx.x & 63) == 0) __hip_atomic_fetch_add(ready + 32 * u.pm, 1u, __ATOMIC_RELAXED, __HIP_MEMORY_SCOPE_AGENT);
        }
    }
    __device__ __forceinline__ const char* a_base(const Unit& u) const { return gather ? (const char*)A : (const char*)A + (size_t)u.pm * BM * lda * 2; }
    __device__ __forceinline__ size_t a_hstep() const { return (size_t)HALF * lda * 2; }
    __device__ __forceinline__ const char* b_base(const Unit& u) const { return (const char*)Bt + ((size_t)u.e * bstride + (size_t)u.pn * BM * K) * 2; }
    __device__ __forceinline__ void a_voff(const Unit& u, int R0, int C0, int R1, int C1, unsigned (&vo)[2][2]) const {
        if (gather) { const unsigned* l = lt + (size_t)u.e * mk::N + u.rt * 256;
            const unsigned t00 = (R0 < u.rows) ? (l[R0] & 0x7fffffffu) : 0u, t01 = (R1 < u.rows) ? (l[R1] & 0x7fffffffu) : 0u;
            const unsigned t10 = (R0 + HALF < u.rows) ? (l[R0 + HALF] & 0x7fffffffu) : 0u, t11 = (R1 + HALF < u.rows) ? (l[R1 + HALF] & 0x7fffffffu) : 0u;
            vo[0][0] = (t00 * (unsigned)lda + C0) * 2u; vo[0][1] = (t01 * (unsigned)lda + C1) * 2u; vo[1][0] = (t10 * (unsigned)lda + C0) * 2u; vo[1][1] = (t11 * (unsigned)lda + C1) * 2u;
        } else { vo[0][0] = (unsigned)(R0 * lda + C0) * 2u; vo[0][1] = (unsigned)(R1 * lda + C1) * 2u; vo[1][0] = vo[0][0]; vo[1][1] = vo[0][1]; }
    }
};
struct EpiGateUp {
    static constexpr bool PERM = true; static constexpr bool WIDE = false;
    bf16_t* act; const float* lw; const float* lr;
    __device__ __forceinline__ void operator()(const f32x4 (&acc)[2][2][4][2], const Unit& u, int wr, int wc, int fr, int fq) const {
        const int rl0 = wr * 64 + fr, col0 = u.pn * 128 + wc * 32 + 8 * fq; const size_t lbase = (size_t)u.e * mk::N + u.rt * 256;
        float wv[8], rv[8];
#pragma unroll
        for (int i = 0; i < 8; ++i) { const int rl = rl0 + (i >> 2) * HALF + (i & 3) * 16; const bool ok = rl < u.rows; wv[i] = ok ? lw[lbase + rl] : 0.f; rv[i] = ok ? lr[lbase + rl] : 0.f; }
#pragma unroll
        for (int ai = 0; ai < 2; ++ai)
#pragma unroll
            for (int m = 0; m < 4; ++m) { const int rl = rl0 + ai * HALF + m * 16; if (rl >= u.rows) continue;
                const float w = wv[ai * 4 + m], rs = rv[ai * 4 + m]; float o[8];
#pragma unroll
                for (int n = 0; n < 2; ++n)
#pragma unroll
                    for (int j = 0; j < 4; ++j) { const float g = acc[ai][0][m][n][j] * rs, up = acc[ai][1][m][n][j] * rs;
                        o[n * 4 + j] = g * __builtin_amdgcn_rcpf(1.f + __builtin_amdgcn_exp2f(-g * mk::LOG2E)) * up * w; }
                u32x4 pk; pk.x = cvtpk(o[0], o[1]); pk.y = cvtpk(o[2], o[3]); pk.z = cvtpk(o[4], o[5]); pk.w = cvtpk(o[6], o[7]);
                st16x<1>(act + ((size_t)u.pm * 256 + rl) * 256 + col0, 0, pk);   }
    }
};
struct EpiDown {
    static constexpr bool PERM = true; static constexpr bool WIDE = false;
    bf16_t* Y; const unsigned* lt;
    __device__ __forceinline__ void operator()(const f32x4 (&acc)[2][2][4][2], const Unit& u, int wr, int wc, int fr, int fq) const {
        const int rl0 = wr * 64 + fr, col0 = u.pn * BM + wc * 32 + 8 * fq; const size_t lbase = (size_t)u.e * mk::N + u.rt * 256;
        unsigned tk[8];
#pragma unroll
        for (int i = 0; i < 8; ++i) { const int rl = rl0 + (i >> 2) * HALF + (i & 3) * 16; tk[i] = (rl < u.rows) ? lt[lbase + rl] : 0u; }
#pragma unroll
        for (int ai = 0; ai < 2; ++ai)
#pragma unroll
            for (int m = 0; m < 4; ++m) { const int rl = rl0 + ai * HALF + m * 16; if (rl >= u.rows) continue;
                const unsigned t_ = tk[ai * 4 + m]; bf16_t* rowp = Y + ((size_t)(t_ >> 31) * mk::N + (t_ & 0x7fffffffu)) * 1024 + col0;
#pragma unroll
                for (int bj = 0; bj < 2; ++bj) { const f32x4 v0 = acc[ai][bj][m][0], v1 = acc[ai][bj][m][1];
                    u32x4 w; w.x = cvtpk(v0[0], v0[1]); w.y = cvtpk(v0[2], v0[3]); w.z = cvtpk(v1[0], v1[1]); w.w = cvtpk(v1[2], v1[3]);
                    st16g(rowp, bj * HALF * 2, w); } }
    }
};
}
namespace att {
constexpr int SLOT_K = 12288, SLOT_V = 8192, SLOT_KB = 256, SLOT = SLOT_K + SLOT_V + SLOT_KB;
constexpr int LDS_WS = 2 * SLOT, LDS_OST = LDS_WS + 8 * 256, LDS_BYTES = LDS_OST + 8 * 4608;
struct UnitDesc {
    const bf16_t* q; long qstride;
    const bf16_t* k; const bf16_t* v; long kstride;
    const bf16_t* kx; long kxstride;
    bf16_t* o; long ostride;
    float* lse; long lsestride;
    const float* kbias;
    int q0, W; float alibi, sink;
    bool has_sink, has_lse;
};
__device__ __forceinline__ int crow(int r, int hi) { return (r & 3) + 8 * (r >> 2) + 4 * hi; }
#define ATT_MX3(a, b, c) __builtin_fmaxf(__builtin_fmaxf((a), (b)), (c))
__device__ __forceinline__ float rowmax(const f32x16& p0, const f32x16& p1) {
    float a = ATT_MX3(p0[0], p0[1], p1[0]), b = ATT_MX3(p0[2], p0[3], p1[1]); a = ATT_MX3(a, p1[2], p1[3]);
#pragma unroll
    for (int r = 4; r < 16; r += 4) { a = ATT_MX3(a, p0[r], p0[r + 1]); b = ATT_MX3(b, p0[r + 2], p0[r + 3]); a = ATT_MX3(a, p1[r], p1[r + 1]); b = ATT_MX3(b, p1[r + 2], p1[r + 3]); }
    float m = __builtin_fmaxf(a, b); auto rr = __builtin_amdgcn_permlane32_swap(__float_as_uint(m), __float_as_uint(m), false, false);
    return __builtin_fmaxf(__uint_as_float(rr[0]), __uint_as_float(rr[1])); }
typedef short v4i16_t __attribute__((ext_vector_type(4)));
__device__ __forceinline__ s16x4 vtr(const LAS unsigned char* p) { return __builtin_bit_cast(s16x4, __builtin_amdgcn_ds_read_tr16_b64_v4i16((LAS v4i16_t*)p)); }

__device__ __forceinline__ void att_store_ot(const f32x16 (&o)[2], float inv, LAS bf16_t* stg, bf16_t* O, long ostride, int lane) {
    const int r32 = lane & 31, hi = lane >> 5;
#pragma unroll
    for (int d0 = 0; d0 < 2; ++d0)
#pragma unroll
        for (int g = 0; g < 4; ++g) { u32x2 p; p.x = cvtpk(o[d0][4 * g] * inv, o[d0][4 * g + 1] * inv); p.y = cvtpk(o[d0][4 * g + 2] * inv, o[d0][4 * g + 3] * inv);
            *(LAS u32x2*)(stg + r32 * 72 + 32 * d0 + 8 * g + 4 * hi) = p; }
#pragma unroll
    for (int i = 0; i < 4; ++i) { const int row = i * 8 + (lane >> 3), ch = lane & 7; const u32x4 v = *(const LAS u32x4*)(stg + row * 72 + ch * 8); st16a(O + (long)row * ostride + ch * 8, 0, v); }
}

template <int NDQ, bool FOX, bool BAND>
__device__ __forceinline__ void attn_unit(const UnitDesc& u, LAS unsigned char* lds, const int tid) {
    const int lane = tid & 63, r32 = lane & 31, hi = lane >> 5; const int w = __builtin_amdgcn_readfirstlane(tid >> 6);
    const int q0 = u.q0, Qw = q0 + 32 * w;
    const int t_lo = BAND ? ((q0 - u.W) > 0 ? ((q0 - u.W) >> 6) : 0) : 0, t_hi = (q0 + 255) >> 6;
    LAS float* wsf = (LAS float*)(lds + LDS_WS) + w * 64;
    const bf16_t* ksrc = u.k + (long)lane * u.kstride + w * 8;
    const bf16_t* kxsrc = (NDQ > 4) ? u.kx + (long)lane * u.kxstride + (NDQ == 6 ? (w & 3) * 8 : 0) : nullptr;
    const bf16_t* vsrc = u.v + (long)(16 * (w & 3) + (lane >> 2)) * u.kstride + (w >> 2) * 32 + (lane & 3) * 8;
#define ATT_DMA(t, bsel) do { LAS unsigned char* kb_ = lds + (bsel) * SLOT; \
        __builtin_amdgcn_global_load_lds((const unsigned*)(ksrc + (long)(t) * 64 * u.kstride), (LAS unsigned*)(kb_ + w * 1024), 16, 0, 0); \
        if (NDQ > 4) { if (w < 2 * (NDQ - 4)) __builtin_amdgcn_global_load_lds((const unsigned*)(kxsrc + (long)(t) * 64 * u.kxstride), (LAS unsigned*)(kb_ + (8 + w) * 1024), 16, 0, 0); } \
        __builtin_amdgcn_global_load_lds((const unsigned*)(vsrc + (long)(t) * 64 * u.kstride), (LAS unsigned*)(kb_ + SLOT_K + w * 1024), 16, 0, 0); } while (0)
    ATT_DMA(t_lo, 0);
    bf16x8 qr[NDQ];
    { const bf16_t* Qw_ = u.q + (long)(32 * w + r32) * u.qstride + hi * 8;
#pragma unroll
      for (int d0 = 0; d0 < (FOX ? 4 : NDQ); ++d0) qr[d0] = *(const bf16x8*)(Qw_ + d0 * 16);
      if (FOX) { const short one = hi ? (short)0 : (short)0x3F80; qr[4] = (bf16x8){one, one, one, 0, 0, 0, 0, 0}; } }
    const float ci = 0.f;
    f32x16 negm;
#pragma unroll
    for (int r = 0; r < 16; ++r) negm[r] = ci;
    float m_run = -1e30f, l_run = 0.f; f32x16 o[2]; o[0] = f32x16{}; o[1] = f32x16{};
    const int koff = hi * 1024 + r32 * 16;
    const int voff = SLOT_K + ((lane >> 4) & 1) * 32 + (lane & 3) * 8 + (4 * hi + ((lane & 15) >> 2)) * 64;
    for (int t = t_lo; t <= t_hi; ++t) {
        const int bsel = (t - t_lo) & 1;
        asm volatile("s_waitcnt vmcnt(0)" ::: "memory");
        __syncthreads();
        if (t < t_hi) ATT_DMA(t + 1, bsel ^ 1);
        const int k0 = 64 * t;
        bool active = (k0 <= Qw + 31); if (BAND) active = active && (Qw - (k0 + 63) <= u.W);
        if (!active) continue;
        const LAS unsigned char* kb = lds + bsel * SLOT;
        f32x16 p0, p1;
        if (BAND) {
#pragma unroll
            for (int r = 0; r < 16; ++r) { p0[r] = 0.f; p1[r] = 0.f; }
        } else { p0 = negm; p1 = negm; }
        __builtin_amdgcn_s_setprio(1);
#pragma unroll
        for (int d0 = 0; d0 < NDQ; ++d0) { const bf16x8 a0 = *(const LAS bf16x8*)(kb + koff + d0 * 2048), a1 = *(const LAS bf16x8*)(kb + koff + d0 * 2048 + 512);
            p0 = __builtin_amdgcn_mfma_f32_32x32x16_bf16(a0, qr[d0], p0, 0, 0, 0); p1 = __builtin_amdgcn_mfma_f32_32x32x16_bf16(a1, qr[d0], p1, 0, 0, 0); }
        __builtin_amdgcn_s_setprio(0);
        const int dbase = Qw + r32 - k0 - 4 * hi;
        float alpha = 1.f; float sacc = 0.f;
        if (BAND) {
#pragma unroll
            for (int r = 0; r < 16; ++r) { const int d0_ = dbase - ((r & 3) + 8 * (r >> 2)), d1_ = d0_ - 32;
                p0[r] = ((unsigned)d0_ <= (unsigned)u.W) ? p0[r] - u.alibi * (float)d0_ : -INFINITY;
                p1[r] = ((unsigned)d1_ <= (unsigned)u.W) ? p1[r] - u.alibi * (float)d1_ : -INFINITY; }
            const float rm = rowmax(p0, p1), m_new = __builtin_fmaxf(m_run, rm);
            alpha = __builtin_amdgcn_exp2f(m_run - m_new);
#pragma unroll
            for (int r = 0; r < 16; ++r) { o[0][r] *= alpha; o[1][r] *= alpha; }
            m_run = m_new;
#pragma unroll
            for (int r = 0; r < 16; ++r) { p0[r] = __builtin_amdgcn_exp2f(p0[r] - m_new); p1[r] = __builtin_amdgcn_exp2f(p1[r] - m_new); sacc += p0[r] + p1[r]; }
        } else {
            if (k0 + 63 > Qw) {
#pragma unroll
                for (int r = 0; r < 16; ++r) { const int d0_ = dbase - ((r & 3) + 8 * (r >> 2));
                    if (d0_ < 0) p0[r] = -INFINITY; if (d0_ < 32) p1[r] = -INFINITY; }
            }
            const float rm = rowmax(p0, p1);
            if (t == 0 || __any(rm > 8.0f)) {
                const float dl = (t == 0) ? rm : __builtin_fmaxf(rm, 0.f);
                alpha = __builtin_amdgcn_exp2f(-dl);
#pragma unroll
                for (int r = 0; r < 16; ++r) { p0[r] -= dl; p1[r] -= dl; negm[r] -= dl; }
                if (t != 0) {
#pragma unroll
                    for (int r = 0; r < 16; ++r) { o[0][r] *= alpha; o[1][r] *= alpha; }
                }
            }
#pragma unroll
            for (int r = 0; r < 16; ++r) { p0[r] = __builtin_amdgcn_exp2f(p0[r]); p1[r] = __builtin_amdgcn_exp2f(p1[r]); sacc += p0[r] + p1[r]; }
        }
        l_run = l_run * alpha + sacc;
        u32x4 pw[4];
#pragma unroll
        for (int j = 0; j < 4; ++j) { pw[0][j] = cvtpk(p0[2 * j], p0[2 * j + 1]); pw[1][j] = cvtpk(p0[8 + 2 * j], p0[9 + 2 * j]); pw[2][j] = cvtpk(p1[2 * j], p1[2 * j + 1]); pw[3][j] = cvtpk(p1[8 + 2 * j], p1[9 + 2 * j]); }
        const LAS unsigned char* vp = kb + voff;
        __builtin_amdgcn_s_setprio(1);
#pragma unroll
        for (int d0 = 0; d0 < 2; ++d0)
#pragma unroll
            for (int ks = 0; ks < 4; ++ks) { const s16x4 lo = vtr(vp + d0 * 4096 + ks * 1024), hh = vtr(vp + d0 * 4096 + ks * 1024 + 512);
                const bf16x8 vf = (bf16x8){lo[0], lo[1], lo[2], lo[3], hh[0], hh[1], hh[2], hh[3]};
                o[d0] = __builtin_amdgcn_mfma_f32_32x32x16_bf16(vf, __builtin_bit_cast(bf16x8, pw[ks]), o[d0], 0, 0, 0); }
        __builtin_amdgcn_s_setprio(0);
    }
#undef ATT_DMA
    { auto rr = __builtin_amdgcn_permlane32_swap(__float_as_uint(l_run), __float_as_uint(l_run), false, false); l_run = __uint_as_float(rr[0]) + __uint_as_float(rr[1]); }
    if (BAND) { if (u.has_sink) l_run += __builtin_amdgcn_exp2f(u.sink - m_run);
                if (u.has_lse) { if (hi == 0) u.lse[(long)(32 * w + r32) * u.lsestride] = m_run + __builtin_amdgcn_logf(l_run); } }
    att_store_ot(o, __builtin_amdgcn_rcpf(l_run), (LAS bf16_t*)(lds + LDS_OST) + w * 2304, u.o + (long)(32 * w) * u.ostride, u.ostride, lane);
    __syncthreads();
}

constexpr int P_LDS_WS = 3 * SLOT, P_LDS_OST = P_LDS_WS + 8 * 256, P_LDS_BYTES = P_LDS_OST + 8 * 4608;
template <int NDQ, bool FOX>
__device__ __forceinline__ void attn_unit_causal(const UnitDesc& u, LAS unsigned char* lds, const int tid) {
    const int lane = tid & 63, r32 = lane & 31, hi = lane >> 5; const int w = __builtin_amdgcn_readfirstlane(tid >> 6);
    const int q0 = u.q0, Qw = q0 + 32 * w, t_hi = (q0 + 255) >> 6, tl = (Qw + 31) >> 6;
    LAS float* wsf = (LAS float*)(lds + P_LDS_WS) + w * 64;
    const unsigned kvo = (unsigned)(lane * (int)u.kstride + w * 8) * 2u, kxo = (unsigned)(lane * (int)u.kxstride + (NDQ == 6 ? (w & 3) * 8 : 0)) * 2u;
    const unsigned vvo = (unsigned)((16 * (w & 3) + (lane >> 2)) * (int)u.kstride + (w >> 2) * 32 + (lane & 3) * 8) * 2u;
    const unsigned ldsb = (unsigned)(uintptr_t)lds + (unsigned)w * 1024u;
#define ATT_DMA(t, slot) do { const unsigned kb_ = ldsb + (unsigned)((slot) * SLOT); \
        pg8::glds_s((const char*)(u.k + (long)(t) * 64 * u.kstride), kvo, kb_); \
        if (w < 2 * (NDQ - 4)) pg8::glds_s((const char*)(u.kx + (long)(t) * 64 * u.kxstride), kxo, kb_ + 8192u); \
        pg8::glds_s((const char*)(u.v + (long)(t) * 64 * u.kstride), vvo, kb_ + (unsigned)SLOT_K); } while (0)
    ATT_DMA(0, 0);
    bf16x8 qr[NDQ];
    { const bf16_t* Qw_ = u.q + (long)(32 * w + r32) * u.qstride + hi * 8;
#pragma unroll
      for (int d0 = 0; d0 < (FOX ? 4 : NDQ); ++d0) qr[d0] = *(const bf16x8*)(Qw_ + d0 * 16);
      if (FOX) { const short one = hi ? (short)0 : (short)0x3F80; qr[NDQ - 1] = (bf16x8){one, one, one, 0, 0, 0, 0, 0}; } }
    float m_ref = -1e30f; f32x16 o[2]; float l_run = 0.f; o[0] = f32x16{}; o[1] = f32x16{};
    constexpr float THR = 30.f;
    const int koff = hi * 1024 + r32 * 16;
    const int voff = SLOT_K + ((lane >> 4) & 1) * 32 + (lane & 3) * 8 + (4 * hi + ((lane & 15) >> 2)) * 64;
    const int dq = r32 - 4 * hi;
#define ATT_KF(kbp, d0, n) (*(const LAS bf16x8*)((kbp) + koff + (d0) * 2048 + (n) * 512))
#define ATT_MASK(P0, P1, t) do { const int db_ = Qw + dq - 64 * (t); _Pragma("unroll") for (int r = 0; r < 16; ++r) { const int d_ = db_ - ((r & 3) + 8 * (r >> 2)); if (d_ < 0) P0[r] = -INFINITY; if (d_ < 32) P1[r] = -INFINITY; } } while (0)
#define ATT_SB() __builtin_amdgcn_sched_barrier(0)
#define ATT_PIN8(X0, X1, b) asm volatile("" : "+v"(X0[b]), "+v"(X0[b + 1]), "+v"(X0[b + 2]), "+v"(X0[b + 3]), "+v"(X1[b]), "+v"(X1[b + 1]), "+v"(X1[b + 2]), "+v"(X1[b + 3]))
    asm volatile("s_waitcnt vmcnt(0)" ::: "memory"); __syncthreads();
    if (t_hi >= 1) ATT_DMA(1, 1);
    f32x16 sa0 = f32x16{}, sa1 = f32x16{}, sb0, sb1;
    { const LAS unsigned char* kb = lds;
#pragma unroll
      for (int d0 = 0; d0 < NDQ; ++d0) { sa0 = __builtin_amdgcn_mfma_f32_32x32x16_bf16(ATT_KF(kb, d0, 0), qr[d0], sa0, 0, 0, 0); sa1 = __builtin_amdgcn_mfma_f32_32x32x16_bf16(ATT_KF(kb, d0, 1), qr[d0], sa1, 0, 0, 0); }
      if (tl == 0) ATT_MASK(sa0, sa1, 0); }
    int slot = 0, t = 0;
#define ATT_STEP(C0, C1, N0, N1) do { \
        const int slot1 = slot == 2 ? 0 : slot + 1, slot2 = slot1 == 2 ? 0 : slot1 + 1; \
        asm volatile("s_waitcnt vmcnt(0)" ::: "memory");                 \
        __syncthreads();                                                 \
        if (t + 2 <= t_hi) ATT_DMA(t + 2, slot2); \
        const LAS unsigned char* kbn = lds + slot1 * SLOT; const LAS unsigned char* vp = lds + slot * SLOT + voff; \
        { const float rm = rowmax(C0, C1); \
          if (__any(rm - m_ref > THR)) { const float m_new = __builtin_fmaxf(m_ref, rm), alpha = __builtin_amdgcn_exp2f(m_ref - m_new); m_ref = m_new; \
            _Pragma("unroll") for (int r = 0; r < 16; ++r) { o[0][r] *= alpha; o[1][r] *= alpha; } l_run *= alpha; } } \
        float sacc = 0.f; u32x4 pw[4]; \
        N0 = f32x16{}; N1 = f32x16{}; \
        { bf16x8 ka = ATT_KF(kbn, 0, 0), kb2 = ATT_KF(kbn, 0, 1); \
          _Pragma("unroll") for (int d0 = 0; d0 < NDQ; ++d0) { \
            bf16x8 na = ka, nb = kb2; if (d0 + 1 < NDQ) { na = ATT_KF(kbn, d0 + 1, 0); nb = ATT_KF(kbn, d0 + 1, 1); } \
            if (d0 < 4) { ATT_PIN8(C0, C1, 4 * d0); } \
            N0 = __builtin_amdgcn_mfma_f32_32x32x16_bf16(ka, qr[d0], N0, 0, 0, 0); N1 = __builtin_amdgcn_mfma_f32_32x32x16_bf16(kb2, qr[d0], N1, 0, 0, 0); \
            if (d0 < 4) { \
                _Pragma("unroll") for (int r = 4 * d0; r < 4 * d0 + 4; ++r) { C0[r] = __builtin_amdgcn_exp2f(C0[r] - m_ref); C1[r] = __builtin_amdgcn_exp2f(C1[r] - m_ref); sacc += C0[r] + C1[r]; } \
                ATT_PIN8(C0, C1, 4 * d0); asm volatile("" : "+v"(sacc)); } \
            ka = na; kb2 = nb; ATT_SB(); } } \
        l_run += sacc; \
        _Pragma("unroll") for (int j = 0; j < 4; ++j) { pw[0][j] = cvtpk(C0[2 * j], C0[2 * j + 1]); pw[1][j] = cvtpk(C0[8 + 2 * j], C0[9 + 2 * j]); pw[2][j] = cvtpk(C1[2 * j], C1[2 * j + 1]); pw[3][j] = cvtpk(C1[8 + 2 * j], C1[9 + 2 * j]); } \
        __builtin_amdgcn_s_setprio(1); \
        _Pragma("unroll") for (int ks = 0; ks < 4; ++ks) _Pragma("unroll") for (int d0 = 0; d0 < 2; ++d0) { const s16x4 lo = vtr(vp + d0 * 4096 + ks * 1024), hh = vtr(vp + d0 * 4096 + ks * 1024 + 512); \
                const bf16x8 vf = (bf16x8){lo[0], lo[1], lo[2], lo[3], hh[0], hh[1], hh[2], hh[3]}; \
                o[d0] = __builtin_amdgcn_mfma_f32_32x32x16_bf16(vf, __builtin_bit_cast(bf16x8, pw[ks]), o[d0], 0, 0, 0); \
                if (d0 == 1 && (ks & 1)) ATT_SB(); } \
        __builtin_amdgcn_s_setprio(0); \
        if (t + 1 == tl) ATT_MASK(N0, N1, t + 1); \
        slot = slot1; ++t; } while (0)
    for (; t + 1 <= tl; ) { ATT_STEP(sa0, sa1, sb0, sb1); ATT_STEP(sb0, sb1, sa0, sa1); }
    if (t <= tl) ATT_STEP(sa0, sa1, sb0, sb1);
    for (; t <= t_hi; ++t) { const int slot1 = slot == 2 ? 0 : slot + 1, slot2 = slot1 == 2 ? 0 : slot1 + 1;
        asm volatile("s_waitcnt vmcnt(0)" ::: "memory"); __syncthreads();
        if (t + 2 <= t_hi) ATT_DMA(t + 2, slot2);
        slot = slot1; }
#undef ATT_STEP
#undef ATT_DMA
#undef ATT_KF
#undef ATT_MASK
#undef ATT_SB
#undef ATT_PIN8
    { auto rr = __builtin_amdgcn_permlane32_swap(__float_as_uint(l_run), __float_as_uint(l_run), false, false); l_run = __uint_as_float(rr[0]) + __uint_as_float(rr[1]); }
    att_store_ot(o, __builtin_amdgcn_rcpf(l_run), (LAS bf16_t*)(lds + P_LDS_OST) + w * 2304, u.o + (long)(32 * w) * u.ostride, u.ostride, lane);
    __syncthreads();
}
}
namespace mk {
constexpr int NWAVES = 8, NTHREADS = 512;
constexpr int RING_BYTES = 131072, MISC_OFF = RING_BYTES, LDS_BYTES = 147456;
constexpr int MISC_PRE = MISC_OFF + 1024, MISC_CNT = MISC_PRE + 512, MISC_STASH = MISC_OFF + 2048;
constexpr int NPHASE = 17;
#define LDS_WAIT() asm volatile("s_waitcnt lgkmcnt(0)" ::: "memory")

struct Args { const float* in[21]; float* out; unsigned char* ws; float* H; int ph_lo, ph_hi; int use_bar, pad; };

typedef const __attribute__((address_space(4))) Args* cargs_t;
__device__ __forceinline__ Args load_args() {
#if defined(__HIP_DEVICE_COMPILE__)
    cargs_t p = (cargs_t)__builtin_amdgcn_kernarg_segment_ptr(); asm volatile("" : "+s"(p)); Args a;
#pragma unroll
    for (int i = 0; i < 21; ++i) a.in[i] = p->in[i];
    a.out = p->out; a.ws = p->ws; a.H = p->H; a.ph_lo = p->ph_lo; a.ph_hi = p->ph_hi; a.use_bar = p->use_bar; a.pad = 0; return a;
#else
    return Args{};
#endif
}

#define XB_TMO      128
#define XB_XCNT(j)  (256  + 64 * (j))
#define XB_XSUB(j)  (1280 + 64 * (j))
#define XB_XGEN(j)  (2304 + 64 * (j))
#define XB_TOP      3328
#define XB_TOPGEN   3392
#define XCD_BAR_WORDS 3456
#define XB_SPIN_CAP (1u << 18)
__device__ __forceinline__ unsigned xb_ld(unsigned* p)              { return __hip_atomic_load(p, __ATOMIC_RELAXED, __HIP_MEMORY_SCOPE_AGENT); }
__device__ __forceinline__ unsigned xb_add(unsigned* p, unsigned v) { return __hip_atomic_fetch_add(p, v, __ATOMIC_RELAXED, __HIP_MEMORY_SCOPE_AGENT); }
__device__ __forceinline__ unsigned xb_xcc_id() { return (unsigned)__builtin_amdgcn_s_getreg((3 << 11) | 20) & 0xFu; }
#define XB_SPIN(cond, bar) do { unsigned _sp = 0; while (cond) { __builtin_amdgcn_s_sleep(1); \
    if ((++_sp & 255u) == 0u) { if (xb_ld(&(bar)[XB_TMO])) break; if (_sp > XB_SPIN_CAP) { atomicAdd(&(bar)[XB_TMO], 1u); break; } } } } while (0)
struct XcdBarrier { unsigned* bar; unsigned x; volatile LAS unsigned* st; };
__device__ __forceinline__ XcdBarrier xcd_barrier_post(unsigned* bar, volatile LAS unsigned* st) {
    XcdBarrier b; b.bar = bar; b.x = xb_xcc_id(); b.st = st;
    if (threadIdx.x == 0) (void)xb_add(&bar[XB_XCNT(b.x)], 1u);
    return b;
}
__device__ __forceinline__ void xcd_barrier_complete(unsigned* bar, unsigned x, unsigned& nloc, unsigned& nx) {
    const unsigned G = gridDim.x * gridDim.y * gridDim.z;
    unsigned sum, cnt, mine, sp = 0u;
    for (;;) {
        sum = 0u; cnt = 0u; mine = 0u;
#pragma unroll
        for (unsigned j = 0; j < 16; ++j) { const unsigned c = xb_ld(&bar[XB_XCNT(j)]); sum += c; cnt += (c > 0u) ? 1u : 0u; mine = (j == x) ? c : mine; }
        if (sum == G) break;
        __builtin_amdgcn_s_sleep(1);
        if ((++sp & 255u) == 0u) { if (xb_ld(&bar[XB_TMO])) break; if (sp > XB_SPIN_CAP) { atomicAdd(&bar[XB_TMO], 1u); break; } }
    }
    nloc = mine > 0u ? mine : 1u; nx = cnt > 0u ? cnt : 1u;
}
__device__ __forceinline__ void xcd_barrier(const XcdBarrier& b) {
    asm volatile("s_waitcnt vmcnt(0)" ::: "memory");
    __syncthreads();
    if (threadIdx.x == 0) {
        unsigned* bar = b.bar;
        __builtin_amdgcn_s_waitcnt(0);
        unsigned nloc = b.st[0], nx = b.st[1];
        if (nloc == 0u) { xcd_barrier_complete(bar, b.x, nloc, nx); b.st[0] = nloc; b.st[1] = nx; }
        const unsigned old = xb_add(&bar[XB_XSUB(b.x)], 1u);
        const unsigned gen = old / nloc;
        if (old + 1u == (gen + 1u) * nloc) {
            __builtin_amdgcn_fence(__ATOMIC_RELEASE, "agent");
            asm volatile("s_waitcnt vmcnt(0)" ::: "memory");
            const unsigned og = xb_add(&bar[XB_TOP], 1u);
            const unsigned tg = og / nx;
            if (og + 1u == (tg + 1u) * nx) xb_add(&bar[XB_TOPGEN], 1u);
            else XB_SPIN(xb_ld(&bar[XB_TOPGEN]) == tg, bar);
            __builtin_amdgcn_fence(__ATOMIC_ACQUIRE, "agent");
            xb_add(&bar[XB_XGEN(b.x)], 1u);
            asm volatile("s_waitcnt vmcnt(0)" ::: "memory");
        } else {
            XB_SPIN(xb_ld(&bar[XB_XGEN(b.x)]) == gen, bar);
            __builtin_amdgcn_fence(__ATOMIC_ACQUIRE, "agent");
            asm volatile("s_waitcnt vmcnt(0)" ::: "memory");
        }
    }
    __syncthreads();
}
constexpr int MISC_BAR = MISC_OFF + 64;
__device__ __forceinline__ void grid_barrier(const Args& a, LAS unsigned char* lds) {
    XcdBarrier b; b.bar = (unsigned*)(a.ws + WS_CTL) + CW_BAR; b.x = xb_xcc_id(); b.st = (volatile LAS unsigned*)(lds + MISC_BAR);
    xcd_barrier(b);
}
__device__ __forceinline__ float wave_sum(float v) {
#pragma unroll
    for (int o = 1; o < 64; o <<= 1) v += __shfl_xor(v, o);
    return v;
}
__device__ __forceinline__ void tr_item(const float* src, int lds_, int ncols, const float* scale, bf16_t* dst, int ldd, LAS float* scr, int lane) {
    float v[32]; const int c0 = lane & 31, kh = lane >> 5;
#pragma unroll
    for (int i = 0; i < 32; ++i) v[i] = (src && c0 < ncols) ? src[(size_t)(2 * i + kh) * lds_ + c0] : 0.f;
    const int c = lane & 7; f32x4 s0 = (f32x4){1.f, 1.f, 1.f, 1.f}, s1 = s0;
    if (scale) { s0 = *(const f32x4*)(scale + 8 * c); s1 = *(const f32x4*)(scale + 8 * c + 4); }
#pragma unroll
    for (int i = 0; i < 32; ++i) scr[(2 * i + kh) * 33 + c0] = v[i];
    LDS_WAIT(); asm volatile("" ::: "memory");
#pragma unroll
    for (int j = 0; j < 4; ++j) { const int n = (lane >> 3) + 8 * j; const LAS float* s = scr + (8 * c) * 33 + n;
        u32x4 o; o.x = cvtpk(s[0 * 33] * s0[0], s[1 * 33] * s0[1]); o.y = cvtpk(s[2 * 33] * s0[2], s[3 * 33] * s0[3]); o.z = cvtpk(s[4 * 33] * s1[0], s[5 * 33] * s1[1]); o.w = cvtpk(s[6 * 33] * s1[2], s[7 * 33] * s1[3]);
        st16s(dst + (size_t)n * ldd + 8 * c, 0, o); }
    LDS_WAIT(); asm volatile("" ::: "memory");
}
struct TrMat { const float* W; int K, ldw; const float* scale; bf16_t* WT; int nblk; int kind; };
__device__ __forceinline__ int tr_srccol(int kind, int n0) {
    switch (kind) {
    case 0: return n0;
    case 1: return n0 < 1536 ? n0 : n0 + 8;
    case 2: return n0 < 384 ? n0 : (n0 < 416 ? n0 + 256 : (n0 < 512 ? -1 : (n0 < 768 ? n0 - 128 : n0 - 96)));
    default: return n0; }
}
__device__ __forceinline__ void tr_mat_item(const TrMat& m, int item, LAS float* scr, int lane) {
    const int kb = item / m.nblk, nb = item % m.nblk, k0 = 64 * kb, n0 = 32 * nb; const int sc = tr_srccol(m.kind, n0);
    tr_item(sc < 0 ? nullptr : m.W + (size_t)k0 * m.ldw + sc, m.ldw, 32, m.scale ? m.scale + k0 : nullptr, m.WT + (size_t)n0 * m.K + k0, m.K, scr, lane);
}

__device__ __forceinline__ void dense_mats(const Args& a, TrMat (&M)[6]) {
    unsigned char* ws = a.ws; const float* attn_norm = a.in[1];
    M[0] = TrMat{a.in[4], 1024, 3080, attn_norm, (bf16_t*)(ws + WS_WIN0), 96, 1};
    M[1] = TrMat{a.in[6], 1024, 1024, nullptr, (bf16_t*)(ws + WS_WOUT0), 32, 0};
    M[2] = TrMat{a.in[7], 1024, 1440, attn_norm + 1024, (bf16_t*)(ws + WS_WIN1), 48, 2};
    M[3] = TrMat{a.in[10], 384, 768, a.in[8], (bf16_t*)(ws + WS_WUQ), 24, 0};
    M[4] = TrMat{a.in[11], 256, 1024, a.in[9], (bf16_t*)(ws + WS_WUKV), 32, 0};
    M[5] = TrMat{a.in[13], 1024, 1024, nullptr, (bf16_t*)(ws + WS_WOUT1), 32, 0};
}
__device__ __forceinline__ void router_item(const Args& a, int it, LAS float* scr, int lane) {
    const float* ffn_norm = a.in[2]; const int l = it >> 5, r = it & 31, kb = r >> 1, nb = r & 1, k0 = 64 * kb;
    bf16_t* dst = (bf16_t*)(a.ws + WS_WR) + (size_t)l * 64 * 1024 + (size_t)(32 * nb) * 1024 + k0;
    if (nb == 0) tr_item(a.in[16] + (size_t)l * 1024 * 32 + (size_t)k0 * 32, 32, 32, ffn_norm + l * 1024 + k0, dst, 1024, scr, lane);
    else tr_item(a.in[14] + (size_t)l * 1024 * 4 + (size_t)k0 * 4, 4, 4, ffn_norm + l * 1024 + k0, dst, 1024, scr, lane);
}
template <int PART>
__device__ __forceinline__ void p0_prologue(const Args& a, LAS unsigned char* lds, int gw, int NGW, int wave, int lane) {
    unsigned char* ws = a.ws; LAS float* scr = (LAS float*)(lds + wave * 16384);
    const float* attn_norm = a.in[1];
    TrMat M[6]; dense_mats(a, M);
    const int cnt[6] = {16 * 96, 16 * 32, 16 * 48, 6 * 24, 4 * 32, 16 * 32};
    int base = 0;
#pragma unroll
    for (int mi = 0; mi < 6; ++mi) { if ((mi == 0) == (PART == 0)) { for (int it = (gw + NGW - base % NGW) % NGW; it < cnt[mi]; it += NGW) tr_mat_item(M[mi], it, scr, lane); base += cnt[mi]; } }
    if (PART == 1) for (int it = gw; it < 64; it += NGW) router_item(a, it, scr, lane);
    if (PART == 1) { f32x2* rope = (f32x2*)(ws + WS_ROPE);
      for (int i = gw * 64 + lane; i < S * 16; i += NGW * 64) { const int pos = i >> 4, j = i & 15; const float inv = powf(10000.0f, -(float)(2 * j) / 32.0f), ang = (float)pos * inv; float sn, cs; sincosf(ang, &sn, &cs); rope[i] = (f32x2){cs, sn}; } }
    if (PART == 0) { const float* x = a.in[0]; const float* win = a.in[4]; const float* bfp = a.in[5];
      bf16_t* XB = (bf16_t*)(ws + WS_XB); float* SS = (float*)(ws + WS_SS); float* LOGF = (float*)(ws + WS_LOGF);
      float wz[4][4][8];
#pragma unroll
      for (int j = 0; j < 4; ++j)
#pragma unroll
          for (int e = 0; e < 4; ++e) { const int k = 256 * j + 4 * lane + e; const float g = attn_norm[k]; const f32x4 w0 = *(const f32x4*)(win + (size_t)k * 3080 + 1536), w1 = *(const f32x4*)(win + (size_t)k * 3080 + 1540);
#pragma unroll
              for (int h = 0; h < 4; ++h) { wz[j][e][h] = w0[h] * g; wz[j][e][4 + h] = w1[h] * g; } }
      for (int row = gw; row < N; row += NGW) {
          const f32x4* xr = (const f32x4*)(x + (size_t)row * D) + lane; f32x4 v[4]; float ssq = 0.f; float zf[8];
#pragma unroll
          for (int h = 0; h < 8; ++h) zf[h] = 0.f;
#pragma unroll
          for (int j = 0; j < 4; ++j) { v[j] = xr[64 * j]; ssq += (v[j][0] * v[j][0] + v[j][1] * v[j][1]) + (v[j][2] * v[j][2] + v[j][3] * v[j][3]);
#pragma unroll
              for (int e = 0; e < 4; ++e)
#pragma unroll
                  for (int h = 0; h < 8; ++h) zf[h] += v[j][e] * wz[j][e][h]; }
          ssq = wave_sum(ssq);
#pragma unroll
          for (int h = 0; h < 8; ++h) zf[h] = wave_sum(zf[h]);
          u32x2* o8 = (u32x2*)(XB + (size_t)row * D) + lane;
#pragma unroll
          for (int j = 0; j < 4; ++j) { u32x2 wv; wv.x = cvtpk(v[j][0], v[j][1]); wv.y = cvtpk(v[j][2], v[j][3]); st8s(o8, 512 * j, wv); }
          if (lane == 0) SS[row] = ssq;
          const float rstd = 1.f / sqrtf(ssq * (1.f / D) + EPS);
          float zsel = zf[0];
#pragma unroll
          for (int h = 1; h < 8; ++h) zsel = (lane == h) ? zf[h] : zsel;
          if (lane < 8) { const float xg = zsel * rstd + bfp[lane]; LOGF[(size_t)row * 8 + lane] = fminf(xg, 0.f) - log1pf(expf(-fabsf(xg))); }
      } }
}
__device__ __forceinline__ void fox_cumsum(const Args& a, LAS unsigned char* lds, int G, const int tid) {
    const float* LOGF = (const float*)(a.ws + WS_LOGF); float* KB = (float*)(a.ws + WS_CB2); u32x4* KX = (u32x4*)(a.ws + WS_KEXT); LAS float* part = (LAS float*)lds;
    const int t = tid, lane = t & 63, wv = t >> 6;
    for (int bh = blockIdx.x; bh < 32; bh += G) { const int b = bh >> 3, h = bh & 7; float loc[8]; float run = 0.f;
#pragma unroll
        for (int i = 0; i < 8; ++i) { run += LOGF[(size_t)(b * S + t * 8 + i) * 8 + h]; loc[i] = run; }
        float inc = run;
#pragma unroll
        for (int o = 1; o < 64; o <<= 1) { const float up = __shfl_up(inc, o); if (lane >= o) inc += up; }
        __syncthreads();
        if (lane == 63) part[wv] = inc;
        __syncthreads();
        float off = inc - run;
        for (int i = 0; i < wv; ++i) off += part[i];
#pragma unroll
        for (int i = 0; i < 8; ++i) { const float kb = -LOG2E * (loc[i] + off); KB[(size_t)bh * S + t * 8 + i] = kb;
            const unsigned h1 = cvtpk(kb, 0.f) & 0xffffu; const float r1 = kb - bflo(h1); const unsigned h2 = cvtpk(r1, 0.f) & 0xffffu; const float r2 = r1 - bflo(h2); const unsigned h3 = cvtpk(r2, 0.f) & 0xffffu;
            KX[(size_t)bh * S + t * 8 + i] = (u32x4){h1 | (h2 << 16), h3, 0u, 0u}; }
    }
    __syncthreads();
}
__device__ __forceinline__ void attn_phase0(const Args& a, LAS unsigned char* lds, int vcu, int G, const int tid) {
    const bf16_t* QKV = (const bf16_t*)(a.ws + R1_QKV0); bf16_t* AO = (bf16_t*)(a.ws + R2_AO); bf16_t* DP = (bf16_t*)(a.ws + R2_DPART);
    float* DLSE = (float*)(a.ws + WS_DLSE); const float* KB = (const float*)(a.ws + WS_CB2);
    for (int it = vcu; it < 256 + 1536; it += G) {
        if (it < 256) { const int bh = it >> 3, s = it & 7, b = bh >> 3, h = bh & 7;
            for (int half = 0; half < 2; ++half) { const int qb = half ? 15 - s : s; att::UnitDesc u{};
                const bf16_t* base = QKV + (size_t)b * S * 3072 + h * 64;
                u.q = base + (size_t)(qb * 256) * 3072; u.qstride = 3072; u.k = base + 512; u.v = base + 1024; u.kstride = 3072;
                u.o = AO + (size_t)(b * S + qb * 256) * 1024 + h * 64; u.ostride = 1024; u.kbias = KB + (size_t)bh * S; u.kx = (const bf16_t*)(a.ws + WS_KEXT) + (size_t)bh * S * 8; u.kxstride = 8; u.q0 = qb * 256; u.W = 1 << 30;
                { int tid_ = tid; asm volatile("" : "+v"(tid_)); att::attn_unit_causal<5, true>(u, lds, tid_); } }
        } else { const int j = it - 256, bh = j / 48, rem = j % 48, br = rem >> 4, idx = rem & 15, b = bh >> 3, h = bh & 7;
            const int dil = br == 0 ? 1 : (br == 1 ? 4 : 16), c = br == 0 ? 0 : (br == 1 ? idx >> 2 : idx), qblk = br == 0 ? idx : (br == 1 ? idx & 3 : 0);
            att::UnitDesc u{}; const bf16_t* base = QKV + (size_t)(b * S + c) * 3072 + 1536 + h * 64; const long st = (long)dil * 3072;
            u.q = base + (size_t)(qblk * 256) * st; u.qstride = st; u.k = base + 512; u.v = base + 1024; u.kstride = st;
            const size_t tok0 = (size_t)b * S + c + (size_t)qblk * 256 * dil;
            u.o = DP + (size_t)br * N * 512 + tok0 * 512 + h * 64; u.ostride = (long)dil * 512;
            u.lse = DLSE + (size_t)br * N * 8 + tok0 * 8 + h; u.lsestride = (long)dil * 8; u.has_lse = true;
            u.q0 = qblk * 256; u.W = 128; u.alibi = exp2f(-(float)(h + 1)) * (float)dil * LOG2E;
            { int tid_ = tid; asm volatile("" : "+v"(tid_)); att::attn_unit<4, false, true>(u, lds, tid_); } }
    }
}
__device__ __forceinline__ void attn_phase1(const Args& a, LAS unsigned char* lds, int vcu, int G, const int tid) {
    const bf16_t* Z1 = (const bf16_t*)(a.ws + R1_Z1); const bf16_t* Q1 = (const bf16_t*)(a.ws + R1_Q1); const bf16_t* KV = (const bf16_t*)(a.ws + R1_KV1);
    bf16_t* AO = (bf16_t*)(a.ws + R2_AO); const float* sinks = a.in[12];
    for (int it = vcu; it < 256 + 512; it += G) {
        if (it < 256) { const int bh = it >> 3, s = it & 7, b = bh >> 3, h = bh & 7;
            for (int half = 0; half < 2; ++half) { const int qb = half ? 15 - s : s; att::UnitDesc u{};
                u.q = Q1 + (size_t)(b * S + qb * 256) * 768 + h * 96; u.qstride = 768;
                u.k = KV + (size_t)b * S * 1024 + h * 128; u.v = u.k + 64; u.kstride = 1024; u.kx = Z1 + (size_t)b * S * 1536 + 384; u.kxstride = 1536;
                u.o = AO + (size_t)(b * S + qb * 256) * 1024 + h * 64; u.ostride = 1024; u.q0 = qb * 256; u.W = 1 << 30;
                { int tid_ = tid; asm volatile("" : "+v"(tid_)); att::attn_unit_causal<6, false>(u, lds, tid_); } }
        } else { const int j = it - 256, b = j >> 7, hq = (j >> 4) & 7, qb = j & 15, kvh = hq >> 2; att::UnitDesc u{};
            const bf16_t* base = Z1 + (size_t)b * S * 1536;
            u.q = base + (size_t)(qb * 256) * 1536 + 768 + hq * 64; u.qstride = 1536; u.k = base + 1280 + kvh * 64; u.v = base + 1408 + kvh * 64; u.kstride = 1536;
            u.o = AO + (size_t)(b * S + qb * 256) * 1024 + 512 + hq * 64; u.ostride = 1024; u.q0 = qb * 256; u.W = 127;
            u.alibi = exp2f(-(float)(hq + 1)) * LOG2E; u.has_sink = true; u.sink = sinks[hq] * LOG2E;
            { int tid_ = tid; asm volatile("" : "+v"(tid_)); att::attn_unit<4, false, true>(u, lds, tid_); } }
    }
}
__device__ __forceinline__ void merge_phase(const Args& a, int gw, int NGW, int lane) {
    const bf16_t* DP = (const bf16_t*)(a.ws + R2_DPART); const float* DLSE = (const float*)(a.ws + WS_DLSE); bf16_t* AO = (bf16_t*)(a.ws + R2_AO);
    for (int tok = gw; tok < N; tok += NGW) { const int h = lane >> 3;
        const float l0 = DLSE[(size_t)tok * 8 + h], l1 = DLSE[(size_t)N * 8 + (size_t)tok * 8 + h], l2 = DLSE[(size_t)2 * N * 8 + (size_t)tok * 8 + h];
        const float mx = fmaxf(l0, fmaxf(l1, l2)); float w0 = exp2f(l0 - mx), w1 = exp2f(l1 - mx), w2 = exp2f(l2 - mx); const float inv = 1.f / (w0 + w1 + w2); w0 *= inv; w1 *= inv; w2 *= inv;
        const u32x4 a0 = *(const u32x4*)(DP + (size_t)tok * 512 + lane * 8), a1 = *(const u32x4*)(DP + (size_t)N * 512 + (size_t)tok * 512 + lane * 8), a2 = *(const u32x4*)(DP + (size_t)2 * N * 512 + (size_t)tok * 512 + lane * 8);
        u32x4 o;
#pragma unroll
        for (int i = 0; i < 4; ++i) { const float lo = w0 * bflo(a0[i]) + w1 * bflo(a1[i]) + w2 * bflo(a2[i]), hi = w0 * bfhi(a0[i]) + w1 * bfhi(a1[i]) + w2 * bfhi(a2[i]); o[i] = cvtpk(lo, hi); }
        st16s(AO + (size_t)tok * 1024 + 512 + lane * 8, 0, o); }
}
__device__ __forceinline__ void route_phase(const Args& a, int layer, LAS unsigned char* lds, int vcu, int G, int wave, int lane) {
    const bf16_t* HB = (const bf16_t*)(a.ws + WS_XB); const bf16_t* WR = (const bf16_t*)(a.ws + WS_WR) + (size_t)layer * 64 * 1024;
    const float* SSP = (const float*)(a.ws + WS_SSP); const float* bg = a.in[15] + layer * 4; const float* br = a.in[17] + layer * 32;
    unsigned* cnt = (unsigned*)(a.ws + WS_CTL) + CW_CNT + layer * 1024;
    unsigned* LT = (unsigned*)(a.ws + WS_LT); float* LW = (float*)(a.ws + WS_LW); float* LR = (float*)(a.ws + WS_LR);
    const int r32 = lane & 31, hi = lane >> 5, kq = wave & 3, half = wave >> 2;
    for (int b0 = vcu * 2; b0 < N / 32; b0 += G * 2) {
        const int blk = b0 + half; const bool live = blk < N / 32; const int tok = (live ? blk : 0) * 32 + r32;
        f32x16 c0 = f32x16{}, c1 = f32x16{}; int E_ = 0, myrank_ = 0, mycnt_ = 0; float wsel_ = 0.f, rstd_ = 0.f;
        const bf16_t* xb = HB + (size_t)tok * 1024 + kq * 256 + hi * 8; const bf16_t* wa = WR + (size_t)r32 * 1024 + kq * 256 + hi * 8;
        if (live) {
#pragma unroll 8
            for (int k0 = 0; k0 < 256; k0 += 16) { const bf16x8 bx = *(const bf16x8*)(xb + k0), a0 = *(const bf16x8*)(wa + k0), a1 = *(const bf16x8*)(wa + 32 * 1024 + k0);
                c0 = __builtin_amdgcn_mfma_f32_32x32x16_bf16(a0, bx, c0, 0, 0, 0); c1 = __builtin_amdgcn_mfma_f32_32x32x16_bf16(a1, bx, c1, 0, 0, 0); } }
        LAS f32x4* red = (LAS f32x4*)(lds + wave * 16384 + 9216) + lane * 5;
        if (kq != 0) { red[0] = (f32x4){c0[0], c0[1], c0[2], c0[3]}; red[1] = (f32x4){c0[4], c0[5], c0[6], c0[7]}; red[2] = (f32x4){c0[8], c0[9], c0[10], c0[11]}; red[3] = (f32x4){c0[12], c0[13], c0[14], c0[15]}; red[4] = (f32x4){c1[0], c1[1], c1[2], c1[3]}; }
        __syncthreads();
        if (kq == 0 && live) {
#pragma unroll
            for (int q = 1; q < 4; ++q) { const LAS f32x4* rq = (const LAS f32x4*)(lds + (wave + q) * 16384 + 9216) + lane * 5;
#pragma unroll
                for (int g = 0; g < 4; ++g) { const f32x4 t = rq[g]; c0[4 * g] += t[0]; c0[4 * g + 1] += t[1]; c0[4 * g + 2] += t[2]; c0[4 * g + 3] += t[3]; }
                const f32x4 t = rq[4]; c1[0] += t[0]; c1[1] += t[1]; c1[2] += t[2]; c1[3] += t[3]; }
            const f32x4* sp = (const f32x4*)(SSP + (size_t)tok * 16); const f32x4 s0 = sp[0], s1 = sp[1], s2 = sp[2], s3 = sp[3];
            const float ssq = ((s0[0] + s0[1]) + (s0[2] + s0[3])) + ((s1[0] + s1[1]) + (s1[2] + s1[3])) + ((s2[0] + s2[1]) + (s2[2] + s2[3])) + ((s3[0] + s3[1]) + (s3[2] + s3[3]));
            const float rstd = 1.f / sqrtf(ssq * (1.f / 1024.f) + EPS);
            float gl[4];
#pragma unroll
            for (int j = 0; j < 4; ++j) { const float mine = c1[j]; const float other = __shfl_xor(mine, 32); gl[j] = (hi == 0 ? mine : other) * rstd + bg[j]; }
            int gi = 0; float gm = gl[0];
#pragma unroll
            for (int j = 1; j < 4; ++j) if (gl[j] > gm) { gm = gl[j]; gi = j; }
            float den = 0.f;
#pragma unroll
            for (int j = 0; j < 4; ++j) den += __expf(gl[j] - gm);
            const float gwt = 1.f / den;
            float mine4[4];
#pragma unroll
            for (int j = 0; j < 4; ++j) { float v = c0[j]; v = (gi == 1) ? c0[4 + j] : v; v = (gi == 2) ? c0[8 + j] : v; v = (gi == 3) ? c0[12 + j] : v; mine4[j] = v; }
            float el[8];
#pragma unroll
            for (int j = 0; j < 4; ++j) { const float other = __shfl_xor(mine4[j], 32); el[j] = (hi == 0 ? mine4[j] : other); el[4 + j] = (hi == 0 ? other : mine4[j]); }
#pragma unroll
            for (int j = 0; j < 8; ++j) el[j] = el[j] * rstd + br[gi * 8 + j];
            int i1 = 0; float v1 = el[0];
#pragma unroll
            for (int j = 1; j < 8; ++j) if (el[j] > v1) { v1 = el[j]; i1 = j; }
            int i2 = -1; float v2 = -INFINITY;
#pragma unroll
            for (int j = 0; j < 8; ++j) if (j != i1 && el[j] > v2) { v2 = el[j]; i2 = j; }
            const float e2 = __expf(v2 - v1); const float w1 = gwt / (1.f + e2), w2 = gwt * e2 / (1.f + e2);
            const int E = gi * 8 + (hi == 0 ? i1 : i2); const float wsel = hi == 0 ? w1 : w2;
            int myrank = 0, mycnt = 0; const unsigned long long ltmask = (1ull << lane) - 1ull;
#pragma unroll 4
            for (int j = 0; j < 32; ++j) { const unsigned long long mj = __ballot(E == j); if (E == j) myrank = __popcll(mj & ltmask); if (lane == j) mycnt = __popcll(mj); }
            E_ = E; wsel_ = wsel; rstd_ = rstd; myrank_ = myrank; mycnt_ = mycnt;
        }
        LAS unsigned* ag = (LAS unsigned*)(lds + MISC_OFF + 256);
        if (kq == 0 && half == 1 && lane < 32) ag[lane] = live ? (unsigned)mycnt_ : 0u;
        __syncthreads();
        unsigned basev = 0;
        if (kq == 0 && half == 0 && lane < 32) { const unsigned mine = live ? (unsigned)mycnt_ : 0u, tot = mine + ag[lane];
            if (tot > 0u) basev = atomicAdd(cnt + lane * 16, tot);
            ag[32 + lane] = basev + mine; }
        __syncthreads();
        if (kq == 0 && live) {
            if (half == 1 && lane < 32) basev = ag[32 + lane];
            const unsigned base = (unsigned)__shfl((int)basev, E_);
            const size_t pos = (size_t)E_ * N + base + myrank_;
            LT[pos] = (unsigned)tok | ((unsigned)hi << 31); LW[pos] = wsel_; LR[pos] = rstd_;
        }
        __syncthreads();
    }
}
constexpr int MOE_CONV_ITEMS = 32 * 256 + 32 * 128;
struct TrDesc { const float* src; int lds_; const float* scale; bf16_t* dst; int ldd; };
__device__ __forceinline__ TrDesc moe_desc(const Args& a, int layer, int it) {
    const float* wg = a.in[18] + (size_t)layer * 32 * 1024 * 256; const float* wu = a.in[19] + (size_t)layer * 32 * 1024 * 256; const float* wd = a.in[20] + (size_t)layer * 32 * 256 * 1024;
    const float* g = a.in[2] + layer * 1024; bf16_t* WGU = (bf16_t*)(a.ws + (layer ? R2_WGU1 : R1_WGU)); bf16_t* WD = (bf16_t*)(a.ws + (layer ? R2_WD1 : R1_WD));
    if (it < 32 * 256) { const int e = it >> 8, r = it & 255, kb = r >> 4, nb = r & 15, k0 = 64 * kb, n0 = 32 * nb;
        const int t = n0 >> 8, s = (n0 >> 7) & 1, j = n0 & 127; const float* src = (s ? wu : wg) + (size_t)e * 1024 * 256 + (size_t)k0 * 256 + 128 * t + j;
        return TrDesc{src, 256, g + k0, WGU + ((size_t)e * 512 + n0) * 1024 + k0, 1024};
    } else { const int i2 = it - 32 * 256, e = i2 >> 7, r = i2 & 127, kb = r >> 5, nb = r & 31, k0 = 64 * kb, n0 = 32 * nb;
        return TrDesc{wd + (size_t)e * 256 * 1024 + (size_t)k0 * 1024 + n0, 1024, nullptr, WD + ((size_t)e * 1024 + n0) * 256 + k0, 256}; }
}
__device__ __forceinline__ void tr_load(const TrDesc& d, float (&v)[32], int lane) {
    const int c0 = lane & 31, kh = lane >> 5;
#pragma unroll
    for (int i = 0; i < 32; ++i) v[i] = d.src[(size_t)(2 * i + kh) * d.lds_ + c0];
}
__device__ __forceinline__ void tr_store(const TrDesc& d, const float (&v)[32], LAS float* scr, int lane) {
    const int c0 = lane & 31, kh = lane >> 5, c = lane & 7; f32x4 s0 = (f32x4){1.f, 1.f, 1.f, 1.f}, s1 = s0;
    if (d.scale) { s0 = *(const f32x4*)(d.scale + 8 * c); s1 = *(const f32x4*)(d.scale + 8 * c + 4); }
#pragma unroll
    for (int i = 0; i < 32; ++i) scr[(2 * i + kh) * 33 + c0] = v[i];
    LDS_WAIT(); asm volatile("" ::: "memory");
#pragma unroll
    for (int j = 0; j < 4; ++j) { const int n = (lane >> 3) + 8 * j; const LAS float* s = scr + (8 * c) * 33 + n;
        u32x4 o; o.x = cvtpk(s[0 * 33] * s0[0], s[1 * 33] * s0[1]); o.y = cvtpk(s[2 * 33] * s0[2], s[3 * 33] * s0[3]); o.z = cvtpk(s[4 * 33] * s1[0], s[5 * 33] * s1[1]); o.w = cvtpk(s[6 * 33] * s1[2], s[7 * 33] * s1[3]);
        st16s(d.dst + (size_t)n * d.ldd + 8 * c, 0, o); }
    LDS_WAIT(); asm volatile("" ::: "memory");
}
__device__ __forceinline__ void moe_convert(const Args& a, int layer, LAS unsigned char* lds, int gw, int NGW, int wave, int lane) {
    LAS float* scr = (LAS float*)(lds + wave * 16384);
    int it = gw; if (it >= MOE_CONV_ITEMS) return;
    TrDesc da = moe_desc(a, layer, it), db = da; float va[32], vb[32]; tr_load(da, va, lane);
    for (;;) {
        const int it2 = it + NGW; const bool h2 = it2 < MOE_CONV_ITEMS;
        if (h2) { db = moe_desc(a, layer, it2); tr_load(db, vb, lane); }
        tr_store(da, va, scr, lane); if (!h2) break;
        const int it3 = it2 + NGW; const bool h3 = it3 < MOE_CONV_ITEMS;
        if (h3) { da = moe_desc(a, layer, it3); tr_load(da, va, lane); }
        tr_store(db, vb, scr, lane); if (!h3) break;
        it = it3; }
}
__device__ __forceinline__ void combine_phase(const Args& a, bool last, int gw, int NGW, int lane) {
    const bf16_t* Y = (const bf16_t*)(a.ws + (last ? Y1_BASE : R2_Y)); bf16_t* XB = (bf16_t*)(a.ws + WS_XB); float* SS = (float*)(a.ws + WS_SS); const float* g = a.in[3];
    for (int row = gw; row < N; row += NGW) {
        u32x2* xr = (u32x2*)(XB + (size_t)row * D) + lane; const u32x2* y0 = (const u32x2*)(Y + (size_t)row * D) + lane; const u32x2* y1 = (const u32x2*)(Y + (size_t)N * D + (size_t)row * D) + lane;
        f32x4 v[4]; float ssq = 0.f; u32x2 hx[4], p[4], q[4];
#pragma unroll
        for (int j = 0; j < 4; ++j) { hx[j] = xr[64 * j]; p[j] = y0[64 * j]; q[j] = y1[64 * j]; }
#pragma unroll
        for (int j = 0; j < 4; ++j) {
            v[j][0] = bflo(hx[j].x) + bflo(p[j].x) + bflo(q[j].x); v[j][1] = bfhi(hx[j].x) + bfhi(p[j].x) + bfhi(q[j].x); v[j][2] = bflo(hx[j].y) + bflo(p[j].y) + bflo(q[j].y); v[j][3] = bfhi(hx[j].y) + bfhi(p[j].y) + bfhi(q[j].y);
            ssq += (v[j][0] * v[j][0] + v[j][1] * v[j][1]) + (v[j][2] * v[j][2] + v[j][3] * v[j][3]); }
        ssq = wave_sum(ssq);
        if (!last) {
#pragma unroll
            for (int j = 0; j < 4; ++j) { u32x2 wv; wv.x = cvtpk(v[j][0], v[j][1]); wv.y = cvtpk(v[j][2], v[j][3]); st8s(xr, 512 * j, wv); }
            if (lane == 0) SS[row] = ssq;
        } else { const float rstd = 1.f / sqrtf(ssq * (1.f / D) + EPS); f32x4* orow = (f32x4*)(a.out + (size_t)row * D) + lane;
#pragma unroll
            for (int j = 0; j < 4; ++j) { const f32x4 gg = ((const f32x4*)g)[lane + 64 * j]; st16fs(orow, 1024 * j, v[j] * rstd * gg); } }
    }
}
__device__ __forceinline__ void moe_tables(const Args& a, int layer, LAS unsigned char* lds, const int tid) {
    LAS int* pre = (LAS int*)(lds + MISC_PRE); LAS int* cn = (LAS int*)(lds + MISC_CNT);
    const unsigned* cnt = (const unsigned*)(a.ws + WS_CTL) + CW_CNT + layer * 1024;
    __syncthreads();
    if (tid < 64) {
        const int e = tid & 31; const int c = (int)__hip_atomic_load(cnt + e * 16, __ATOMIC_RELAXED, __HIP_MEMORY_SCOPE_AGENT);
        const int tiles = (c + 255) >> 8, full = c >> 8, tail = c & 255; int pt = tiles, pf = full;
#pragma unroll
        for (int o = 1; o < 32; o <<= 1) { const int ut = __shfl_up(pt, o, 32), uf = __shfl_up(pf, o, 32); if (e >= o) { pt += ut; pf += uf; } }
        int rank = 0, ntail = 0;
#pragma unroll 8
        for (int j = 0; j < 32; ++j) { const int tj = __shfl(tail, j, 32); ntail += tj ? 1 : 0; rank += (tj > tail || (tj == tail && j < e)) ? 1 : 0; }
        if (tid < 32) { cn[e] = c; pre[e] = pt - tiles; pre[40 + e] = pf - full; if (tail) pre[80 + rank] = e;
            if (e == 31) { pre[32] = pt; pre[72] = pf; pre[112] = ntail; } }
    }
    __syncthreads();
}

__global__ void __launch_bounds__(NTHREADS, 2) mega(Args args) {
    extern __shared__ __attribute__((aligned(16))) unsigned char lds_raw[];
    LAS unsigned char* lds = (LAS unsigned char*)lds_raw;
    const int G = gridDim.x;
    const int lo = args.ph_lo, hi = args.ph_hi;
    if (args.use_bar) { if (threadIdx.x < 2) ((volatile LAS unsigned*)(lds + MISC_BAR))[threadIdx.x] = 0u; __syncthreads();
        (void)xcd_barrier_post((unsigned*)(args.ws + WS_CTL) + CW_BAR, (volatile LAS unsigned*)(lds + MISC_BAR)); }
#define IN(k) (lo <= (k) && (k) < hi)
#define SEAM(k) do { if (IN(k) && IN((k) + 1)) { const Args ba_ = load_args(); grid_barrier(ba_, lds); } } while (0)
#define LA() const Args args = load_args(); unsigned char* ws = args.ws; (void)ws; int tid = threadIdx.x; asm volatile("" : "+v"(tid)); int bx = blockIdx.x; asm volatile("" : "+s"(bx)); \
    const int lane = tid & 63, wave = __builtin_amdgcn_readfirstlane(tid >> 6), vcu = (G % 8 == 0) ? (bx % 8) * (G / 8) + bx / 8 : bx, gw = vcu * NWAVES + wave, NGW = G * NWAVES; (void)lane; (void)gw; (void)NGW
    if (IN(0)) { LA(); p0_prologue<0>(args, lds, gw, NGW, wave, lane); }
    SEAM(0);
    if (IN(1)) {
#pragma nounroll
        for (int pass = 0; pass < 2; ++pass) {
            { LA(); const int nfc = G > 64 ? 32 : 0;
              if (pass == (vcu & 1) && bx >= nfc) { __syncthreads(); p0_prologue<1>(args, lds, (bx - nfc) * NWAVES + wave, (G - nfc) * NWAVES, wave, lane); __syncthreads(); } }
            if (pass == 0) { LA(); fox_cumsum(args, lds, G, tid);
                pg8::Dense P; P.init((const bf16_t*)(ws + WS_XB), 1024, (const bf16_t*)(ws + WS_WIN0), N, 3072, 1024, G, bx);
                pg8::EpiQkv0 E{(bf16_t*)(ws + R1_QKV0), (const float*)(ws + WS_SS)};
                pg8::gemm_phase<pg8::EpiQkv0, pg8::Dense, false>(lds, P, E, tid); }
        }
    }
    SEAM(1);
    if (IN(2)) { LA(); attn_phase0(args, lds, vcu, G, tid); }
    SEAM(2);
#ifndef CONV_IN_WOUT
#define CONV_IN_WOUT 3
#endif
    if (IN(3)) { LA(); merge_phase(args, gw, NGW, lane); if (!(CONV_IN_WOUT & 1)) moe_convert(args, 0, lds, gw, NGW, wave, lane); }
    SEAM(3);
    for (int layer = 0; layer < 2; ++layer) {
        const int pb = layer == 0 ? 4 : 12;
        if (layer == 1) {
            if (IN(9)) { LA();
                unsigned* rdy = (unsigned*)(ws + WS_CTL) + CW_RDY2;
                { pg8::DenseT<1> P; P.init((const bf16_t*)(ws + WS_XB), 1024, (const bf16_t*)(ws + WS_WIN1), N, 1536, 1024, G, bx); P.ready = rdy;
                  pg8::EpiWin1 E{(bf16_t*)(ws + R1_Z1), (const float*)(ws + WS_SS), (float*)(ws + WS_SSZ), (const f32x2*)(ws + WS_ROPE)};
                  pg8::gemm_phase<pg8::EpiWin1, pg8::DenseT<1>, false>(lds, P, E, tid); }
                { const int ce = G != 256 ? bx : (bx >= 128 ? bx - 128 : (bx >= 64 ? 64 + bx : (1 << 20))), ge = G != 256 ? G : (1 << 20);
                  pg8::DenseT<2> P; P.init((const bf16_t*)(ws + R1_Z1), 1536, (const bf16_t*)(ws + WS_WUQ), N, 768, 384, ge, ce); P.ready = rdy; P.need = 16u; P.sel = 0;
                  pg8::EpiUq E{(bf16_t*)(ws + R1_Q1), (const float*)(ws + WS_SSZ), (const f32x2*)(ws + WS_ROPE)};
                  int tid2 = threadIdx.x; asm volatile("" : "+v"(tid2));
                  pg8::gemm_phase<pg8::EpiUq, pg8::DenseT<2>, false>(lds, P, E, tid2); }
                { const int ce = G != 256 ? bx : (bx >= 128 ? bx - 128 : (1 << 20)), ge = G != 256 ? G : 128;
                  pg8::DenseT<2> P; P.init((const bf16_t*)(ws + R1_Z1) + 512, 1536, (const bf16_t*)(ws + WS_WUKV), N, 1024, 256, ge, ce); P.ready = rdy; P.need = 8u; P.sel = 1;
                  pg8::EpiUkv E{(bf16_t*)(ws + R1_KV1), (const float*)(ws + WS_SSZ)};
                  int tid3 = threadIdx.x; asm volatile("" : "+v"(tid3));
                  pg8::gemm_phase<pg8::EpiUkv, pg8::DenseT<2>, false>(lds, P, E, tid3); } }
            SEAM(10);
            if (IN(11)) { LA(); attn_phase1(args, lds, vcu, G, tid); if (!(CONV_IN_WOUT & 2)) moe_convert(args, 1, lds, gw, NGW, wave, lane); }
            SEAM(11);
        }
        if (IN(pb)) { LA();
            const bool cv = (CONV_IN_WOUT >> layer) & 1;
            if (cv && !(vcu & 1)) { moe_convert(args, layer, lds, gw, NGW, wave, lane); __syncthreads(); }
            { pg8::Dense P; P.init((const bf16_t*)(ws + R2_AO), 1024, (const bf16_t*)(ws + (layer == 0 ? WS_WOUT0 : WS_WOUT1)), N, 1024, 1024, G, bx);
              pg8::EpiOut E{(bf16_t*)(ws + WS_XB), (float*)(ws + WS_SSP)};
              pg8::gemm_phase<pg8::EpiOut, pg8::Dense, false>(lds, P, E, tid); }
            if (cv && (vcu & 1)) { __syncthreads(); int l2 = threadIdx.x & 63; asm volatile("" : "+v"(l2)); moe_convert(args, layer, lds, gw, NGW, wave, l2); } }
        SEAM(pb);
        if (IN(pb + 1)) { LA(); route_phase(args, layer, lds, vcu, G, wave, lane); }
        SEAM(pb + 1);
        if (IN(pb + 2)) { LA(); moe_tables(args, layer, lds, tid);
            unsigned* rdy = (unsigned*)(ws + WS_CTL) + CW_RDY + layer * 8192;
            { pg8::MoeProb<1> P{(const LAS int*)(lds + MISC_PRE), (const LAS int*)(lds + MISC_CNT), 2, G, vcu, 1024, 1024, (const bf16_t*)(ws + WS_XB), (const bf16_t*)(ws + (layer ? R2_WGU1 : R1_WGU)), (size_t)512 * 1024, (const unsigned*)(ws + WS_LT), true, rdy, 16u};
              pg8::EpiGateUp E{(bf16_t*)(ws + R1_ACT), (const float*)(ws + WS_LW), (const float*)(ws + WS_LR)};
              pg8::gemm_phase<pg8::EpiGateUp, pg8::MoeProb<1>, true>(lds, P, E, tid, (LAS unsigned*)(lds + MISC_STASH)); }
            { int tid2 = threadIdx.x; asm volatile("" : "+v"(tid2));
              pg8::MoeProb<2> P{(const LAS int*)(lds + MISC_PRE), (const LAS int*)(lds + MISC_CNT), 4, G, vcu, 256, 256, (const bf16_t*)(ws + R1_ACT), (const bf16_t*)(ws + (layer ? R2_WD1 : R1_WD)), (size_t)1024 * 256, (const unsigned*)(ws + WS_LT), false, rdy, 16u};
              pg8::EpiDown E{(bf16_t*)(ws + (layer ? Y1_BASE : R2_Y)), (const unsigned*)(ws + WS_LT)};
              pg8::gemm_phase<pg8::EpiDown, pg8::MoeProb<2>, false>(lds, P, E, tid2); } }
        SEAM(pb + 3);
        if (IN(pb + 4)) { LA(); combine_phase(args, layer == 1, gw, NGW, lane); }
        if (layer == 0) SEAM(8);
    }
#undef IN
#undef SEAM
#undef LA
}
}
extern "C" void kernel_launch(void* const* d_in, const int* in_sizes, int n_in, void* d_out, int out_size, void* d_ws, size_t ws_size, hipStream_t stream) {
    using namespace mk;
    static int grid = 0;
    if (grid == 0) {
        if (n_in != 21 || out_size != N * D || ws_size < 283 * MiB) { fprintf(stderr, "kernel_launch: unexpected problem (n_in %d out %d ws %zu)\n", n_in, out_size, ws_size); grid = -1; return; }
        int dev = 0, cus = 0, per_cu = 0;
        if (hipGetDevice(&dev) != hipSuccess || hipDeviceGetAttribute(&cus, hipDeviceAttributeMultiprocessorCount, dev) != hipSuccess) { grid = -1; return; }
        if (hipFuncSetAttribute((const void*)mega, hipFuncAttributeMaxDynamicSharedMemorySize, LDS_BYTES) != hipSuccess) { fprintf(stderr, "kernel_launch: hipFuncSetAttribute failed\n"); grid = -1; return; }
        if (hipOccupancyMaxActiveBlocksPerMultiprocessor(&per_cu, (const void*)mega, NTHREADS, LDS_BYTES) != hipSuccess || per_cu < 1) { fprintf(stderr, "kernel_launch: occupancy query says %d blocks per CU\n", per_cu); (void)hipGetLastError(); grid = -1; return; }
        grid = cus;
    }
    if (grid < 0) return;
    Args a{};
    for (int i = 0; i < 21; ++i) a.in[i] = (const float*)d_in[i];
    a.out = (float*)d_out; a.ws = (unsigned char*)d_ws; a.H = (float*)d_out; a.use_bar = 1; a.ph_lo = 0; a.ph_hi = NPHASE;
    (void)hipMemsetAsync((char*)d_ws + WS_CTL, 0, CTL_ZERO_BYTES, stream);
    hipLaunchKernelGGL(mega, dim3(grid), dim3(NTHREADS), LDS_BYTES, stream, a);
}
```
